# Optimizing an MI355X kernel written in HIP

```python
import math
import jax
import jax.numpy as jnp
from jax import lax
import numpy as np


D_MODEL = 1024
BATCH = 8
SEQ = 4096
DEPTH = 2

CTX_LEN = 256
GRID_W = 64
EPS = 1e-6
CONV_CH = 512
CONV_GROUPS = 8
CONV_WIDTH = 31
FOURIER_CH = 512
FOURIER_GROUPS = 4
MIX_IN = 2 * CONV_CH + FOURIER_CH
MIX_OUT = CONV_CH + FOURIER_CH
DA_HEADS = 8
DA_QK_DIM = 64
DA_V_DIM = 2 * DA_QK_DIM
QK_W = DA_HEADS * 2 * DA_QK_DIM
V_W = DA_HEADS * DA_V_DIM
ROPE_BASE = 10000.0
Q_BLOCK = 128
N_EXPERTS = 64
TOP_K = 6
N_GROUPS = 8
TOPK_GROUPS = 4
EXPERT_FF = 256
SHARED_FF = 256
ROUTED_SCALE = 2.5
MOE_BLOCK = 128
N_EVEN = (DEPTH + 1) // 2
N_ODD = DEPTH // 2

kernel_name = 'hybrid_conv_fourier_diffattn_moe_dit'


def rms_norm(x, g):
    xf = x.astype(jnp.float32)
    y = xf * lax.rsqrt(jnp.mean(xf * xf, axis=-1, keepdims=True) + EPS)
    return (y * g.astype(jnp.float32)).astype(x.dtype)


def swiglu(x, w_gate, w_up, w_down):
    return (jax.nn.silu(x @ w_gate) * (x @ w_up)) @ w_down


def conv_fourier_mix(h, w_in, conv_w, conv_b, ln_g, ln_b, w_out):
    bn, seq_len, _ = h.shape
    u = h @ w_in
    a_val, a_gate, f = jnp.split(u, [CONV_CH, 2 * CONV_CH], axis=-1)
    a = a_val * jax.nn.sigmoid(a_gate)
    a = lax.conv_general_dilated(a, conv_w.astype(a.dtype), window_strides=(1,),
                                 padding=[(CONV_WIDTH // 2, CONV_WIDTH // 2)],
                                 dimension_numbers=('NWC', 'WIO', 'NWC'),
                                 feature_group_count=CONV_CH) + conv_b
    ag = a.reshape(bn, seq_len, CONV_GROUPS, -1).astype(jnp.float32)
    mu = jnp.mean(ag, axis=-1, keepdims=True)
    var = jnp.mean(jnp.square(ag - mu), axis=-1, keepdims=True)
    an = ((ag - mu) * lax.rsqrt(var + EPS)).reshape(bn, seq_len, CONV_CH)
    a = jax.nn.silu(an * ln_g.astype(jnp.float32) + ln_b.astype(jnp.float32)).astype(h.dtype)
    fg = f.reshape(bn, seq_len, FOURIER_GROUPS, -1).astype(jnp.float32)
    fr = jnp.fft.fft2(fg, axes=(1, 3), norm='ortho').real.reshape(bn, seq_len, FOURIER_CH).astype(h.dtype)
    return jnp.concatenate([a, fr], axis=-1) @ w_out


def axial_rope_tables(n_tokens):
    rows = n_tokens // GRID_W
    row = jnp.repeat(jnp.arange(rows), GRID_W).astype(jnp.float32)
    col = jnp.tile(jnp.arange(GRID_W), rows).astype(jnp.float32)
    n_freq = DA_QK_DIM // 4
    inv = jnp.power(ROPE_BASE, -jnp.arange(n_freq, dtype=jnp.float32) / n_freq)
    ang = jnp.concatenate([row[:, None] * inv, col[:, None] * inv], axis=-1)
    ang = jnp.concatenate([ang, ang], axis=-1)
    return jnp.cos(ang), jnp.sin(ang)


def apply_rope(x, cos, sin):
    half = DA_QK_DIM // 2
    xf = x.astype(jnp.float32)
    rot = jnp.concatenate([-xf[..., half:], xf[..., :half]], axis=-1)
    c = cos[:, None, None, :]
    s = sin[:, None, None, :]
    return (xf * c + rot * s).astype(x.dtype)


def da_queries(h, w_qkv):
    return (h @ w_qkv[:, :QK_W]).reshape(h.shape[0], h.shape[1], DA_HEADS, 2, DA_QK_DIM)


def da_keys_values(h, w_qkv):
    k, v = jnp.split(h @ w_qkv[:, QK_W:], [QK_W], axis=-1)
    return (k.reshape(h.shape[0], h.shape[1], DA_HEADS, 2, DA_QK_DIM),
            v.reshape(h.shape[0], h.shape[1], DA_HEADS, DA_V_DIM))


def diff_attention_core(q, k, v, lam):
    bn, lq = q.shape[0], q.shape[1]
    nb = lq // Q_BLOCK
    qb = jnp.moveaxis(q.reshape(bn, nb, Q_BLOCK, DA_HEADS, 2, DA_QK_DIM), 1, 0)
    scale = DA_QK_DIM ** -0.5

    def block(qi):
        s = jnp.einsum('bqhcd,bkhcd->bchqk', qi, k, preferred_element_type=jnp.float32) * scale
        p = jax.nn.softmax(s, axis=-1)
        pd = p[:, 0] - lam * p[:, 1]
        return jnp.einsum('bhqk,bkhe->bqhe', pd.astype(v.dtype), v,
                          preferred_element_type=jnp.float32).astype(v.dtype)

    o = lax.map(block, qb)
    return jnp.moveaxis(o, 0, 1).reshape(bn, lq, DA_HEADS, DA_V_DIM)


def diff_attn_out(o, subln_g, lam_init, w_out):
    o = rms_norm(o, subln_g) * (1.0 - lam_init)
    return o.reshape(o.shape[0], o.shape[1], V_W) @ w_out


def moe_ffn(h, router_w, router_b, w_gate, w_up, w_down, sh_gate, sh_up, sh_down):
    n_tok, dm = h.shape
    scores = jax.nn.sigmoid(jnp.matmul(h, router_w, preferred_element_type=jnp.float32))
    biased = scores + router_b.astype(jnp.float32)
    grouped = biased.reshape(n_tok, N_GROUPS, N_EXPERTS // N_GROUPS)
    group_score = jnp.sum(lax.top_k(grouped, 2)[0], axis=-1)
    top_groups = lax.top_k(group_score, TOPK_GROUPS)[1]
    group_mask = jnp.sum(jax.nn.one_hot(top_groups, N_GROUPS, dtype=jnp.float32), axis=1) > 0
    expert_mask = jnp.repeat(group_mask, N_EXPERTS // N_GROUPS, axis=1)
    top_e = lax.top_k(jnp.where(expert_mask, biased, -jnp.inf), TOP_K)[1]
    gates = jnp.take_along_axis(scores, top_e, axis=1)
    gates = gates / jnp.sum(gates, axis=-1, keepdims=True) * ROUTED_SCALE
    n_assign = n_tok * TOP_K
    flat_e = top_e.reshape(-1)
    flat_tok = jnp.repeat(jnp.arange(n_tok, dtype=jnp.int32), TOP_K)
    flat_g = gates.reshape(-1)
    order = jnp.argsort(flat_e)
    sorted_e = flat_e[order]
    counts = jnp.bincount(flat_e, length=N_EXPERTS)
    starts = jnp.cumsum(counts) - counts
    padded = (counts + MOE_BLOCK - 1) // MOE_BLOCK * MOE_BLOCK
    pad_ends = jnp.cumsum(padded)
    pad_starts = pad_ends - padded
    dest = pad_starts[sorted_e] + jnp.arange(n_assign) - starts[sorted_e]
    n_blocks = -(-(n_assign + N_EXPERTS * (MOE_BLOCK - 1)) // MOE_BLOCK)
    n_rows = n_blocks * MOE_BLOCK
    row_tok = jnp.zeros((n_rows,), jnp.int32).at[dest].set(flat_tok[order])
    row_gate = jnp.zeros((n_rows,), jnp.float32).at[dest].set(flat_g[order])
    block_e = jnp.minimum(jnp.searchsorted(pad_ends, jnp.arange(n_blocks) * MOE_BLOCK, side='right'),
                          N_EXPERTS - 1)
    xb = h[row_tok].reshape(n_blocks, MOE_BLOCK, dm)
    yb = lax.map(lambda a: swiglu(a[0], w_gate[a[1]], w_up[a[1]], w_down[a[1]]), (xb, block_e))
    routed = jnp.zeros((n_tok, dm), jnp.float32).at[row_tok].add(
        yb.reshape(n_rows, dm).astype(jnp.float32) * row_gate[:, None])
    shared = swiglu(h, sh_gate, sh_up, sh_down).astype(jnp.float32)
    return (routed + shared).astype(h.dtype)


def setup_inputs(seed: int = 0) -> dict:
    key = jax.random.key(seed)
    ks = jax.random.split(key, 32)
    d = D_MODEL

    def nrm(k, shape, s):
        return jax.random.normal(k, shape, jnp.float32) * s

    return {
        'x': nrm(ks[0], (BATCH, SEQ, d), 1.0),
        'c': nrm(ks[1], (BATCH, d), 1.0),
        'ctx': nrm(ks[2], (BATCH, CTX_LEN, d), 1.0),
        'c_ctx': nrm(ks[3], (d,), 1.0),
        'ada_w': nrm(ks[4], (DEPTH, d, 6 * d), 0.5 * d ** -0.5),
        'ada_b': nrm(ks[5], (DEPTH, 6 * d), 0.02),
        'norm_g': 1.0 + nrm(ks[6], (DEPTH, 4, d), 0.02),
        'cf_w_in': nrm(ks[7], (N_EVEN, d, MIX_IN), d ** -0.5),
        'cf_conv_w': nrm(ks[8], (N_EVEN, CONV_WIDTH, 1, CONV_CH), CONV_WIDTH ** -0.5),
        'cf_conv_b': nrm(ks[9], (N_EVEN, CONV_CH), 0.02),
        'cf_ln_g': 1.0 + nrm(ks[10], (N_EVEN, CONV_CH), 0.02),
        'cf_ln_b': nrm(ks[11], (N_EVEN, CONV_CH), 0.02),
        'cf_w_out': nrm(ks[12], (N_EVEN, MIX_OUT, d), MIX_OUT ** -0.5),
        'da_w_qkv': nrm(ks[13], (N_ODD, d, 2 * QK_W + V_W), d ** -0.5),
        'da_lambda': nrm(ks[14], (N_ODD, 4, DA_QK_DIM), 0.1),
        'da_subln_g': 1.0 + nrm(ks[15], (N_ODD, DA_V_DIM), 0.02),
        'da_w_out': nrm(ks[16], (N_ODD, V_W, d), V_W ** -0.5),
        'moe_router_w': nrm(ks[17], (DEPTH, d, N_EXPERTS), d ** -0.5),
        'moe_router_b': nrm(ks[18], (DEPTH, N_EXPERTS), 0.01),
        'moe_w_gate': nrm(ks[19], (DEPTH, N_EXPERTS, d, EXPERT_FF), d ** -0.5),
        'moe_w_up': nrm(ks[20], (DEPTH, N_EXPERTS, d, EXPERT_FF), d ** -0.5),
        'moe_w_down': nrm(ks[21], (DEPTH, N_EXPERTS, EXPERT_FF, d), EXPERT_FF ** -0.5),
        'moe_sh_gate': nrm(ks[22], (DEPTH, d, SHARED_FF), d ** -0.5),
        'moe_sh_up': nrm(ks[23], (DEPTH, d, SHARED_FF), d ** -0.5),
        'moe_sh_down': nrm(ks[24], (DEPTH, SHARED_FF, d), SHARED_FF ** -0.5),
    }


def reference(x, c, ctx, c_ctx, ada_w, ada_b, norm_g, cf_w_in, cf_conv_w, cf_conv_b, cf_ln_g, cf_ln_b,
              cf_w_out, da_w_qkv, da_lambda, da_subln_g, da_w_out, moe_router_w, moe_router_b,
              moe_w_gate, moe_w_up, moe_w_down, moe_sh_gate, moe_sh_up, moe_sh_down):
    bn, n_lat, dm = x.shape
    n_ctx = ctx.shape[1]
    cos, sin = axial_rope_tables(n_lat)
    c_lat = jax.nn.silu(c)[:, None, :]
    c_con = jax.nn.silu(c_ctx)[None, None, :]
    for i in range(DEPTH):
        last = i == DEPTH - 1
        odd = i % 2 == 1
        j = i // 2
        m_lat = jnp.split(c_lat @ ada_w[i] + ada_b[i], 6, axis=-1)
        m_ctx = jnp.split(c_con @ ada_w[i] + ada_b[i], 6, axis=-1)
        hx = rms_norm(x, norm_g[i, 0]) * (1.0 + m_lat[1]) + m_lat[0]
        if odd:
            hc = rms_norm(ctx, norm_g[i, 0]) * (1.0 + m_ctx[1]) + m_ctx[0]
            lam_init = 0.8 - 0.6 * math.exp(-0.3 * i)
            lp = da_lambda[j].astype(jnp.float32)
            lam = jnp.exp(jnp.sum(lp[0] * lp[1])) - jnp.exp(jnp.sum(lp[2] * lp[3])) + lam_init
            qx = apply_rope(da_queries(hx, da_w_qkv[j]), cos, sin)
            kx, vx = da_keys_values(hx, da_w_qkv[j])
            kx = apply_rope(kx, cos, sin)
            kc, vc = da_keys_values(hc, da_w_qkv[j])
            k_all = jnp.concatenate([kc, kx], axis=1)
            v_all = jnp.concatenate([vc, vx], axis=1)
            yx = diff_attn_out(diff_attention_core(qx, k_all, v_all, lam), da_subln_g[j], lam_init, da_w_out[j])
            if not last:
                qc = da_queries(hc, da_w_qkv[j])
                yc = diff_attn_out(diff_attention_core(qc, kc, vc, lam), da_subln_g[j], lam_init, da_w_out[j])
        else:
            yx = conv_fourier_mix(hx, cf_w_in[j], cf_conv_w[j], cf_conv_b[j], cf_ln_g[j], cf_ln_b[j], cf_w_out[j])
            if not last:
                hc = rms_norm(ctx, norm_g[i, 0]) * (1.0 + m_ctx[1]) + m_ctx[0]
                yc = conv_fourier_mix(hc, cf_w_in[j], cf_conv_w[j], cf_conv_b[j], cf_ln_g[j], cf_ln_b[j],
                                      cf_w_out[j])
        x = x + m_lat[2] * rms_norm(yx, norm_g[i, 1])
        if not last:
            ctx = ctx + m_ctx[2] * rms_norm(yc, norm_g[i, 1])
        tok = (rms_norm(x, norm_g[i, 2]) * (1.0 + m_lat[4]) + m_lat[3]).reshape(-1, dm)
        if not last:
            tok_c = (rms_norm(ctx, norm_g[i, 2]) * (1.0 + m_ctx[4]) + m_ctx[3]).reshape(-1, dm)
            tok = jnp.concatenate([tok, tok_c], axis=0)
        y = moe_ffn(tok, moe_router_w[i], moe_router_b[i], moe_w_gate[i], moe_w_up[i], moe_w_down[i],
                    moe_sh_gate[i], moe_sh_up[i], moe_sh_down[i])
        x = x + m_lat[5] * rms_norm(y[:bn * n_lat].reshape(bn, n_lat, dm), norm_g[i, 3])
        if not last:
            ctx = ctx + m_ctx[5] * rms_norm(y[bn * n_lat:].reshape(bn, n_ctx, dm), norm_g[i, 3])
    return x
```

```cpp
#include <hip/hip_runtime.h>
#include <hip/hip_bf16.h>
#include <cstdio>
#include <cstdint>
#include <cmath>

#ifndef MK_SINGLE
#define MK_SINGLE 1
#endif

constexpr int DM = 1024, NBATCH = 8, SEQ = 4096, CTXL = 256;
constexpr int TL = NBATCH * SEQ;
constexpr int TC = NBATCH * CTXL;
constexpr int T0 = TL + TC;
constexpr int LKV = CTXL + SEQ;
constexpr float EPSN = 1e-6f;
constexpr int NEXP = 64, TOPK = 6;
constexpr int NCH = 2;
constexpr int CAP = T0 / NCH;

namespace pg8 {
#define PG8_LAS __attribute__((address_space(3)))
#define PG8_GAS __attribute__((address_space(1)))
typedef unsigned short bf16_t;
typedef short bf16x8 __attribute__((ext_vector_type(8)));
typedef float f32x4 __attribute__((ext_vector_type(4)));
typedef unsigned u32x4 __attribute__((ext_vector_type(4)));
constexpr int BM = 256, BK = 64, HALF = 128, HTB = HALF * BK * 2, STAGE_BYTES = 8 * HTB;

__host__ __device__ __forceinline__ int lds_byte(int r, int c) { const int st = (r >> 4) * 2 + (c >> 5), rr = r & 15, cc = c & 31, ob = rr * 64 + cc * 2; return st * 1024 + (ob ^ (((ob >> 9) & 1) << 5)); }
__host__ __device__ __forceinline__ void stage_rc(int b, int& R, int& C) { const int st = b / 1024, sb = b % 1024, swz = sb ^ (((sb >> 9) & 1) << 5); R = (st >> 1) * 16 + swz / 64; C = (st & 1) * 32 + (swz % 64) / 2; }
__host__ __device__ __forceinline__ int perm32(int rho) { const int n = rho >> 4, i = rho & 15; return 8 * (i >> 2) + 4 * n + (i & 3); }

struct Unit { unsigned A, B; int pm, pn, aux; };

__device__ __forceinline__ unsigned cvt_pk_bf16(float lo, float hi) { unsigned r; asm volatile("v_cvt_pk_bf16_f32 %0, %1, %2" : "=v"(r) : "v"(lo), "v"(hi)); return r; }
__device__ __forceinline__ u32x4 pack8(const f32x4& a, const f32x4& b) { u32x4 w; w.x = cvt_pk_bf16(a[0], a[1]); w.y = cvt_pk_bf16(a[2], a[3]); w.z = cvt_pk_bf16(b[0], b[1]); w.w = cvt_pk_bf16(b[2], b[3]); return w; }


template <class Epi, class Sched>
__device__ __forceinline__ void gemm_phase(PG8_LAS unsigned char* lds, const void* wsbase, const int K, const int ldb, const Sched& S, const Epi& E) {
    const __amdgpu_buffer_rsrc_t rsrc = __builtin_amdgcn_make_buffer_rsrc((void*)wsbase, 0, 0x7fffffff, 0x00020000);
    int tid_ = threadIdx.x; asm volatile("" : "+v"(tid_));
    const int tid = tid_, wid = __builtin_amdgcn_readfirstlane(tid >> 6), lane = tid & 63, wr = wid >> 2, wc = wid & 3, fr = lane & 15, fq = lane >> 4;
    const int nt = K / BK;
    unsigned voffB[2];
#pragma unroll
    for (int i = 0; i < 2; ++i) { int R, C; stage_rc(tid * 16 + i * 8192, R, C); const int Rb = (R & ~31) + perm32(R & 31); voffB[i] = (unsigned)(Rb * ldb + C) * 2u; }
    const unsigned kstep = (unsigned)(BK * 2);
    const unsigned hstepB = (unsigned)HALF * ldb * 2;
    const unsigned ldsw = (unsigned)wid * 1024u;
    const int aoff = lds_byte(wr * 64 + fr, fq * 8), boff = lds_byte(wc * 32 + fr, fq * 8);
#define PG8_SA(b, h) (((b) * 2 + (h)) * HTB)
#define PG8_SB(b, h) ((4 + (b) * 2 + (h)) * HTB)
#define PG8_STG(bufoff, gbase, v0, v1) do { \
        __builtin_amdgcn_raw_ptr_buffer_load_lds(rsrc, (PG8_LAS unsigned*)(lds + (bufoff) + ldsw), 16, (v0), (gbase), 0, 0); \
        __builtin_amdgcn_raw_ptr_buffer_load_lds(rsrc, (PG8_LAS unsigned*)(lds + (bufoff) + ldsw + 8192), 16, (v1), (gbase), 0, 0); } while (0)
#define PG8_STGB(bufoff, gbase) PG8_STG(bufoff, gbase, voffB[0], voffB[1])
#define PG8_LDA(dst, b, h) do { _Pragma("unroll") for (int m = 0; m < 4; ++m) _Pragma("unroll") for (int k = 0; k < 2; ++k) dst[m][k] = *(const PG8_LAS bf16x8*)(lds + PG8_SA(b, h) + aoff + m * 2048 + k * 1024); } while (0)
#define PG8_LDB(dst, b, h) do { _Pragma("unroll") for (int n = 0; n < 2; ++n) _Pragma("unroll") for (int k = 0; k < 2; ++k) dst[n][k] = *(const PG8_LAS bf16x8*)(lds + PG8_SB(b, h) + boff + n * 2048 + k * 1024); } while (0)
#define PG8_MMA(ai, bj, At, Bt) do { __builtin_amdgcn_s_setprio(1); _Pragma("unroll") for (int m = 0; m < 4; ++m) _Pragma("unroll") for (int n = 0; n < 2; ++n) _Pragma("unroll") for (int k = 0; k < 2; ++k) \
        acc[ai][bj][m][n] = __builtin_amdgcn_mfma_f32_16x16x32_bf16(Bt[n][k], At[m][k], acc[ai][bj][m][n], 0, 0, 0); __builtin_amdgcn_s_setprio(0); } while (0)
#define PG8_WAIT_V(n) asm volatile("s_waitcnt vmcnt(" #n ")" ::: "memory")
#define PG8_WAIT_L(n) asm volatile("s_waitcnt lgkmcnt(" #n ")" ::: "memory")
#define PG8_BAR __builtin_amdgcn_s_barrier()
#define PG8_SCHED __builtin_amdgcn_sched_barrier(0)
    Unit cur, nxt; int ui = 0;
    if (!S.next(0, cur)) return;
    f32x4 acc[2][2][4][2];
#pragma unroll
    for (int a = 0; a < 2; ++a)
#pragma unroll
        for (int b = 0; b < 2; ++b)
#pragma unroll
            for (int m = 0; m < 4; ++m)
#pragma unroll
                for (int n = 0; n < 2; ++n) acc[a][b][m][n] = (f32x4){0.f, 0.f, 0.f, 0.f};
    bf16x8 At[4][2], B0[2][2], B1[2][2];
    unsigned vAc[2][2], vAn[2][2];
    S.aoffs(cur, vAc);
    unsigned cA = cur.A, cB = cur.B;
    PG8_STGB(PG8_SB(0, 0), cB); PG8_STGB(PG8_SB(0, 1), cB + hstepB); PG8_STG(PG8_SA(0, 0), cA, vAc[0][0], vAc[0][1]); PG8_STG(PG8_SA(0, 1), cA, vAc[1][0], vAc[1][1]);
    if (wr == 1) PG8_BAR;
    PG8_WAIT_V(2); PG8_BAR;
    PG8_STGB(PG8_SB(1, 0), cB + kstep); PG8_STG(PG8_SA(1, 0), cA + kstep, vAc[0][0], vAc[0][1]); PG8_STGB(PG8_SB(1, 1), cB + hstepB + kstep);
    PG8_WAIT_V(6); PG8_BAR;
    for (;;) {
        const bool has_next = S.next(ui + 1, nxt);
        if constexpr (Sched::GATHER) {
            if (has_next) S.aoffs(nxt, vAn);
            else {
#pragma unroll
                for (int h = 0; h < 2; ++h)
#pragma unroll
                    for (int i = 0; i < 2; ++i) vAn[h][i] = vAc[h][i]; } }
        const unsigned nA = has_next ? nxt.A : cA, nB = has_next ? nxt.B : cB;
        for (int t = 0; t < nt; t += 2) {
            const bool last = (t == nt - 2);
            const unsigned a1 = cA + (unsigned)(t + 1) * kstep;
            const unsigned a2 = last ? nA : cA + (unsigned)(t + 2) * kstep, b2 = last ? nB : cB + (unsigned)(t + 2) * kstep;
            const unsigned a3 = a2 + kstep, b3 = b2 + kstep;
            unsigned w00 = vAc[0][0], w01 = vAc[0][1], w10 = vAc[1][0], w11 = vAc[1][1];
            if constexpr (Sched::GATHER) { w00 = last ? vAn[0][0] : w00; w01 = last ? vAn[0][1] : w01; w10 = last ? vAn[1][0] : w10; w11 = last ? vAn[1][1] : w11; }
            PG8_LDB(B0, 0, 0); PG8_LDB(B1, 0, 1); PG8_SCHED; PG8_LDA(At, 0, 0); PG8_STG(PG8_SA(1, 1), a1, vAc[1][0], vAc[1][1]);
            PG8_WAIT_V(8); PG8_WAIT_L(0); PG8_BAR; PG8_MMA(0, 0, At, B0); PG8_MMA(0, 1, At, B1); PG8_BAR; PG8_SCHED;
            PG8_LDA(At, 0, 1); PG8_STGB(PG8_SB(0, 0), b2); PG8_STGB(PG8_SB(0, 1), b2 + hstepB); PG8_STG(PG8_SA(0, 0), a2, w00, w01);
            PG8_WAIT_V(8); PG8_WAIT_L(0); PG8_BAR; PG8_MMA(1, 0, At, B0); PG8_MMA(1, 1, At, B1); PG8_BAR; PG8_SCHED;
            PG8_LDB(B0, 1, 0); PG8_LDB(B1, 1, 1); PG8_SCHED; PG8_LDA(At, 1, 0); PG8_STG(PG8_SA(0, 1), a2, w10, w11);
            PG8_WAIT_V(8); PG8_WAIT_L(0); PG8_BAR; PG8_MMA(0, 0, At, B0); PG8_MMA(0, 1, At, B1); PG8_BAR; PG8_SCHED;
            PG8_LDA(At, 1, 1); PG8_STGB(PG8_SB(1, 0), b3); PG8_STGB(PG8_SB(1, 1), b3 + hstepB); PG8_STG(PG8_SA(1, 0), a3, w00, w01);
            PG8_WAIT_V(8); PG8_WAIT_L(0); PG8_BAR; PG8_MMA(1, 0, At, B0); PG8_MMA(1, 1, At, B1); PG8_BAR; PG8_SCHED;
        }
        if (wr == 0) PG8_BAR;
        { int t2 = threadIdx.x; asm volatile("" : "+v"(t2)); const int l2 = t2 & 63, w2 = __builtin_amdgcn_readfirstlane(t2 >> 6);
          E(acc, cur, w2 >> 2, w2 & 3, l2 & 15, l2 >> 4); }
        if (!has_next) break;
#pragma unroll
        for (int a = 0; a < 2; ++a)
#pragma unroll
            for (int b = 0; b < 2; ++b)
#pragma unroll
                for (int m = 0; m < 4; ++m)
#pragma unroll
                    for (int n = 0; n < 2; ++n) acc[a][b][m][n] = (f32x4){0.f, 0.f, 0.f, 0.f};
        cur = nxt; cA = nA; cB = nB; ++ui;
        if constexpr (Sched::GATHER) {
#pragma unroll
            for (int h = 0; h < 2; ++h)
#pragma unroll
                for (int i = 0; i < 2; ++i) vAc[h][i] = vAn[h][i]; }
        if (wr == 1) PG8_BAR;
    }
    PG8_WAIT_V(0);
    PG8_BAR;
#undef PG8_SA
#undef PG8_SB
#undef PG8_STG
#undef PG8_STGB
#undef PG8_LDA
#undef PG8_LDB
#undef PG8_MMA
#undef PG8_WAIT_V
#undef PG8_WAIT_L
#undef PG8_BAR
#undef PG8_SCHED
}

struct DenseOrder {
    static constexpr bool GATHER = false;
    unsigned A, B; int lda, ldb, nM, nN, pn0, nwg, G, c;
    __device__ __forceinline__ void init(size_t A_, int lda_, size_t B_, int ldb_, int nM_, int nN_, int pn0_, int G_, int c_) { A = (unsigned)A_; B = (unsigned)B_; lda = lda_; ldb = ldb_; nM = nM_; nN = nN_; pn0 = pn0_; nwg = nM * nN; G = G_; c = c_; }
    __device__ __forceinline__ bool next(int i, Unit& u) const {
        const long L = (long)i * G + c; if (L >= nwg) return false;
        int wgid = (int)L; { const int q = nwg / 8, r = nwg % 8, xcd = wgid % 8, off = wgid / 8; wgid = (xcd < r ? xcd * (q + 1) : r * (q + 1) + (xcd - r) * q) + off; }
        const int nig = 8 * nN, gid = wgid / nig, fm = gid * 8, gsz = (nM - fm) < 8 ? (nM - fm) : 8;
        u.pm = fm + ((wgid % nig) % gsz); u.pn = (wgid % nig) / gsz + pn0; u.aux = 0;
        u.A = A + (unsigned)u.pm * 256u * lda * 2u; u.B = B + (unsigned)u.pn * 256u * ldb * 2u; return true;
    }
    __device__ __forceinline__ void aoffs(const Unit&, unsigned (&v)[2][2]) const {
        int tid = threadIdx.x; asm volatile("" : "+v"(tid));
#pragma unroll
        for (int i = 0; i < 2; ++i) { int R, C; stage_rc(tid * 16 + i * 8192, R, C);
#pragma unroll
            for (int h = 0; h < 2; ++h) v[h][i] = (unsigned)((h * 128 + R) * lda + C) * 2u; }
    }
};

struct EpiBf16 {
    bf16_t* O; int ldc, coff;
    __device__ __forceinline__ void operator()(const f32x4 (&acc)[2][2][4][2], const Unit& u, int wr, int wc, int fr, int fq) const {
        const int row0 = u.pm * BM + wr * 64 + fr, col0 = coff + u.pn * BM + wc * 32 + 8 * fq;
#pragma unroll
        for (int ai = 0; ai < 2; ++ai)
#pragma unroll
            for (int m = 0; m < 4; ++m) { bf16_t* rowp = O + (size_t)(row0 + ai * HALF + m * 16) * ldc + col0;
#pragma unroll
                for (int bj = 0; bj < 2; ++bj) *(PG8_GAS u32x4*)(rowp + bj * HALF) = pack8(acc[ai][bj][m][0], acc[ai][bj][m][1]); }
    }
};
__device__ __forceinline__ float sigm(float x) { return 1.f / (1.f + __expf(-x)); }
struct EpiSwiglu {
    bf16_t* H; int ldh;
    __device__ __forceinline__ void operator()(const f32x4 (&acc)[2][2][4][2], const Unit& u, int wr, int wc, int fr, int fq) const {
        const int row0 = u.pm * BM + wr * 64 + fr, col0 = u.pn * HALF + wc * 32 + 8 * fq;
#pragma unroll
        for (int ai = 0; ai < 2; ++ai)
#pragma unroll
            for (int m = 0; m < 4; ++m) { f32x4 o[2];
#pragma unroll
                for (int n = 0; n < 2; ++n)
#pragma unroll
                    for (int j = 0; j < 4; ++j) { const float g = acc[ai][0][m][n][j]; o[n][j] = g * sigm(g) * acc[ai][1][m][n][j]; }
                *(PG8_GAS u32x4*)(H + (size_t)(row0 + ai * HALF + m * 16) * ldh + col0) = pack8(o[0], o[1]); }
    }
};
struct EpiGlu {
    bf16_t* AGLU;
    __device__ __forceinline__ void operator()(const f32x4 (&acc)[2][2][4][2], const Unit& u, int wr, int wc, int fr, int fq) const {
        const int row0 = u.pm * BM + wr * 64 + fr, col0 = u.pn * HALF + wc * 32 + 8 * fq;
#pragma unroll
        for (int ai = 0; ai < 2; ++ai)
#pragma unroll
            for (int m = 0; m < 4; ++m) { f32x4 o[2];
#pragma unroll
                for (int n = 0; n < 2; ++n)
#pragma unroll
                    for (int j = 0; j < 4; ++j) o[n][j] = acc[ai][0][m][n][j] * sigm(acc[ai][1][m][n][j]);
                *(PG8_GAS u32x4*)(AGLU + (size_t)(row0 + ai * HALF + m * 16) * 512 + col0) = pack8(o[0], o[1]); }
    }
};
struct EpiFT {
    bf16_t* FT; bf16_t* FTC;
    __device__ __forceinline__ void operator()(const f32x4 (&acc)[2][2][4][2], const Unit& u, int wr, int wc, int fr, int fq) const {
        const int rb = u.pm * BM; bf16_t* base; int L, l0;
        if (rb < TL) { base = FT + (size_t)(rb / SEQ) * 512 * SEQ; L = SEQ; l0 = rb % SEQ; } else { base = FTC + (size_t)((rb - TL) / CTXL) * 512 * CTXL; L = CTXL; l0 = 0; }
        const int ch0 = (u.pn - 4) * BM + wc * 32 + 8 * fq;
        bf16_t* lanep = base + (size_t)ch0 * L + l0 + wr * 64 + fr;
#pragma unroll
        for (int ai = 0; ai < 2; ++ai)
#pragma unroll
            for (int m = 0; m < 4; ++m)
#pragma unroll
                for (int bj = 0; bj < 2; ++bj)
#pragma unroll
                    for (int n = 0; n < 2; ++n) { const unsigned p0 = cvt_pk_bf16(acc[ai][bj][m][n][0], acc[ai][bj][m][n][1]), p1 = cvt_pk_bf16(acc[ai][bj][m][n][2], acc[ai][bj][m][n][3]);
                        PG8_GAS bf16_t* d = (PG8_GAS bf16_t*)(lanep + (size_t)(bj * HALF + 4 * n) * L + (ai * HALF + m * 16));
                        d[0] = (bf16_t)(p0 & 0xffffu); d[(size_t)L] = (bf16_t)(p0 >> 16); d[(size_t)2 * L] = (bf16_t)(p1 & 0xffffu); d[(size_t)3 * L] = (bf16_t)(p1 >> 16); }
    }
};
template <int L> struct EpiDft {
    bf16_t* FF; int tok0;
    __device__ __forceinline__ void operator()(const f32x4 (&acc)[2][2][4][2], const Unit& u, int wr, int wc, int fr, int fq) const {
        constexpr int H = L / 2;
        const size_t tokbase = (size_t)tok0 + (size_t)u.aux * L;
        const int c0 = wc * 32 + 8 * fq;
#pragma unroll
        for (int ai = 0; ai < 2; ++ai)
#pragma unroll
            for (int m = 0; m < 4; ++m) { const int r = u.pm * BM + ai * HALF + wr * 64 + m * 16 + fr; const int part = r > H ? 1 : 0, k = part ? r - H : r;
#pragma unroll
                for (int bj = 0; bj < 2; ++bj) { const int g = 2 * u.pn + bj; const f32x4 a0 = acc[ai][bj][m][0], a1 = acc[ai][bj][m][1];
                    const u32x4 pos = pack8(a0, a1);
                    bf16_t* d1 = FF + (tokbase + k) * 1024 + g * 256 + part * 128 + c0; *(PG8_GAS u32x4*)d1 = pos;
                    if (k != 0 && k != H) { bf16_t* d2 = FF + (tokbase + (L - k)) * 1024 + g * 256 + part * 128 + c0; u32x4 w = pos; if (part) { w.x ^= 0x80008000u; w.y ^= 0x80008000u; w.z ^= 0x80008000u; w.w ^= 0x80008000u; } *(PG8_GAS u32x4*)d2 = w; }
                    else if (!part) { bf16_t* d3 = FF + (tokbase + k) * 1024 + g * 256 + 128 + c0; *(PG8_GAS u32x4*)d3 = (u32x4){0u, 0u, 0u, 0u}; } } }
    }
};
constexpr float QSCALE = 0.125f * 1.4426950408889634f;
struct EpiQkv {
    bf16_t* Q; bf16_t* KA; bf16_t* VA; const float* rc; const float* rs; int is_ctx;
    __device__ __forceinline__ void operator()(const f32x4 (&acc)[2][2][4][2], const Unit& u, int wr, int wc, int fr, int fq) const {
        const int kind = u.pn >> 2, pt = u.pn & 3;
        const int rb = u.pm * BM;
        const int b = is_ctx ? rb / CTXL : rb / SEQ, s0 = is_ctx ? 0 : rb % SEQ;
        const size_t kvrow0 = (size_t)b * LKV + (is_ctx ? 0 : CTXL) + s0;
        const int lr0 = wr * 64 + fr;
        if (kind == 2) {
            const int col0 = pt * BM + wc * 32 + 8 * fq;
#pragma unroll
            for (int ai = 0; ai < 2; ++ai)
#pragma unroll
                for (int m = 0; m < 4; ++m) { bf16_t* rowp = VA + (kvrow0 + lr0 + ai * HALF + m * 16) * 1024 + col0;
#pragma unroll
                    for (int bj = 0; bj < 2; ++bj) *(PG8_GAS u32x4*)(rowp + bj * HALF) = pack8(acc[ai][bj][m][0], acc[ai][bj][m][1]); }
        } else {
            const int head = 2 * pt + (wc >> 1), comp = wc & 1, colb = head * 128 + comp * 64 + 8 * fq;
            const float sc = kind == 0 ? QSCALE : 1.f;
#pragma unroll
            for (int ai = 0; ai < 2; ++ai)
#pragma unroll
                for (int m = 0; m < 4; ++m) { const int lr = lr0 + ai * HALF + m * 16;
                    f32x4 o1[2], o2[2];
                    if (!is_ctx) { const float* pc = rc + (size_t)(s0 + lr) * 32 + 8 * fq; const float* ps = rs + (size_t)(s0 + lr) * 32 + 8 * fq;
#pragma unroll
                        for (int n = 0; n < 2; ++n) { const f32x4 cv = *(const PG8_GAS f32x4*)(pc + 4 * n), sv = *(const PG8_GAS f32x4*)(ps + 4 * n); const f32x4 x1 = acc[ai][0][m][n], x2 = acc[ai][1][m][n];
                            o1[n] = (x1 * cv - x2 * sv) * sc; o2[n] = (x2 * cv + x1 * sv) * sc; }
                    } else { o1[0] = acc[ai][0][m][0]; o1[1] = acc[ai][0][m][1]; o2[0] = acc[ai][1][m][0]; o2[1] = acc[ai][1][m][1]; }
                    bf16_t* d = (kind == 0 ? Q + (size_t)(rb + lr) * 1024 : KA + (kvrow0 + lr) * 1024) + colb;
                    *(u32x4*)d = pack8(o1[0], o1[1]); *(PG8_GAS u32x4*)(d + 32) = pack8(o2[0], o2[1]); }
        }
    }
};
}

namespace attn_body {
using bf16=__hip_bfloat16;
using bf16x8=__attribute__((ext_vector_type(8)))short;
using s16x4=__attribute__((ext_vector_type(4)))short;
using f32x16=__attribute__((ext_vector_type(16)))float;
using u32x4=__attribute__((ext_vector_type(4)))unsigned;
constexpr int D=64,DM=1024,DMO=2048;
constexpr int NW=8,NMAIN=4,QBLK=32,QB=QBLK*NMAIN,KVBLK=64;
constexpr int ATTN_PITCH=DM, ATTN_UNIT_ROWS=QB;
__device__ __forceinline__ int crow(int r,int hi){return (r&3)+8*(r>>2)+4*hi;}
#define SBAR() __builtin_amdgcn_sched_barrier(0)

constexpr int NSLOT=3, SLOTB=8192;
constexpr int NVSLOT=4, VSLOTB=16384;
constexpr int LDS_K=0, LDS_V=NSLOT*SLOTB, LDS_P=LDS_V+NVSLOT*VSLOTB, LDS_WS=LDS_P+2*16384, LDS_FLAG=LDS_WS+NW*64*4, LDS_OST=LDS_P, LDS_BYTES=LDS_FLAG+64;
constexpr float C2=0.125f*1.4426950408889634f;
__device__ __forceinline__ void glds16(const void*gsrc,unsigned lds_dst){unsigned keep;
  asm volatile("s_mov_b32 %0, m0\n\ts_mov_b32 m0, %2\n\ts_nop 0\n\tglobal_load_lds_dwordx4 %1, off\n\ts_mov_b32 m0, %0":"=&s"(keep):"v"(gsrc),"s"(lds_dst):"memory");}
__device__ __forceinline__ float max3f(float a,float b,float c){float r;asm("v_max3_f32 %0, %1, %2, %3":"=v"(r):"v"(a),"v"(b),"v"(c));return r;}
__device__ __forceinline__ float max2f(float a,float b){float r;asm("v_max_f32_e32 %0, %1, %2":"=v"(r):"v"(a),"v"(b));return r;}
__device__ __forceinline__ float fadd_s(float a,float b){float r;asm("v_add_f32_e32 %0, %1, %2":"=v"(r):"v"(a),"v"(b));return r;}
__device__ __forceinline__ float fsub_s(float a,float b){float r;asm("v_sub_f32_e32 %0, %1, %2":"=v"(r):"v"(a),"v"(b));return r;}
typedef float f32x2_t __attribute__((ext_vector_type(2))); typedef __bf16 bf16x2_t __attribute__((ext_vector_type(2)));
__device__ __forceinline__ unsigned cvtpk_s(float lo,float hi){f32x2_t v={lo,hi};bf16x2_t b=__builtin_convertvector(v,bf16x2_t);return __builtin_bit_cast(unsigned,b);}
#define WAIT_BAR(N) asm volatile("s_waitcnt vmcnt(" #N ") lgkmcnt(0)\n\ts_barrier":::"memory")

__device__ __forceinline__ void qkt(f32x16&p0,f32x16&p1,const char*Kslot,const bf16x8*qr,const f32x16&negm,int r32,int hi){
  const char*kb=Kslot+hi*1024+r32*16;
  #pragma unroll
  for(int d0=0;d0<4;++d0){
    const bf16x8 b0=*reinterpret_cast<const bf16x8*>(kb+d0*2048);
    const bf16x8 b1=*reinterpret_cast<const bf16x8*>(kb+d0*2048+512);
    if(d0==0){p0=__builtin_amdgcn_mfma_f32_32x32x16_bf16(b0,qr[0],negm,0,0,0);p1=__builtin_amdgcn_mfma_f32_32x32x16_bf16(b1,qr[0],negm,0,0,0);}
    else{p0=__builtin_amdgcn_mfma_f32_32x32x16_bf16(b0,qr[d0],p0,0,0,0);p1=__builtin_amdgcn_mfma_f32_32x32x16_bf16(b1,qr[d0],p1,0,0,0);}}
}
typedef __attribute__((address_space(3))) const char* lds_cptr;
typedef short v4i16_t __attribute__((ext_vector_type(4)));
__device__ __forceinline__ void kload8(bf16x8*kf,lds_cptr kp){
  kf[0]=*(const __attribute__((address_space(3))) bf16x8*)(kp);      kf[1]=*(const __attribute__((address_space(3))) bf16x8*)(kp+512);
  kf[2]=*(const __attribute__((address_space(3))) bf16x8*)(kp+2048); kf[3]=*(const __attribute__((address_space(3))) bf16x8*)(kp+2560);
  kf[4]=*(const __attribute__((address_space(3))) bf16x8*)(kp+4096); kf[5]=*(const __attribute__((address_space(3))) bf16x8*)(kp+4608);
  kf[6]=*(const __attribute__((address_space(3))) bf16x8*)(kp+6144); kf[7]=*(const __attribute__((address_space(3))) bf16x8*)(kp+6656);
}
__device__ __forceinline__ void kload2(bf16x8*kf,lds_cptr kp,int j){ kf[2*j]=*(const __attribute__((address_space(3))) bf16x8*)(kp+j*2048); kf[2*j+1]=*(const __attribute__((address_space(3))) bf16x8*)(kp+j*2048+512); }
__device__ __forceinline__ s16x4 vtr(lds_cptr p){ return __builtin_bit_cast(s16x4,__builtin_amdgcn_ds_read_tr16_b64_v4i16((__attribute__((address_space(3))) v4i16_t*)p)); }
__device__ __forceinline__ float rowmax(const f32x16&p0,const f32x16&p1){
  float a=max3f(p0[0],p0[1],p1[0]),b=max3f(p0[2],p0[3],p1[1]);a=max3f(a,p1[2],p1[3]);
  #pragma unroll
  for(int r=4;r<16;r+=4){a=max3f(a,p0[r],p0[r+1]);b=max3f(b,p0[r+2],p0[r+3]);a=max3f(a,p1[r],p1[r+1]);b=max3f(b,p1[r+2],p1[r+3]);}
  const float m=max2f(a,b);
  auto rr=__builtin_amdgcn_permlane32_swap(__float_as_uint(m),__float_as_uint(m),false,false);
  return max2f(__uint_as_float(rr[0]),__uint_as_float(rr[1]));
}
__device__ __forceinline__ void pv(f32x16*o,int vb,bf16x8 pa0,bf16x8 pa1,bf16x8 pa2,bf16x8 pa3){
  #pragma unroll
  for(int d0=0;d0<2;++d0){s16x4 lo[4],hi[4];
    #pragma unroll
    for(int ks=0;ks<4;++ks){
      asm volatile("ds_read_b64_tr_b16 %0,%1 offset:%c2":"=&v"(lo[ks]):"v"(vb),"i"(d0*4096+ks*1024):"memory");
      asm volatile("ds_read_b64_tr_b16 %0,%1 offset:%c2":"=&v"(hi[ks]):"v"(vb),"i"(d0*4096+ks*1024+512):"memory");}
    asm volatile("s_waitcnt lgkmcnt(0)":::"memory");SBAR();
    #define PK(k) (bf16x8){lo[k][0],lo[k][1],lo[k][2],lo[k][3],hi[k][0],hi[k][1],hi[k][2],hi[k][3]}
    o[d0]=__builtin_amdgcn_mfma_f32_32x32x16_bf16(pa0,PK(0),o[d0],0,0,0);
    o[d0]=__builtin_amdgcn_mfma_f32_32x32x16_bf16(pa1,PK(1),o[d0],0,0,0);
    o[d0]=__builtin_amdgcn_mfma_f32_32x32x16_bf16(pa2,PK(2),o[d0],0,0,0);
    o[d0]=__builtin_amdgcn_mfma_f32_32x32x16_bf16(pa3,PK(3),o[d0],0,0,0);
    #undef PK
  }
}

#ifndef ATTN_STORE16
#define ATTN_STORE16(p,v) (*(__attribute__((address_space(1))) u32x4*)(p)=(v))
#endif
template<int THRL> __device__ __forceinline__ void attn_unit(const bf16*Qu,const bf16*__restrict__ Kh,const bf16*__restrict__ Vh,bf16*Ou,const int NT,char*shm){
  const int tid=threadIdx.x,lane=tid&63,r32=lane&31,hi=lane>>5; const int wid=__builtin_amdgcn_readfirstlane(tid>>6);
  const int pw_=wid&3;
  const bf16*Qw=Qu+(long)(pw_*QBLK)*DM;
  const unsigned lds0=(unsigned)(uintptr_t)shm;
  float*wsf=(float*)(shm+LDS_WS)+pw_*128;
  volatile __attribute__((address_space(3))) int*flagp=(volatile __attribute__((address_space(3))) int*)(shm+LDS_FLAG)+pw_;
  char*pbuf=shm+LDS_P+pw_*4096+lane*16;
  const bf16*ksrc=Kh+(long)lane*DM+wid*8;
  const bf16*vsrc=Vh+(long)(16*(wid&3)+(lane>>2))*DM+(wid>>2)*32+(lane&3)*8;
  const unsigned kdst=lds0+LDS_K+wid*1024, vdst=lds0+LDS_V+wid*1024;
  #define DMA_K(t,slot) glds16(ksrc+(long)(t)*KVBLK*DM,(unsigned)__builtin_amdgcn_readfirstlane(kdst+(slot)))
  #define DMA_V(t,slot) do{ glds16(vsrc+(long)(t)*KVBLK*DM,(unsigned)__builtin_amdgcn_readfirstlane(vdst+((t)&3)*VSLOTB)); glds16(vsrc+64+(long)(t)*KVBLK*DM,(unsigned)__builtin_amdgcn_readfirstlane(vdst+8192+((t)&3)*VSLOTB)); }while(0)
  const int vb0=(int)(lds0+LDS_V)+((lane>>4)&1)*32+(lane&3)*8+(4*hi+((lane&15)>>2))*64;
  const char*Kbase=shm+LDS_K; bf16x8 kf[8];
  const lds_cptr shm3=(lds_cptr)shm; const lds_cptr kp0=shm3+LDS_K+hi*1024+r32*16; const lds_cptr vp0=shm3+LDS_V+((lane>>4)&1)*32+(lane&3)*8+(4*hi+((lane&15)>>2))*64;
  DMA_K(0,0);DMA_V(0,0);DMA_K(1,SLOTB);
  int sl_prev=0,sl_cur=0,sl_next=SLOTB;
  #define ROT() do{sl_prev=sl_cur;sl_cur=sl_next;sl_next=(sl_next==(NSLOT-1)*SLOTB)?0:sl_next+SLOTB;}while(0)
  #define MIDBAR() asm volatile("s_waitcnt lgkmcnt(0)\n\ts_barrier":::"memory")
  #define ENDW(tt) do{ if((tt)+3<NT){WAIT_BAR(3);} else if((tt)+2<NT){WAIT_BAR(2);} else {WAIT_BAR(0);} }while(0)
  typedef __attribute__((address_space(3))) char* lds_ptr;
  const lds_ptr pb3=(lds_ptr)(pbuf);
  if(wid<NMAIN){
  __builtin_amdgcn_s_setprio(2);
  bf16x8 qr[4];
  #pragma unroll
  for(int d0=0;d0<4;++d0)qr[d0]=*(const __attribute__((address_space(1))) bf16x8*)(&Qw[(long)r32*DM+d0*16+hi*8]);
  float mhat=0.f,l_reg=0.f;f32x16 negm=f32x16{};asm volatile("":"+v"(negm));
  #define CMASK(P0,P1,t) do{}while(0)
  bool resc=false;
  #define START(P0,P1) do{ const float rm=rowmax(P0,P1); resc=false; \
    { const float dl=rm; mhat=fadd_s(mhat,dl); \
      _Pragma("unroll") for(int r=0;r<16;++r){P0[r]=fsub_s(P0[r],dl);P1[r]=fsub_s(P1[r],dl);} \
      _Pragma("unroll") for(int r=0;r<16;++r)negm[r]=-mhat; asm volatile("":"+v"(negm)); } \
    _Pragma("unroll") for(int r=0;r<16;++r)P0[r]=__builtin_amdgcn_exp2f(P0[r]); }while(0)
  #define RESC(par) do{}while(0)
  f32x16 pA0,pA1,pB0,pB1;
  DMA_K(2,2*SLOTB);
  WAIT_BAR(4);
  qkt(pA0,pA1,Kbase,qr,negm,r32,hi);asm volatile("s_nop 15\n\ts_nop 7":"+v"(pA0),"+v"(pA1));CMASK(pA0,pA1,0);
  START(pA0,pA1);
  _Pragma("unroll") for(int r=0;r<16;++r)pA1[r]=__builtin_amdgcn_exp2f(pA1[r]);
  WAIT_BAR(0);
  DMA_K(3,0);DMA_V(1,SLOTB);
  ROT();
  kload8(kf,kp0+sl_cur);
  WAIT_BAR(3);
  u32x4 pw0,pw1,pw2,pw3;
  #define PKW(P,B) cvtpk_s(P[B],P[B+1])
  #define PAF(k) __builtin_bit_cast(bf16x8,pw##k)
  #define VFR(i) (bf16x8){vlo[i][0],vlo[i][1],vlo[i][2],vlo[i][3],vhi[i][0],vhi[i][1],vhi[i][2],vhi[i][3]}
  #define PIN(x) asm volatile("":"+v"(x))
  #define MX3(a,b,c) __builtin_fmaxf(__builtin_fmaxf((a),(b)),(c))
  #define GAPA(MF,A0,A1,A2,A3,W0,W1,PW) do{ MF; sacc+=A0; sacc+=A1; sacc+=A2; sacc+=A3; PIN(sacc); W0; W1; PIN(PW); SBAR(); }while(0)
  #define EX(v) __builtin_amdgcn_exp2f(v)
  #define GAPB(X,B) do{ X[B]=EX(X[B]); X[B+1]=EX(X[B+1]); X[B+2]=EX(X[B+2]); X[B+3]=EX(X[B+3]); PIN(X); SBAR(); }while(0)
  #define VRD(i) do{ vlo[i]=vtr(vp_+(((i)>>2)*4096+((i)&3)*1024)); vhi[i]=vtr(vp_+(((i)>>2)*4096+((i)&3)*1024+512)); }while(0)
  #define KRD(G,j) do{ if(G){ kload2(kf,kp0+sl_next,j); SBAR(); } }while(0)
  #define STEP(C0,C1,P0,P1,t,GK,GV,GL) do{ SBAR(); \
    float sacc=(P0[0]+P0[1]); \
    GAPA(C0=__builtin_amdgcn_mfma_f32_32x32x16_bf16(kf[0],qr[0],negm,0,0,0), P0[2],P0[3],P0[4],P0[5],     pw0[0]=PKW(P0,0), pw0[1]=PKW(P0,2), pw0); \
    GAPA(C1=__builtin_amdgcn_mfma_f32_32x32x16_bf16(kf[1],qr[0],negm,0,0,0), P0[6],P0[7],P0[8],P0[9],     pw0[2]=PKW(P0,4), pw0[3]=PKW(P0,6), pw0); \
    GAPA(C0=__builtin_amdgcn_mfma_f32_32x32x16_bf16(kf[2],qr[1],C0,0,0,0),   P0[10],P0[11],P0[12],P0[13], pw1[0]=PKW(P0,8), pw1[1]=PKW(P0,10), pw1); \
    GAPA(C1=__builtin_amdgcn_mfma_f32_32x32x16_bf16(kf[3],qr[1],C1,0,0,0),   P0[14],P0[15],P1[0],P1[1],   pw1[2]=PKW(P0,12),pw1[3]=PKW(P0,14), pw1); \
    GAPA(C0=__builtin_amdgcn_mfma_f32_32x32x16_bf16(kf[4],qr[2],C0,0,0,0),   P1[2],P1[3],P1[4],P1[5],     pw2[0]=PKW(P1,0), pw2[1]=PKW(P1,2), pw2); \
    GAPA(C1=__builtin_amdgcn_mfma_f32_32x32x16_bf16(kf[5],qr[2],C1,0,0,0),   P1[6],P1[7],P1[8],P1[9],     pw2[2]=PKW(P1,4), pw2[3]=PKW(P1,6), pw2); \
    GAPA(C0=__builtin_amdgcn_mfma_f32_32x32x16_bf16(kf[6],qr[3],C0,0,0,0),   P1[10],P1[11],P1[12],P1[13], pw3[0]=PKW(P1,8), pw3[1]=PKW(P1,10), pw3); \
    GAPA(C1=__builtin_amdgcn_mfma_f32_32x32x16_bf16(kf[7],qr[3],C1,0,0,0),   P1[14],P1[15],0.f,0.f,       pw3[2]=PKW(P1,12),pw3[3]=PKW(P1,14), pw3); \
    l_reg+=sacc; \
    { const lds_ptr pq_=pb3+(((t)-1)&1)*16384; *(__attribute__((address_space(3))) u32x4*)(pq_)=pw0; *(__attribute__((address_space(3))) u32x4*)(pq_+1024)=pw1; *(__attribute__((address_space(3))) u32x4*)(pq_+2048)=pw2; *(__attribute__((address_space(3))) u32x4*)(pq_+3072)=pw3; } \
    if(GK){DMA_K((t)+3,sl_cur);} if(GV){DMA_V((t)+1,sl_next);} \
    CMASK(C0,C1,t); \
    { float a=MX3(C0[0],C0[1],C1[0]),b=MX3(C0[2],C0[3],C1[1]); a=MX3(a,C1[2],C1[3]); \
      _Pragma("unroll") for(int r=4;r<16;r+=4){a=MX3(a,C0[r],C0[r+1]);b=MX3(b,C0[r+2],C0[r+3]);a=MX3(a,C1[r],C1[r+1]);b=MX3(b,C1[r+2],C1[r+3]);} \
      float rm=__builtin_fmaxf(a,b); { auto rr=__builtin_amdgcn_permlane32_swap(__float_as_uint(rm),__float_as_uint(rm),false,false); rm=__builtin_fmaxf(__uint_as_float(rr[0]),__uint_as_float(rr[1])); } \
      resc=false; \
      if(__builtin_expect(__any(rm>(float)THRL),0)){ const float dl=__builtin_fmaxf(rm,0.f); mhat+=dl; \
        _Pragma("unroll") for(int r=0;r<16;++r){C0[r]-=dl;C1[r]-=dl;} \
        _Pragma("unroll") for(int r=0;r<16;++r)negm[r]=-mhat; asm volatile("":"+v"(negm)); \
        const float f=__builtin_amdgcn_exp2f(-dl); l_reg*=f; if(hi==0)wsf[((t)&1)*32+r32]=f; resc=true; } } \
    if(lane==0)flagp[((t)&1)*4]=resc?1:0;     \
    SBAR(); \
    GAPB(C0,0); \
    GAPB(C0,4); \
    KRD(GL,0); GAPB(C0,8); \
    KRD(GL,1); GAPB(C0,12); \
    KRD(GL,2); GAPB(C1,0); \
    KRD(GL,3); GAPB(C1,4); \
    GAPB(C1,8); \
    GAPB(C1,12); \
    }while(0)
  int t=1;
  for(;t+5<NT;t+=2){
    STEP(pB0,pB1,pA0,pA1,t,true,true,true);     WAIT_BAR(3); RESC(1); ROT();
    STEP(pA0,pA1,pB0,pB1,t+1,true,true,true);   WAIT_BAR(3); RESC(0); ROT();
  }
  for(;t+1<NT;t+=2){
    STEP(pB0,pB1,pA0,pA1,t,(t+3<NT),(t+1<NT),(t+1<NT));       ENDW(t);   RESC(1); ROT();
    STEP(pA0,pA1,pB0,pB1,t+1,(t+4<NT),(t+2<NT),(t+2<NT));     ENDW(t+1); RESC(0); ROT();
  }
  STEP(pB0,pB1,pA0,pA1,NT-1,false,false,false); WAIT_BAR(0);
  { float sacc=pB0[0]+pB0[1]; _Pragma("unroll") for(int r=2;r<16;++r)sacc+=pB0[r]; _Pragma("unroll") for(int r=0;r<16;++r)sacc+=pB1[r]; l_reg+=sacc;
    pw0=(u32x4){PKW(pB0,0),PKW(pB0,2),PKW(pB0,4),PKW(pB0,6)};pw1=(u32x4){PKW(pB0,8),PKW(pB0,10),PKW(pB0,12),PKW(pB0,14)};pw2=(u32x4){PKW(pB1,0),PKW(pB1,2),PKW(pB1,4),PKW(pB1,6)};pw3=(u32x4){PKW(pB1,8),PKW(pB1,10),PKW(pB1,12),PKW(pB1,14)};
    { const lds_ptr pq_=pb3+((NT-1)&1)*16384; *(__attribute__((address_space(3))) u32x4*)(pq_)=pw0; *(__attribute__((address_space(3))) u32x4*)(pq_+1024)=pw1; *(__attribute__((address_space(3))) u32x4*)(pq_+2048)=pw2; *(__attribute__((address_space(3))) u32x4*)(pq_+3072)=pw3; } }
  #undef PKW
  #undef PAF
  #undef VFR
  #undef PIN
  #undef MX3
  #undef GAPA
  #undef GAPB
  #undef EX
  #undef VRD
  #undef KRD
  #undef STEP
  {auto rr=__builtin_amdgcn_permlane32_swap(__float_as_uint(l_reg),__float_as_uint(l_reg),false,false);l_reg=__uint_as_float(rr[0])+__uint_as_float(rr[1]);}
  if(hi==0)wsf[64+r32]=l_reg;asm volatile("s_waitcnt lgkmcnt(0)\n\ts_barrier":::"memory");
  __builtin_amdgcn_s_setprio(0);
  }else{
    f32x16 o2[4];o2[0]=f32x16{};o2[1]=f32x16{};o2[2]=f32x16{};o2[3]=f32x16{};
    const lds_cptr vq0=vp0;
    DMA_K(2,2*SLOTB);
    WAIT_BAR(4);
    WAIT_BAR(0);
    DMA_K(3,0);DMA_V(1,SLOTB);
    ROT();
    WAIT_BAR(3);
    #define HVF(i) (bf16x8){hl[i][0],hl[i][1],hl[i][2],hl[i][3],hh[i][0],hh[i][1],hh[i][2],hh[i][3]}
    #define HIT(j,RS) do{ const int j_=(j); const lds_cptr vp_=vq0+((j_-1)&3)*VSLOTB; const lds_ptr pq_=pb3+((j_-1)&1)*16384; s16x4 hl[16],hh[16]; \
      _Pragma("unroll") for(int i=0;i<16;++i){ hl[i]=vtr(vp_+((i>>2)*4096+(i&3)*1024)); hh[i]=vtr(vp_+((i>>2)*4096+(i&3)*1024+512)); } \
      const bf16x8 pa0=*(const __attribute__((address_space(3))) bf16x8*)(pq_),pa1=*(const __attribute__((address_space(3))) bf16x8*)(pq_+1024),pa2=*(const __attribute__((address_space(3))) bf16x8*)(pq_+2048),pa3=*(const __attribute__((address_space(3))) bf16x8*)(pq_+3072); \
      o2[0]=__builtin_amdgcn_mfma_f32_32x32x16_bf16(pa0,HVF(0),o2[0],0,0,0); o2[1]=__builtin_amdgcn_mfma_f32_32x32x16_bf16(pa0,HVF(4),o2[1],0,0,0); o2[2]=__builtin_amdgcn_mfma_f32_32x32x16_bf16(pa0,HVF(8),o2[2],0,0,0); o2[3]=__builtin_amdgcn_mfma_f32_32x32x16_bf16(pa0,HVF(12),o2[3],0,0,0); o2[0]=__builtin_amdgcn_mfma_f32_32x32x16_bf16(pa1,HVF(1),o2[0],0,0,0); o2[1]=__builtin_amdgcn_mfma_f32_32x32x16_bf16(pa1,HVF(5),o2[1],0,0,0); o2[2]=__builtin_amdgcn_mfma_f32_32x32x16_bf16(pa1,HVF(9),o2[2],0,0,0); o2[3]=__builtin_amdgcn_mfma_f32_32x32x16_bf16(pa1,HVF(13),o2[3],0,0,0); o2[0]=__builtin_amdgcn_mfma_f32_32x32x16_bf16(pa2,HVF(2),o2[0],0,0,0); o2[1]=__builtin_amdgcn_mfma_f32_32x32x16_bf16(pa2,HVF(6),o2[1],0,0,0); o2[2]=__builtin_amdgcn_mfma_f32_32x32x16_bf16(pa2,HVF(10),o2[2],0,0,0); o2[3]=__builtin_amdgcn_mfma_f32_32x32x16_bf16(pa2,HVF(14),o2[3],0,0,0); o2[0]=__builtin_amdgcn_mfma_f32_32x32x16_bf16(pa3,HVF(3),o2[0],0,0,0); o2[1]=__builtin_amdgcn_mfma_f32_32x32x16_bf16(pa3,HVF(7),o2[1],0,0,0); o2[2]=__builtin_amdgcn_mfma_f32_32x32x16_bf16(pa3,HVF(11),o2[2],0,0,0); o2[3]=__builtin_amdgcn_mfma_f32_32x32x16_bf16(pa3,HVF(15),o2[3],0,0,0); \
      if(RS){ if(flagp[(j_&1)*4]){ _Pragma("unroll") for(int d_=0;d_<4;++d_) _Pragma("unroll") for(int r=0;r<16;++r)o2[d_][r]*=wsf[(j_&1)*32+crow(r,hi)]; } } }while(0)
    for(int t=1;t<=NT-2;++t){
      if(t+3<NT){DMA_K(t+3,sl_cur);} DMA_V(t+1,0);
      if(t>=2){ HIT(t-1,true); }
      ENDW(t); ROT();
    }
    HIT(NT-2,true);
    WAIT_BAR(0);
    HIT(NT-1,true);
    asm volatile("s_waitcnt lgkmcnt(0)\n\ts_barrier":::"memory");
    HIT(NT,false);
    #undef HIT
    float rli[16];
    #pragma unroll
    for(int r=0;r<16;++r)rli[r]=__builtin_amdgcn_rcpf(wsf[64+crow(r,hi)]);
    bf16*Ow=Ou+(long)(pw_*QBLK)*DMO;
    #pragma unroll
    for(int hf=0;hf<2;++hf){ bf16*stg=(bf16*)(shm+LDS_OST)+wid*2048;
      #pragma unroll
      for(int r=0;r<16;++r){const int orow=crow(r,hi);
        #pragma unroll
        for(int d0=0;d0<2;++d0)stg[orow*64+d0*32+r32]=__float2bfloat16(o2[2*hf+d0][r]*rli[r]);}
      asm volatile("s_waitcnt lgkmcnt(0)":::"memory");
      #pragma unroll
      for(int i=0;i<4;++i){const int row=i*8+(lane>>3),ch=lane&7; const u32x4 v=*(const u32x4*)(stg+row*64+ch*8); ATTN_STORE16(Ow+(long)row*DMO+hf*64+ch*8,v);}
      asm volatile("s_waitcnt lgkmcnt(0)":::"memory"); }
    #undef HVF
  }
  asm volatile("s_waitcnt lgkmcnt(0)\n\ts_barrier":::"memory");
  #undef DMA_K
  #undef DMA_V
  #undef CMASK
  #undef START
  #undef RESC
  #undef ROT
  #undef MIDBAR
  #undef ENDW
}
constexpr int ATTN_LDS_BYTES=LDS_BYTES;
#undef SBAR
#undef WAIT_BAR
}

constexpr int NWAVES = 8;
#ifndef DBG_LAST_PHASE
#define DBG_LAST_PHASE 25
#endif
constexpr int NPHASES = 26;

constexpr size_t MiB = 1u << 20;
constexpr size_t WS_CTL = 0, CTL_ZERO_BYTES = 1 * MiB;
constexpr size_t WS_MOD = 1 * MiB;
constexpr size_t WS_ROPE = 2 * MiB;
constexpr size_t WS_WIN = 3 * MiB;
constexpr size_t WS_WOUT = 6 * MiB;
constexpr size_t WS_WQKV = 8 * MiB;
constexpr size_t WS_WDAO = 14 * MiB;
constexpr size_t WS_SHUP = 16 * MiB;
constexpr size_t WS_SHDN = 18 * MiB;
constexpr size_t WS_WRT = 19 * MiB;
constexpr size_t WS_TABC = 19 * MiB + 512 * 1024;
constexpr size_t WS_BD = 20 * MiB;
constexpr size_t WS_LIST = 21 * MiB;
constexpr size_t WS_TOKSLOT = 29 * MiB + 512 * 1024;
constexpr size_t WS_TOKGATE = 30 * MiB + 768 * 1024;
constexpr size_t WS_CTXRES = 32 * MiB;
constexpr size_t WS_WEDN = 40 * MiB;
constexpr size_t WS_WEUP = 72 * MiB;
constexpr size_t WS_HX = 136 * MiB;
constexpr size_t WS_HID = 204 * MiB;
constexpr size_t WS_YEXP = 272 * MiB;
constexpr size_t WS_END = 542 * MiB;
constexpr size_t WS_TAB = 204 * MiB;
constexpr size_t WS_AGLU = 236 * MiB;
constexpr size_t WS_FT = 272 * MiB;
constexpr size_t WS_FTC = 304 * MiB;
constexpr size_t WS_FF = 306 * MiB;
constexpr size_t WS_MIX = 374 * MiB;
constexpr size_t WS_Y = 442 * MiB;
constexpr size_t WS_TOKLO = 272 * MiB;
constexpr size_t WS_Q = 204 * MiB;
constexpr size_t WS_OC = 272 * MiB;
constexpr size_t WS_KALL = 400 * MiB;
constexpr size_t WS_VALL = 468 * MiB;
constexpr size_t WS_Y1 = 400 * MiB;
static_assert(WS_LIST + (size_t)NCH * 64 * CAP * 4 <= WS_TOKSLOT && WS_TOKSLOT + (size_t)T0 * 32 <= WS_TOKGATE && WS_TOKGATE + (size_t)T0 * 32 <= WS_CTXRES, "lists");
constexpr int CW_TMO = 0, CW_CODE = 1, CW_BAR = 4096, CW_CNT = 16384, CNT_STRIDE = 64;

constexpr int RING_OFF = 0, RING_BYTES = 131072;
constexpr int LDSCTL_OFF = RING_BYTES, MISC_OFF = LDSCTL_OFF + 320, INPTR_OFF = LDSCTL_OFF + 512, TBL_OFF = LDSCTL_OFF + 1024;
constexpr int LDS_BYTES = 147456;

#define GAS __attribute__((address_space(1)))
#define LAS __attribute__((address_space(3)))
typedef unsigned short bf16;
typedef unsigned v4u __attribute__((ext_vector_type(4)));
typedef unsigned v2u __attribute__((ext_vector_type(2)));
typedef float f32x4 __attribute__((ext_vector_type(4)));
typedef short bf16x8 __attribute__((ext_vector_type(8)));
typedef GAS unsigned gu32;
#define RLX_AGENT __ATOMIC_RELAXED, __HIP_MEMORY_SCOPE_AGENT
#define LDS_WAIT() asm volatile("s_waitcnt lgkmcnt(0)" ::: "memory")
#define VM_WAIT() asm volatile("s_waitcnt vmcnt(0)" ::: "memory")
__device__ __forceinline__ unsigned f2bf(float f) { unsigned u = __builtin_bit_cast(unsigned, f); return (u + 0x7fffu + ((u >> 16) & 1u)) >> 16; }
__device__ __forceinline__ float bf2f(unsigned b) { return __builtin_bit_cast(float, b << 16); }
__device__ __forceinline__ unsigned pk2(float lo, float hi) { return f2bf(lo) | (f2bf(hi) << 16); }

#define XB_TMO      128
#define XB_XCNT(j)  (256  + 64 * (j))
#define XB_XSUB(j)  (1280 + 64 * (j))
#define XB_XGEN(j)  (2304 + 64 * (j))
#define XB_TOP      3328
#define XB_TOPGEN   3392
#define XCD_BAR_WORDS 3456
#define XB_SPIN_CAP (1u << 18)

__device__ __forceinline__ unsigned xb_ld(unsigned* p)              { return __hip_atomic_load(p, __ATOMIC_RELAXED, __HIP_MEMORY_SCOPE_AGENT); }
__device__ __forceinline__ unsigned xb_add(unsigned* p, unsigned v) { return __hip_atomic_fetch_add(p, v, __ATOMIC_RELAXED, __HIP_MEMORY_SCOPE_AGENT); }
__device__ __forceinline__ unsigned xb_xcc_id() { return (unsigned)__builtin_amdgcn_s_getreg((3 << 11) | 20) & 0xFu; }
#define XB_SPIN(cond, bar) do { unsigned _sp = 0; while (cond) { __builtin_amdgcn_s_sleep(1); \
    if ((++_sp & 255u) == 0u) { if (xb_ld(&(bar)[XB_TMO])) break; if (_sp > XB_SPIN_CAP) { atomicAdd(&(bar)[XB_TMO], 1u); break; } } } } while (0)

struct XcdBarrier {
    unsigned* bar; unsigned x;
    volatile LAS unsigned* st;
};

__device__ __forceinline__ XcdBarrier xcd_barrier_post(unsigned* bar, volatile LAS unsigned* st) {
    XcdBarrier b; b.bar = bar; b.x = xb_xcc_id(); b.st = st;
    if (threadIdx.x == 0) (void)xb_add(&bar[XB_XCNT(b.x)], 1u);
    return b;
}
__device__ __forceinline__ void xcd_barrier_complete(unsigned* bar, unsigned x, unsigned& nloc, unsigned& nx) {
    const unsigned G = gridDim.x * gridDim.y * gridDim.z;
    unsigned sum, cnt, mine, sp = 0u;
    for (;;) {
        sum = 0u; cnt = 0u; mine = 0u;
#pragma unroll
        for (unsigned j = 0; j < 16; ++j) { const unsigned c = xb_ld(&bar[XB_XCNT(j)]); sum += c; cnt += (c > 0u) ? 1u : 0u; mine = (j == x) ? c : mine; }
        if (sum == G) break;
        __builtin_amdgcn_s_sleep(1);
        if ((++sp & 255u) == 0u) { if (xb_ld(&bar[XB_TMO])) break; if (sp > XB_SPIN_CAP) { atomicAdd(&bar[XB_TMO], 1u); break; } }
    }
    nloc = mine > 0u ? mine : 1u; nx = cnt > 0u ? cnt : 1u;
}

__device__ __forceinline__ void xcd_barrier(const XcdBarrier& b) {
    asm volatile("s_waitcnt vmcnt(0)" ::: "memory");
    __syncthreads();
    if (threadIdx.x == 0) {
        unsigned* bar = b.bar;
        __builtin_amdgcn_s_waitcnt(0);
        unsigned nloc = b.st[0], nx = b.st[1];
        if (nloc == 0u) { xcd_barrier_complete(bar, b.x, nloc, nx); b.st[0] = nloc; b.st[1] = nx; }
        const unsigned old = xb_add(&bar[XB_XSUB(b.x)], 1u);
        const unsigned gen = old / nloc;
        if (old + 1u == (gen + 1u) * nloc) {
            __builtin_amdgcn_fence(__ATOMIC_RELEASE, "agent");
            asm volatile("s_waitcnt vmcnt(0)" ::: "memory");
            const unsigned og = xb_add(&bar[XB_TOP], 1u);
            const unsigned tg = og / nx;
            if (og + 1u == (tg + 1u) * nx) xb_add(&bar[XB_TOPGEN], 1u);
            else XB_SPIN(xb_ld(&bar[XB_TOPGEN]) == tg, bar);
            __builtin_amdgcn_fence(__ATOMIC_ACQUIRE, "agent");
            xb_add(&bar[XB_XGEN(b.x)], 1u);
            asm volatile("s_waitcnt vmcnt(0)" ::: "memory");
        } else {
            XB_SPIN(xb_ld(&bar[XB_XGEN(b.x)]) == gen, bar);
            __builtin_amdgcn_fence(__ATOMIC_ACQUIRE, "agent");
            asm volatile("s_waitcnt vmcnt(0)" ::: "memory");
        }
    }
    __syncthreads();
}

struct Frame {
    LAS unsigned char* lds;
    volatile LAS unsigned* MISC;
    gu32* ctl;
    unsigned char* ws;
    int tid, lane, wave, vcu, G;
    float* out;
};
template <class T> __device__ __forceinline__ T* wsp(const Frame& F, size_t off) { return (T*)(F.ws + off); }
enum { I_X = 0, I_C, I_CTX, I_CCTX, I_ADAW, I_ADAB, I_NORMG, I_WIN, I_CONVW, I_CONVB, I_LNG, I_LNB, I_WOUT, I_WQKV, I_LAMBDA, I_SUBLNG, I_DAWOUT, I_RTW, I_RTB, I_WGATE, I_WUP, I_WDOWN, I_SHG, I_SHU, I_SHD };
__device__ __forceinline__ const float* inp(const Frame& F, int i) { const LAS unsigned* t = (const LAS unsigned*)(F.lds + INPTR_OFF) + 2 * i;
    const unsigned lo = __builtin_amdgcn_readfirstlane(t[0]), hi = __builtin_amdgcn_readfirstlane(t[1]); return (const float*)(const GAS float*)(((unsigned long long)hi << 32) | lo); }
#define FENCE(F) do { int t_ = threadIdx.x; asm volatile("" : "+v"(t_)); F.tid = t_; F.lane = t_ & 63; F.wave = __builtin_amdgcn_readfirstlane(t_ >> 6); asm volatile("" : "+s"(F.ws), "+s"(F.out), "+s"(F.ctl) :: "memory"); F.ws = (unsigned char*)(GAS unsigned char*)F.ws; F.out = (float*)(GAS float*)F.out; } while (0)

__device__ __forceinline__ float wave_sum(float v) {
#pragma unroll
    for (int o = 1; o < 64; o <<= 1) v += __shfl_xor(v, o);
    return v;
}
__device__ __forceinline__ void ldrow_f32(const float* p, int lane, f32x4 (&v)[4]) { const GAS f32x4* q = (const GAS f32x4*)p + lane;
#pragma unroll
    for (int j = 0; j < 4; ++j) v[j] = q[64 * j]; }
__device__ __forceinline__ void ldrow_bf16(const bf16* p, int lane, f32x4 (&v)[4]) { const GAS v2u* q = (const GAS v2u*)p + lane;
#pragma unroll
    for (int j = 0; j < 4; ++j) { const v2u w = q[64 * j]; v[j] = (f32x4){bf2f(w.x & 0xffffu), bf2f(w.x >> 16), bf2f(w.y & 0xffffu), bf2f(w.y >> 16)}; } }
__device__ __forceinline__ void strow_f32(float* p, int lane, const f32x4 (&v)[4]) { GAS f32x4* q = (GAS f32x4*)p + lane;
#pragma unroll
    for (int j = 0; j < 4; ++j) q[64 * j] = v[j]; }
__device__ __forceinline__ void strow_bf16(bf16* p, int lane, const f32x4 (&v)[4]) { GAS v2u* q = (GAS v2u*)p + lane;
#pragma unroll
    for (int j = 0; j < 4; ++j) q[64 * j] = (v2u){pk2(v[j].x, v[j].y), pk2(v[j].z, v[j].w)}; }
__device__ __forceinline__ float rstd_of(const f32x4 (&v)[4]) { float s = 0.f;
#pragma unroll
    for (int j = 0; j < 4; ++j) s += (v[j].x * v[j].x + v[j].y * v[j].y) + (v[j].z * v[j].z + v[j].w * v[j].w);
    return rsqrtf(wave_sum(s) * (1.f / DM) + EPSN); }
__device__ __forceinline__ void modnorm(const f32x4 (&v)[4], float rstd, const float* g, const float* shift, const float* scale, int lane, f32x4 (&o)[4]) {
    f32x4 gg[4], sh[4], sc[4]; ldrow_f32(g, lane, gg); ldrow_f32(shift, lane, sh); ldrow_f32(scale, lane, sc);
#pragma unroll
    for (int j = 0; j < 4; ++j) o[j] = v[j] * rstd * gg[j] * (sc[j] + 1.f) + sh[j]; }
__device__ __forceinline__ const float* modp(const Frame& F, int layer, int rb, int j) { return wsp<const float>(F, WS_MOD) + ((size_t)(layer * 9 + rb) * 6 + j) * 1024; }
__device__ __forceinline__ int rowbatch(int row) { return row < TL ? row / SEQ : 8; }

__device__ __forceinline__ int maprow(int mode, int n) {
    if (mode == 1) { if (n < 512) return 256 * (n >> 7) + (n & 127); if (n < 1024) { const int q = n - 512; return 256 * (q >> 7) + 128 + (q & 127); } return n; }
    if (mode == 2) { if (n < 2048) { const int blk = n >> 10, q = n & 1023, h = q >> 7, comp = (q >> 6) & 1, d = q & 63, bj = d >> 5, dd = d & 31, g = (h & 1) * 2 + comp; return blk * 1024 + 256 * (h >> 1) + 128 * bj + 32 * g + dd; } return n; }
    if (mode == 3) return 256 * (n >> 7) + (n & 127);
    if (mode == 4) return 256 * (n >> 7) + 128 + (n & 127);
    return n;
}
__device__ __forceinline__ void p0_transpose_item(const float* W, int K, int N, bf16* WT, int mode, LAS float* scr, int item, int lane) {
    const int nblk = N / 32, kb = item / nblk, nb = item % nblk, k0 = 64 * kb, n0 = 32 * nb;
#pragma unroll 8
    for (int i = 0; i < 32; ++i) { const int kk = 2 * i + (lane >> 5); scr[kk * 33 + (lane & 31)] = ((const GAS float*)W)[(size_t)(k0 + kk) * N + n0 + (lane & 31)]; }
    LDS_WAIT(); asm volatile("" ::: "memory");
    const int c = lane & 7;
#pragma unroll
    for (int j = 0; j < 4; ++j) { const int n = (lane >> 3) + 8 * j; const LAS float* s = scr + (8 * c) * 33 + n;
        v4u o; o.x = pk2(s[0 * 33], s[1 * 33]); o.y = pk2(s[2 * 33], s[3 * 33]); o.z = pk2(s[4 * 33], s[5 * 33]); o.w = pk2(s[6 * 33], s[7 * 33]);
        *(GAS v4u*)(WT + (size_t)maprow(mode, n0 + n) * K + k0 + 8 * c) = o; }
    LDS_WAIT(); asm volatile("" ::: "memory");
}
__device__ __forceinline__ void p0_router_item(const float* W, bf16* HI, bf16* LO, LAS float* scr, int item, int lane) {
    const int kb = item >> 1, nb = item & 1, k0 = 64 * kb, n0 = 32 * nb;
#pragma unroll 8
    for (int i = 0; i < 32; ++i) { const int kk = 2 * i + (lane >> 5); scr[kk * 33 + (lane & 31)] = ((const GAS float*)W)[(size_t)(k0 + kk) * 64 + n0 + (lane & 31)]; }
    LDS_WAIT(); asm volatile("" ::: "memory");
    const int c = lane & 7;
#pragma unroll
    for (int j = 0; j < 4; ++j) { const int n = (lane >> 3) + 8 * j; const LAS float* s = scr + (8 * c) * 33 + n;
        unsigned h[8], l[8];
#pragma unroll
        for (int q = 0; q < 8; ++q) { const float w = s[q * 33]; h[q] = f2bf(w); l[q] = f2bf(w - bf2f(h[q])); }
        v4u oh, ol; oh.x = h[0] | (h[1] << 16); oh.y = h[2] | (h[3] << 16); oh.z = h[4] | (h[5] << 16); oh.w = h[6] | (h[7] << 16);
        ol.x = l[0] | (l[1] << 16); ol.y = l[2] | (l[3] << 16); ol.z = l[4] | (l[5] << 16); ol.w = l[6] | (l[7] << 16);
        *(GAS v4u*)(HI + (size_t)(n0 + n) * 1024 + k0 + 8 * c) = oh; *(GAS v4u*)(LO + (size_t)(n0 + n) * 1024 + k0 + 8 * c) = ol; }
    LDS_WAIT(); asm volatile("" ::: "memory");
}
__device__ __forceinline__ void convert_experts(Frame& F, int layer) {
    LAS float* scr = (LAS float*)(F.lds + RING_OFF + F.wave * 16384);
    const int gw = F.vcu * NWAVES + F.wave, NGW = F.G * NWAVES;
    bf16* UP = wsp<bf16>(F, WS_WEUP); bf16* DN = wsp<bf16>(F, WS_WEDN);
    for (int it = gw; it < 64 * 384; it += NGW) {
        const int e = it / 384, r = it % 384; const size_t eo = (size_t)(layer * 64 + e) * 1024 * 256;
        if (r < 128) p0_transpose_item(inp(F, I_WGATE) + eo, 1024, 256, UP + (size_t)e * 512 * 1024, 3, scr, r, F.lane);
        else if (r < 256) p0_transpose_item(inp(F, I_WUP) + eo, 1024, 256, UP + (size_t)e * 512 * 1024, 4, scr, r - 128, F.lane);
        else p0_transpose_item(inp(F, I_WDOWN) + eo, 256, 1024, DN + (size_t)e * 1024 * 256, 0, scr, r - 256, F.lane);
    }
}
__device__ __forceinline__ float silu(float v) { return v / (1.f + __expf(-v)); }

__device__ __forceinline__ void p0_prologue(Frame& F) {
    __syncthreads();
#ifndef P0_PARTS
#define P0_PARTS 15
#endif
    if (P0_PARTS & 1)
    {
        LAS float* sc = (LAS float*)(F.lds);
        LAS float* part = (LAS float*)(F.lds + 40960);
        for (int i = F.tid; i < 9 * 1024; i += 512) { const int r = i >> 10, k = i & 1023; sc[i] = silu(r < 8 ? inp(F, I_C)[r * 1024 + k] : inp(F, I_CCTX)[k]); }
        __syncthreads();
        for (int item = F.vcu; item < 192; item += F.G) {
            const int layer = item / 96, col = (item % 96) * 64 + F.lane;
            const float* W = inp(F, I_ADAW) + (size_t)layer * 1024 * 6144 + col;
            float a[9];
#pragma unroll
            for (int r = 0; r < 9; ++r) a[r] = 0.f;
#pragma unroll 8
            for (int kk = 0; kk < 128; ++kk) { const int k = F.wave * 128 + kk; const float w = W[(size_t)k * 6144];
#pragma unroll
                for (int r = 0; r < 9; ++r) a[r] += sc[r * 1024 + k] * w; }
#pragma unroll
            for (int r = 0; r < 9; ++r) part[(F.wave * 9 + r) * 64 + F.lane] = a[r];
            __syncthreads();
            for (int i = F.tid; i < 576; i += 512) { const int r = i >> 6, l = i & 63; float s = 0.f;
#pragma unroll
                for (int w = 0; w < 8; ++w) s += part[(w * 9 + r) * 64 + l];
                const int cc = (item % 96) * 64 + l;
                wsp<float>(F, WS_MOD)[(size_t)(layer * 9 + r) * 6144 + cc] = s + inp(F, I_ADAB)[layer * 6144 + cc]; }
            __syncthreads();
        }
        __syncthreads();
    }
    LAS float* scr = (LAS float*)(F.lds + RING_OFF + F.wave * 16384);
    const int gw = F.vcu * NWAVES + F.wave, NGW = F.G * NWAVES;
    constexpr int NI_IN = 16 * 48, NI_OUT = 16 * 32, NI_QKV = 16 * 96, NI_DAO = 16 * 32, NI_SHG = 16 * 8, NI_SHD = 4 * 32, NI_RT = 32;
    constexpr int NI_TAB = 4096, NI_TABC = 256, NI_BD = 512, NI_ROPE = 2048;
    constexpr int NITEMS = NI_IN + NI_OUT + NI_QKV + NI_DAO + 4 * NI_SHG + 2 * NI_SHD + 2 * NI_RT + NI_TAB + NI_TABC + NI_BD + NI_ROPE;
#ifndef P0_IT_LO
#define P0_IT_LO 0
#define P0_IT_HI 1000000
#endif
    if (P0_PARTS & 2)
    for (int it = gw; it < NITEMS; it += NGW) {
        int r = it; if (it < P0_IT_LO || it >= P0_IT_HI) continue;
        if (r < NI_IN) { p0_transpose_item(inp(F, I_WIN), 1024, 1536, wsp<bf16>(F, WS_WIN), 1, scr, r, F.lane); continue; } r -= NI_IN;
        if (r < NI_OUT) { p0_transpose_item(inp(F, I_WOUT), 1024, 1024, wsp<bf16>(F, WS_WOUT), 0, scr, r, F.lane); continue; } r -= NI_OUT;
        if (r < NI_QKV) { p0_transpose_item(inp(F, I_WQKV), 1024, 3072, wsp<bf16>(F, WS_WQKV), 2, scr, r, F.lane); continue; } r -= NI_QKV;
        if (r < NI_DAO) { p0_transpose_item(inp(F, I_DAWOUT), 1024, 1024, wsp<bf16>(F, WS_WDAO), 0, scr, r, F.lane); continue; } r -= NI_DAO;
        if (r < 4 * NI_SHG) { const int l = r / (2 * NI_SHG), q = r % (2 * NI_SHG);
            if (q < NI_SHG) p0_transpose_item(inp(F, I_SHG) + (size_t)l * 1024 * 256, 1024, 256, wsp<bf16>(F, WS_SHUP) + (size_t)l * 512 * 1024, 3, scr, q, F.lane);
            else p0_transpose_item(inp(F, I_SHU) + (size_t)l * 1024 * 256, 1024, 256, wsp<bf16>(F, WS_SHUP) + (size_t)l * 512 * 1024, 4, scr, q - NI_SHG, F.lane);
            continue; } r -= 4 * NI_SHG;
        if (r < 2 * NI_SHD) { const int l = r / NI_SHD; p0_transpose_item(inp(F, I_SHD) + (size_t)l * 256 * 1024, 256, 1024, wsp<bf16>(F, WS_SHDN) + (size_t)l * 1024 * 256, 0, scr, r % NI_SHD, F.lane); continue; } r -= 2 * NI_SHD;
        if (r < 2 * NI_RT) { const int l = r / NI_RT; bf16* base = wsp<bf16>(F, WS_WRT) + (size_t)l * 2 * 64 * 1024; p0_router_item(inp(F, I_RTW) + (size_t)l * 1024 * 64, base, base + 64 * 1024, scr, r % NI_RT, F.lane); continue; } r -= 2 * NI_RT;
        if (r < NI_TAB) {
            const int kk = r <= 2048 ? r : r - 2048; bf16* row = wsp<bf16>(F, WS_TAB) + (size_t)r * 4096;
            for (int q = 0; q < 8; ++q) { const int l0 = q * 512 + F.lane * 8; unsigned h[8];
#pragma unroll
                for (int i = 0; i < 8; ++i) { const int idx = (kk * (l0 + i)) & 4095; float s, c; sincospif((float)idx * (1.f / 2048.f), &s, &c); h[i] = f2bf((r <= 2048 ? c : -s) * (1.f / 64.f)); }
                *(GAS v4u*)(row + l0) = (v4u){h[0] | (h[1] << 16), h[2] | (h[3] << 16), h[4] | (h[5] << 16), h[6] | (h[7] << 16)}; }
            continue; } r -= NI_TAB;
        if (r < NI_TABC) { const int kk = r <= 128 ? r : r - 128; bf16* row = wsp<bf16>(F, WS_TABC) + (size_t)r * 256; const int l0 = F.lane * 4; unsigned h[4];
#pragma unroll
            for (int i = 0; i < 4; ++i) { const int idx = (kk * (l0 + i)) & 255; float s, c; sincospif((float)idx * (1.f / 128.f), &s, &c); h[i] = f2bf((r <= 128 ? c : -s) * (1.f / 16.f)); }
            *(GAS v2u*)(row + l0) = (v2u){h[0] | (h[1] << 16), h[2] | (h[3] << 16)};
            continue; } r -= NI_TABC;
        if (r < NI_BD) { const int g = r >> 7, m = r & 127; bf16* row = wsp<bf16>(F, WS_BD) + (size_t)r * 1024; const int c0 = F.lane * 16; unsigned h[16];
#pragma unroll
            for (int i = 0; i < 16; ++i) { const int col = c0 + i, g2 = col >> 8, part = (col >> 7) & 1, cc = col & 127; const int idx = (m * cc) & 127; float s, c; sincospif((float)idx * (1.f / 64.f), &s, &c);
                h[i] = g2 == g ? f2bf((part ? s : c) * 0.08838834764831845f) : 0u; }
            *(GAS v4u*)(row + c0) = (v4u){h[0] | (h[1] << 16), h[2] | (h[3] << 16), h[4] | (h[5] << 16), h[6] | (h[7] << 16)};
            *(GAS v4u*)(row + c0 + 8) = (v4u){h[8] | (h[9] << 16), h[10] | (h[11] << 16), h[12] | (h[13] << 16), h[14] | (h[15] << 16)};
            continue; } r -= NI_BD;
        { const int s = r * 2 + (F.lane >> 5), dd = F.lane & 31, i = dd & 15; const float inv = powf(10000.f, -(float)i * (1.f / 16.f)); const float pos = (float)(dd < 16 ? s / 64 : s % 64); const float ang = pos * inv;
          wsp<float>(F, WS_ROPE)[s * 32 + dd] = cosf(ang); wsp<float>(F, WS_ROPE + 512 * 1024)[s * 32 + dd] = sinf(ang); }
    }
    if (P0_PARTS & 4) convert_experts(F, 0);
#if DBG_LAST_PHASE < 6
    if (P0_PARTS & 8)
    for (int m = gw; m < TL; m += NGW) { f32x4 v[4]; ldrow_f32(inp(F, I_X) + (size_t)m * DM, F.lane, v); strow_f32(F.out + (size_t)m * DM, F.lane, v); }
#endif
}

__device__ __forceinline__ void phase_modnorm0(Frame& F) {
    const int gw = F.vcu * NWAVES + F.wave, NGW = F.G * NWAVES;
    for (int row = gw; row < T0; row += NGW) {
        const int rb = rowbatch(row); const float* xr = row < TL ? inp(F, I_X) + (size_t)row * DM : inp(F, I_CTX) + (size_t)(row - TL) * DM;
        f32x4 v[4], o[4]; ldrow_f32(xr, F.lane, v);
        modnorm(v, rstd_of(v), inp(F, I_NORMG), modp(F, 0, rb, 0), modp(F, 0, rb, 1), F.lane, o);
        strow_bf16(wsp<bf16>(F, WS_HX) + (size_t)row * DM, F.lane, o);
    }
}
__device__ __forceinline__ void phase_e2(Frame& F, int layer) {
    const int gw = F.vcu * NWAVES + F.wave, NGW = F.G * NWAVES;
    const int nrows = layer == 0 ? T0 : TL;
    const bf16* Y = wsp<const bf16>(F, layer == 0 ? WS_Y : WS_Y1);
    const float* g1 = inp(F, I_NORMG) + (layer * 4 + 1) * 1024; const float* g2 = inp(F, I_NORMG) + (layer * 4 + 2) * 1024;
    for (int row = gw; row < nrows; row += NGW) {
        const int rb = rowbatch(row);
        const float* xr = layer == 0 ? (row < TL ? inp(F, I_X) + (size_t)row * DM : inp(F, I_CTX) + (size_t)(row - TL) * DM) : F.out + (size_t)row * DM;
        float* xo = row < TL ? F.out + (size_t)row * DM : wsp<float>(F, WS_CTXRES) + (size_t)(row - TL) * DM;
        f32x4 x[4], y[4], gg[4], mm[4]; ldrow_f32(xr, F.lane, x); ldrow_bf16(Y + (size_t)row * DM, F.lane, y);
        const float ry = rstd_of(y); ldrow_f32(g1, F.lane, gg); ldrow_f32(modp(F, layer, rb, 2), F.lane, mm);
#pragma unroll
        for (int j = 0; j < 4; ++j) x[j] = x[j] + mm[j] * (y[j] * ry * gg[j]);
        strow_f32(xo, F.lane, x);
        f32x4 t[4]; modnorm(x, rstd_of(x), g2, modp(F, layer, rb, 3), modp(F, layer, rb, 4), F.lane, t);
        GAS v2u* qh = (GAS v2u*)(wsp<bf16>(F, WS_HX) + (size_t)row * DM) + F.lane; GAS v2u* ql = (GAS v2u*)(wsp<bf16>(F, WS_TOKLO) + (size_t)row * DM) + F.lane;
#pragma unroll
        for (int j = 0; j < 4; ++j) { unsigned h[4], l[4];
#pragma unroll
            for (int i = 0; i < 4; ++i) { h[i] = f2bf(t[j][i]); l[i] = f2bf(t[j][i] - bf2f(h[i])); }
            qh[64 * j] = (v2u){h[0] | (h[1] << 16), h[2] | (h[3] << 16)}; ql[64 * j] = (v2u){l[0] | (l[1] << 16), l[2] | (l[3] << 16)}; }
    }
}
__device__ __forceinline__ void phase_e4(Frame& F, int layer, int chunk, int CT, bool dry = false) {
    const int gw = F.vcu * NWAVES + F.wave, NGW = F.G * NWAVES;
    const LAS int* tbs = (const LAS int*)(F.lds + TBL_OFF + 4096);
    const int NBr = tbs[64], cstart = chunk * CT;
    const bf16* YE = wsp<const bf16>(F, WS_YEXP);
    const GAS int* TS = (const GAS int*)wsp<const int>(F, WS_TOKSLOT); const GAS float* TG = (const GAS float*)wsp<const float>(F, WS_TOKGATE);
    const float* g3 = inp(F, I_NORMG) + (layer * 4 + 3) * 1024;
    for (int t = cstart + gw; t < cstart + CT; t += NGW) {
        const int rb = rowbatch(t);
        f32x4 y[4], v[4]; ldrow_bf16(YE + ((size_t)256 * NBr + (t - cstart)) * DM, F.lane, y);
#pragma unroll
        for (int k = 0; k < TOPK; ++k) { const int s = __builtin_amdgcn_readfirstlane(TS[t * 8 + k]); const float gt = __builtin_bit_cast(float, __builtin_amdgcn_readfirstlane(__builtin_bit_cast(int, TG[t * 8 + k])));
            const size_t row = (size_t)256 * tbs[s >> 20] + (s & 0xfffff); ldrow_bf16(YE + row * DM, F.lane, v);
#pragma unroll
            for (int j = 0; j < 4; ++j) y[j] = y[j] + v[j] * gt; }
        float* xo = t < TL ? F.out + (size_t)t * DM : wsp<float>(F, WS_CTXRES) + (size_t)(t - TL) * DM;
        f32x4 x[4], gg[4], mm[4]; ldrow_f32(xo, F.lane, x);
        const float ry = rstd_of(y); ldrow_f32(g3, F.lane, gg); ldrow_f32(modp(F, layer, rb, 5), F.lane, mm);
#pragma unroll
        for (int j = 0; j < 4; ++j) x[j] = x[j] + mm[j] * (y[j] * ry * gg[j]);
        if (dry) { if (x[0].x == 1.2345e30f) strow_f32(xo, F.lane, x); continue; }
        strow_f32(xo, F.lane, x);
        if (layer == 0) { f32x4 h[4]; modnorm(x, rstd_of(x), inp(F, I_NORMG) + 4 * 1024, modp(F, 1, rb, 0), modp(F, 1, rb, 1), F.lane, h); strow_bf16(wsp<bf16>(F, WS_HX) + (size_t)t * DM, F.lane, h); }
    }
}
__device__ __forceinline__ void phase_combine(Frame& F) {
    const int gw = F.vcu * NWAVES + F.wave, NGW = F.G * NWAVES;
    const float lam_init = 0.8f - 0.6f * expf(-0.3f);
    float s01 = 0.f, s23 = 0.f;
    for (int i = 0; i < 64; ++i) { s01 += inp(F, I_LAMBDA)[i] * inp(F, I_LAMBDA)[64 + i]; s23 += inp(F, I_LAMBDA)[128 + i] * inp(F, I_LAMBDA)[192 + i]; }
    const float lam = expf(s01) - expf(s23) + lam_init, post = 1.f - lam_init;
    const bf16* OC = wsp<const bf16>(F, WS_OC); bf16* AO = wsp<bf16>(F, WS_Q);
    const int h = F.lane >> 3, e0 = (F.lane & 7) * 16;
    float sg[16];
#pragma unroll
    for (int i = 0; i < 16; ++i) sg[i] = inp(F, I_SUBLNG)[e0 + i] * post;
    for (int t = gw; t < TL; t += NGW) {
        const bf16* p = OC + (size_t)t * 2048 + h * 256 + e0;
        const v4u a0 = *(const GAS v4u*)p, a1 = *(const GAS v4u*)(p + 8), b0 = *(const GAS v4u*)(p + 128), b1 = *(const GAS v4u*)(p + 136);
        const unsigned aw[8] = {a0.x, a0.y, a0.z, a0.w, a1.x, a1.y, a1.z, a1.w}, bw[8] = {b0.x, b0.y, b0.z, b0.w, b1.x, b1.y, b1.z, b1.w};
        float d[16]; float ss = 0.f;
#pragma unroll
        for (int i = 0; i < 8; ++i) { d[2 * i] = bf2f(aw[i] & 0xffffu) - lam * bf2f(bw[i] & 0xffffu); d[2 * i + 1] = bf2f(aw[i] >> 16) - lam * bf2f(bw[i] >> 16); ss += d[2 * i] * d[2 * i] + d[2 * i + 1] * d[2 * i + 1]; }
        ss += __shfl_xor(ss, 1); ss += __shfl_xor(ss, 2); ss += __shfl_xor(ss, 4);
        const float rstd = rsqrtf(ss * (1.f / 128.f) + EPSN);
        unsigned w[8];
#pragma unroll
        for (int i = 0; i < 8; ++i) w[i] = pk2(d[2 * i] * rstd * sg[2 * i], d[2 * i + 1] * rstd * sg[2 * i + 1]);
        bf16* q = AO + (size_t)t * DM + h * 128 + e0;
        *(GAS v4u*)q = (v4u){w[0], w[1], w[2], w[3]}; *(GAS v4u*)(q + 8) = (v4u){w[4], w[5], w[6], w[7]};
    }
}

__device__ __forceinline__ void phase_conv(Frame& F) {
    const int c = F.tid;
    float w[31];
#pragma unroll
    for (int j = 0; j < 31; ++j) w[j] = inp(F, I_CONVW)[j * 512 + c];
    const float bias = inp(F, I_CONVB)[c], lg = inp(F, I_LNG)[c], lb = inp(F, I_LNB)[c];
    LAS bf16* tile = (LAS bf16*)(F.lds);
    const bf16* AG = wsp<const bf16>(F, WS_AGLU); bf16* MIX = wsp<bf16>(F, WS_MIX);
    for (int ti = F.vcu; ti < 544; ti += F.G) {
        int rowbase, L, p0;
        if (ti < 512) { rowbase = (ti >> 6) * SEQ; p0 = (ti & 63) * 64; L = SEQ; } else { const int q = ti - 512; rowbase = TL + (q >> 2) * CTXL; p0 = (q & 3) * 64; L = CTXL; }
        __syncthreads();
        for (int rr = F.wave; rr < 94; rr += 8) { const int p = p0 - 15 + rr; v4u val = (v4u){0u, 0u, 0u, 0u};
            if (p >= 0 && p < L) val = *(const GAS v4u*)(AG + (size_t)(rowbase + p) * 512 + F.lane * 8);
            *(LAS v4u*)(tile + rr * 512 + F.lane * 8) = val; }
        __syncthreads();
        for (int ch = 0; ch < 8; ++ch) {
            float in[38];
#pragma unroll
            for (int i = 0; i < 38; ++i) in[i] = bf2f(tile[(ch * 8 + i) * 512 + c]);
#pragma unroll
            for (int q = 0; q < 8; ++q) { float a = bias;
#pragma unroll
                for (int j = 0; j < 31; ++j) a += w[j] * in[q + j];
                const float mean = wave_sum(a) * (1.f / 64.f), d = a - mean, var = wave_sum(d * d) * (1.f / 64.f);
                const float z = d * rsqrtf(var + EPSN) * lg + lb;
                ((GAS bf16*)MIX)[(size_t)(rowbase + p0 + ch * 8 + q) * DM + c] = (bf16)f2bf(silu(z)); }
        }
    }
    __syncthreads();
}

__device__ __forceinline__ void phase_router(Frame& F, int layer, int ntok, int CT, int cnt_off = 0) {
    typedef float f4 __attribute__((ext_vector_type(4)));
    const int gw = F.vcu * NWAVES + F.wave, NGW = F.G * NWAVES;
    LAS float* lg = (LAS float*)(F.lds + RING_OFF + F.wave * 20480);
    const bf16* TH = wsp<const bf16>(F, WS_HX); const bf16* TLo = wsp<const bf16>(F, WS_TOKLO);
    const bf16* WH = wsp<const bf16>(F, WS_WRT) + (size_t)layer * 2 * 64 * 1024; const bf16* WL = WH + 64 * 1024;
    const float* rbias = inp(F, I_RTB) + layer * 64;
    unsigned* cnt = (unsigned*)(F.ctl + CW_CNT) + layer * NCH * 64 * CNT_STRIDE + cnt_off;
    int* LIST = wsp<int>(F, WS_LIST); int* TS = wsp<int>(F, WS_TOKSLOT); float* TG = wsp<float>(F, WS_TOKGATE);
    const int lr = F.lane & 15, lq = F.lane >> 4;
    for (int task = F.wave * F.G + F.vcu; task < ntok / 64; task += NGW) {
        const int t0 = task * 64;
        f4 acc[4][4];
#pragma unroll
        for (int m = 0; m < 4; ++m)
#pragma unroll
            for (int n = 0; n < 4; ++n) acc[m][n] = (f4){0.f, 0.f, 0.f, 0.f};
        const bf16* ah = TH + (size_t)(t0 + lr) * DM + 8 * lq; const bf16* al = TLo + (size_t)(t0 + lr) * DM + 8 * lq;
        const bf16* bh = WH + (size_t)lr * DM + 8 * lq; const bf16* bl = WL + (size_t)lr * DM + 8 * lq;
        for (int ks = 0; ks < 32; ++ks) { const int k0 = ks * 32;
            bf16x8 xh[4], xl[4], wh[4], wl[4];
#pragma unroll
            for (int m = 0; m < 4; ++m) { xh[m] = *(const GAS bf16x8*)(ah + (size_t)m * 16 * DM + k0); xl[m] = *(const GAS bf16x8*)(al + (size_t)m * 16 * DM + k0); }
#pragma unroll
            for (int n = 0; n < 4; ++n) { wh[n] = *(const GAS bf16x8*)(bh + (size_t)n * 16 * DM + k0); wl[n] = *(const GAS bf16x8*)(bl + (size_t)n * 16 * DM + k0); }
#pragma unroll
            for (int m = 0; m < 4; ++m)
#pragma unroll
                for (int n = 0; n < 4; ++n) {
                    acc[m][n] = __builtin_amdgcn_mfma_f32_16x16x32_bf16(xh[m], wh[n], acc[m][n], 0, 0, 0);
                    acc[m][n] = __builtin_amdgcn_mfma_f32_16x16x32_bf16(xl[m], wh[n], acc[m][n], 0, 0, 0);
                    acc[m][n] = __builtin_amdgcn_mfma_f32_16x16x32_bf16(xh[m], wl[n], acc[m][n], 0, 0, 0); } }
#pragma unroll
        for (int m = 0; m < 4; ++m)
#pragma unroll
            for (int n = 0; n < 4; ++n)
#pragma unroll
                for (int j = 0; j < 4; ++j) lg[(m * 16 + 4 * lq + j) * 65 + n * 16 + lr] = acc[m][n][j];
        LDS_WAIT(); asm volatile("" ::: "memory");
        {
            const int t = t0 + F.lane;
            float v[64];
#pragma unroll
            for (int e = 0; e < 64; ++e) v[e] = 1.f / (1.f + expf(-lg[F.lane * 65 + e])) + rbias[e];
            float gs[8];
#pragma unroll
            for (int g = 0; g < 8; ++g) { float m1 = -INFINITY, m2 = -INFINITY;
#pragma unroll
                for (int i = 0; i < 8; ++i) { const float xx = v[8 * g + i]; m2 = fmaxf(m2, fminf(m1, xx)); m1 = fmaxf(m1, xx); }
                gs[g] = m1 + m2; }
#pragma unroll
            for (int g = 0; g < 8; ++g) { int rank = 0;
#pragma unroll
                for (int g2 = 0; g2 < 8; ++g2) rank += (gs[g2] > gs[g] || (gs[g2] == gs[g] && g2 < g)) ? 1 : 0;
                if (rank >= 4) {
#pragma unroll
                    for (int i = 0; i < 8; ++i) v[8 * g + i] = -INFINITY; } }
            int se[TOPK]; float ss[TOPK]; float ssum = 0.f;
#pragma unroll
            for (int k = 0; k < TOPK; ++k) { float best = -INFINITY; int bi = 0;
#pragma unroll
                for (int e = 0; e < 64; ++e) { const bool gt = v[e] > best; best = gt ? v[e] : best; bi = gt ? e : bi; }
#pragma unroll
                for (int e = 0; e < 64; ++e) v[e] = (e == bi) ? -INFINITY : v[e];
                const float bs = 1.f / (1.f + expf(-lg[F.lane * 65 + bi]));
                se[k] = bi; ss[k] = bs; ssum += bs; }
            const int chunk = t0 / CT; const float inv = 2.5f / ssum;
            LAS unsigned* hist = (LAS unsigned*)(lg + 64 * 65); LAS unsigned* hbase = hist + 64;
            hist[F.lane] = 0u; LDS_WAIT(); asm volatile("" ::: "memory");
            unsigned lrank[TOPK];
#pragma unroll
            for (int k = 0; k < TOPK; ++k) lrank[k] = __hip_atomic_fetch_add(hist + se[k], 1u, __ATOMIC_RELAXED, __HIP_MEMORY_SCOPE_WORKGROUP);
            LDS_WAIT(); asm volatile("" ::: "memory");
            { const unsigned tot = hist[F.lane]; unsigned base = 0u; if (tot) base = __hip_atomic_fetch_add(cnt + (chunk * 64 + F.lane) * CNT_STRIDE, tot, RLX_AGENT); hbase[F.lane] = base; }
            LDS_WAIT(); asm volatile("" ::: "memory");
#pragma unroll
            for (int k = 0; k < TOPK; ++k) { const int e = se[k]; const unsigned pos = hbase[e] + lrank[k];
                ((GAS int*)LIST)[((size_t)chunk * 64 + e) * CAP + pos] = t; ((GAS int*)TS)[t * 8 + k] = (e << 20) | (int)pos; ((GAS float*)TG)[t * 8 + k] = ss[k] * inv; }
        }
        LDS_WAIT(); asm volatile("" ::: "memory");
    }
}

template <bool GATHER_> struct MoeOrder {
    static constexpr bool GATHER = GATHER_;
    const LAS int* tb; int NBr, NBt, NPN, G, vcu;
    unsigned Asrc; int lda;
    unsigned Bexp, bstride, Bsh; int ldb;
    const int* list; const unsigned* cnt; int cstart;
    __device__ __forceinline__ bool next(int i, pg8::Unit& u) const {
        const int L = i * G + vcu; if (L >= NBt * NPN) return false;
        const int blk = L / NPN, pn = L - blk * NPN; u.pm = blk; u.pn = pn;
        if (blk < NBr) { const int w = tb[blk]; u.aux = w; u.B = Bexp + (unsigned)(w >> 16) * bstride + (unsigned)pn * 256u * ldb * 2u; }
        else { u.aux = -1; u.B = Bsh + (unsigned)pn * 256u * ldb * 2u; }
        u.A = GATHER ? Asrc : Asrc + (unsigned)blk * 256u * lda * 2u; return true;
    }
    __device__ __forceinline__ void aoffs(const pg8::Unit& u, unsigned (&v)[2][2]) const {
        int tid = threadIdx.x; asm volatile("" : "+v"(tid));
#pragma unroll
        for (int i = 0; i < 2; ++i) { int R, C; pg8::stage_rc(tid * 16 + i * 8192, R, C);
#pragma unroll
            for (int h = 0; h < 2; ++h) { const int r = h * 128 + R;
                if constexpr (!GATHER) v[h][i] = (unsigned)(r * lda + C) * 2u;
                else { int tok;
                    if (u.aux >= 0) { const int e = u.aux >> 16, pos = (u.aux & 0xffff) * 256 + r; tok = pos < (int)((const GAS unsigned*)cnt)[e * CNT_STRIDE] ? ((const GAS int*)list)[(size_t)e * CAP + pos] : cstart; }
                    else tok = cstart + (u.pm - NBr) * 256 + r;
                    v[h][i] = (unsigned)(tok * lda + C) * 2u; } } }
    }
};
__device__ __forceinline__ void moe_tables(Frame& F, const unsigned* cnt) {
    LAS int* tb = (LAS int*)(F.lds + TBL_OFF); LAS int* tbs = (LAS int*)(F.lds + TBL_OFF + 4096);
    __syncthreads();
    if (F.wave == 0) { const int c = (int)cnt[F.lane * CNT_STRIDE]; const int nb = (c + 255) >> 8; int inc = nb;
#pragma unroll
        for (int o = 1; o < 64; o <<= 1) { const int t = __shfl_up(inc, o); if (F.lane >= o) inc += t; }
        const int start = inc - nb; tbs[F.lane] = start; if (F.lane == 63) tbs[64] = inc;
        for (int j = 0; j < nb; ++j) tb[start + j] = (F.lane << 16) | j; }
    __syncthreads();
}

struct DftOrder {
    static constexpr bool GATHER = false;
    unsigned TAB, FT; int L, nM, G, vcu;
    __device__ __forceinline__ bool next(int i, pg8::Unit& u) const {
        const int U = i * G + vcu; if (U >= NBATCH * nM * 2) return false;
        const int b = U / (nM * 2), r = U % (nM * 2); u.pm = r >> 1; u.pn = r & 1; u.aux = b;
        u.A = TAB + (unsigned)u.pm * 256u * L * 2u; u.B = FT + ((unsigned)b * 512u + u.pn * 256u) * L * 2u; return true;
    }
    __device__ __forceinline__ void aoffs(const pg8::Unit&, unsigned (&v)[2][2]) const {
        int tid = threadIdx.x; asm volatile("" : "+v"(tid));
#pragma unroll
        for (int i = 0; i < 2; ++i) { int R, C; pg8::stage_rc(tid * 16 + i * 8192, R, C);
#pragma unroll
            for (int h = 0; h < 2; ++h) v[h][i] = (unsigned)((h * 128 + R) * L + C) * 2u; }
    }
};

struct Args { const float* in[25]; float* out; unsigned char* ws; int ph_lo, ph_hi, li, pad; };
#ifndef REPEAT_MASK
#define REPEAT_MASK 0u
#endif
#define IN(k) (lo <= (k) && (k) < hi && (k) <= DBG_LAST_PHASE)
#define REPS(k) for (int rep_ = 0; rep_ <= (int)((REPEAT_MASK >> (k)) & 1u); ++rep_)
#define SEAM(k) do { if (lo <= (k) && (k) + 1 < hi) xcd_barrier(bar); } while (0)

template <int LAYER, int CHUNK> __device__ __forceinline__ void moe_chunk(Frame& F, const XcdBarrier& bar, const int lo, const int hi) {
    constexpr int pb = 6 + 12 * LAYER, p = pb + 2 + 3 * CHUNK, ntok = LAYER == 0 ? T0 : TL, CT = ntok / NCH;
    if (IN(p)) REPS(p) { FENCE(F);
        const unsigned* cnt = (const unsigned*)(F.ctl + CW_CNT) + (LAYER * NCH + CHUNK) * 64 * CNT_STRIDE; const int* list = wsp<const int>(F, WS_LIST) + (size_t)CHUNK * 64 * CAP;
        const LAS int* tb = (const LAS int*)(F.lds + TBL_OFF); const LAS int* tbs = (const LAS int*)(F.lds + TBL_OFF + 4096);
        moe_tables(F, cnt); const int NBr = tbs[64];
        MoeOrder<true> S{tb, NBr, NBr + CT / 256, 2, F.G, F.vcu, (unsigned)WS_HX, 1024, (unsigned)WS_WEUP, 512u * 1024u * 2u, (unsigned)WS_SHUP + (unsigned)LAYER * 512u * 1024u * 2u, 1024, list, cnt, CHUNK * CT};
        pg8::EpiSwiglu E{wsp<bf16>(F, WS_HID), 256}; pg8::gemm_phase(F.lds + RING_OFF, F.ws, 1024, 1024, S, E); } SEAM(p);
    if (IN(p + 1)) REPS(p + 1) { FENCE(F);
        const unsigned* cnt = (const unsigned*)(F.ctl + CW_CNT) + (LAYER * NCH + CHUNK) * 64 * CNT_STRIDE; const int* list = wsp<const int>(F, WS_LIST) + (size_t)CHUNK * 64 * CAP;
        const LAS int* tb = (const LAS int*)(F.lds + TBL_OFF); const LAS int* tbs = (const LAS int*)(F.lds + TBL_OFF + 4096);
        moe_tables(F, cnt); const int NBr = tbs[64];
        MoeOrder<false> S{tb, NBr, NBr + CT / 256, 4, F.G, F.vcu, (unsigned)WS_HID, 256, (unsigned)WS_WEDN, 1024u * 256u * 2u, (unsigned)WS_SHDN + (unsigned)LAYER * 1024u * 256u * 2u, 256, list, cnt, CHUNK * CT};
        pg8::EpiBf16 E{wsp<bf16>(F, WS_YEXP), 1024, 0}; pg8::gemm_phase(F.lds + RING_OFF, F.ws, 256, 256, S, E); } SEAM(p + 1);
    if (IN(p + 2)) REPS(p + 2) { FENCE(F);
        const unsigned* cnt = (const unsigned*)(F.ctl + CW_CNT) + (LAYER * NCH + CHUNK) * 64 * CNT_STRIDE;
        moe_tables(F, cnt);
#ifdef E4_TIMING
        phase_e4(F, LAYER, CHUNK, CT, true); FENCE(F);
#endif
        phase_e4(F, LAYER, CHUNK, CT); } SEAM(p + 2);
}
template <int LAYER> __device__ __forceinline__ void moe_part(Frame& F, const XcdBarrier& bar, const int lo, const int hi) {
    constexpr int pb = 6 + 12 * LAYER, ntok = LAYER == 0 ? T0 : TL, CT = ntok / NCH;
    if (IN(pb)) REPS(pb) { FENCE(F); phase_e2(F, LAYER); } SEAM(pb);
    if (IN(pb + 1)) { FENCE(F);
#ifdef ROUTER_TIMING
        phase_router(F, LAYER, ntok, CT, 4 * 64 * CNT_STRIDE); FENCE(F);
#endif
        phase_router(F, LAYER, ntok, CT); } SEAM(pb + 1);
    moe_chunk<LAYER, 0>(F, bar, lo, hi);
    moe_chunk<LAYER, 1>(F, bar, lo, hi);
}

__global__ void __launch_bounds__(NWAVES * 64, 2) mega_fwd(Args args) {
    extern __shared__ __attribute__((aligned(16))) unsigned char lds[];
    Frame F;
    F.lds = (LAS unsigned char*)lds;
    F.MISC = (volatile LAS unsigned*)(F.lds + MISC_OFF);
    F.tid = threadIdx.x; F.lane = F.tid & 63; F.wave = __builtin_amdgcn_readfirstlane(F.tid >> 6);
    F.G = gridDim.x; { const int bx = blockIdx.x; F.vcu = (F.G % 8 == 0) ? (bx % 8) * (F.G / 8) + bx / 8 : bx; }
    F.ws = args.ws; F.ctl = (gu32*)(args.ws + WS_CTL); F.out = args.out;
    for (int u = F.tid; u < (LDS_BYTES - LDSCTL_OFF) / 4; u += NWAVES * 64) ((LAS unsigned*)(F.lds + LDSCTL_OFF))[u] = 0u;
    __syncthreads();
    if (F.tid < 25) { const unsigned long long pv = (unsigned long long)args.in[F.tid]; LAS unsigned* t = (LAS unsigned*)(F.lds + INPTR_OFF) + 2 * F.tid; t[0] = (unsigned)pv; t[1] = (unsigned)(pv >> 32); }
    __syncthreads();
    XcdBarrier bar; bar.bar = (unsigned*)(F.ctl + CW_BAR); bar.x = 0; bar.st = nullptr;
#if MK_SINGLE
    bar = xcd_barrier_post((unsigned*)(F.ctl + CW_BAR), F.MISC + 8);
#endif
    const int lo = args.ph_lo, hi = args.ph_hi;
    const int bx = (int)blockIdx.x;

    if (IN(0)) REPS(0) { FENCE(F); p0_prologue(F); } SEAM(0);
    if (IN(1)) REPS(1) { FENCE(F); phase_modnorm0(F); } SEAM(1);
    if (IN(2)) REPS(2) { FENCE(F);
        { pg8::DenseOrder S; S.init((unsigned)WS_HX, 1024, (unsigned)WS_WIN, 1024, T0 / 256, 4, 0, F.G, bx); pg8::EpiGlu E{wsp<bf16>(F, WS_AGLU)}; pg8::gemm_phase(F.lds + RING_OFF, F.ws, 1024, 1024, S, E); }
        FENCE(F);
        { pg8::DenseOrder S; S.init((unsigned)WS_HX, 1024, (unsigned)WS_WIN, 1024, T0 / 256, 2, 4, F.G, bx); pg8::EpiFT E{wsp<bf16>(F, WS_FT), wsp<bf16>(F, WS_FTC)}; pg8::gemm_phase(F.lds + RING_OFF, F.ws, 1024, 1024, S, E); } } SEAM(2);
    if (IN(3)) REPS(3) { FENCE(F); phase_conv(F);
        { DftOrder S{(unsigned)WS_TAB, (unsigned)WS_FT, SEQ, SEQ / 256, F.G, F.vcu}; pg8::EpiDft<SEQ> E{wsp<bf16>(F, WS_FF), 0}; pg8::gemm_phase(F.lds + RING_OFF, F.ws, SEQ, SEQ, S, E); }
        FENCE(F);
        { DftOrder S{(unsigned)WS_TABC, (unsigned)WS_FTC, CTXL, 1, F.G, F.vcu}; pg8::EpiDft<CTXL> E{wsp<bf16>(F, WS_FF), TL}; pg8::gemm_phase(F.lds + RING_OFF, F.ws, CTXL, CTXL, S, E); } } SEAM(3);
    if (IN(4)) REPS(4) { FENCE(F); pg8::DenseOrder S; S.init((unsigned)WS_FF, 1024, (unsigned)WS_BD, 1024, T0 / 256, 2, 0, F.G, bx);
        pg8::EpiBf16 E{wsp<bf16>(F, WS_MIX), 1024, 512}; pg8::gemm_phase(F.lds + RING_OFF, F.ws, 1024, 1024, S, E); } SEAM(4);
    if (IN(5)) REPS(5) { FENCE(F); pg8::DenseOrder S; S.init((unsigned)WS_MIX, 1024, (unsigned)WS_WOUT, 1024, T0 / 256, 4, 0, F.G, bx);
        pg8::EpiBf16 E{wsp<bf16>(F, WS_Y), 1024, 0}; pg8::gemm_phase(F.lds + RING_OFF, F.ws, 1024, 1024, S, E); } SEAM(5);
    moe_part<0>(F, bar, lo, hi);
    if (IN(14)) REPS(14) { FENCE(F);
        { pg8::DenseOrder S; S.init((unsigned)WS_HX, 1024, (unsigned)WS_WQKV, 1024, TL / 256, 12, 0, F.G, bx);
          pg8::EpiQkv E{wsp<bf16>(F, WS_Q), wsp<bf16>(F, WS_KALL), wsp<bf16>(F, WS_VALL), wsp<float>(F, WS_ROPE), wsp<float>(F, WS_ROPE + 512 * 1024), 0}; pg8::gemm_phase(F.lds + RING_OFF, F.ws, 1024, 1024, S, E); }
        FENCE(F);
        { pg8::DenseOrder S; S.init((unsigned)(WS_HX + (size_t)TL * 2048), 1024, (unsigned)WS_WQKV, 1024, TC / 256, 8, 4, F.G, bx);
          pg8::EpiQkv E{wsp<bf16>(F, WS_Q), wsp<bf16>(F, WS_KALL), wsp<bf16>(F, WS_VALL), wsp<float>(F, WS_ROPE), wsp<float>(F, WS_ROPE + 512 * 1024), 1}; pg8::gemm_phase(F.lds + RING_OFF, F.ws, 1024, 1024, S, E); }
    } SEAM(14);
    if (IN(15)) REPS(15) { FENCE(F);
        const attn_body::bf16* Q = wsp<const attn_body::bf16>(F, WS_Q); const attn_body::bf16* KA = wsp<const attn_body::bf16>(F, WS_KALL); const attn_body::bf16* VA = wsp<const attn_body::bf16>(F, WS_VALL);
        attn_body::bf16* OC = wsp<attn_body::bf16>(F, WS_OC);
        for (int i = 0;; ++i) { int bh, cc, qb;
            if (F.G == 256) { if (i >= 16) break; const int xg = F.vcu >> 5, ci = F.vcu & 31, un = (i & 1) * 32 + ci; bh = xg * 8 + (i >> 1); cc = un >> 5; qb = un & 31; }
            else { const int u = i * F.G + F.vcu; if (u >= 64 * 2 * (SEQ / 128)) break; bh = u >> 6; cc = (u >> 5) & 1; qb = u & 31; }
            const int b = bh >> 3, h = bh & 7;
            attn_body::attn_unit<8>(Q + ((size_t)b * SEQ + qb * 128) * 1024 + h * 128 + cc * 64, KA + (size_t)b * LKV * 1024 + h * 128 + cc * 64, VA + (size_t)b * LKV * 1024 + h * 128,
                                    OC + ((size_t)b * SEQ + qb * 128) * 2048 + h * 256 + cc * 128, LKV / 64, (char*)lds + RING_OFF); }
    } SEAM(15);
    if (IN(16)) REPS(16) { FENCE(F); phase_combine(F); FENCE(F); convert_experts(F, 1); } SEAM(16);
    if (IN(17)) REPS(17) { FENCE(F); pg8::DenseOrder S; S.init((unsigned)WS_Q, 1024, (unsigned)WS_WDAO, 1024, TL / 256, 4, 0, F.G, bx);
        pg8::EpiBf16 E{wsp<bf16>(F, WS_Y1), 1024, 0}; pg8::gemm_phase(F.lds + RING_OFF, F.ws, 1024, 1024, S, E); } SEAM(17);
    moe_part<1>(F, bar, lo, hi);
}
#undef IN
#undef SEAM

extern "C" void kernel_launch(void* const* d_in, const int* in_sizes, int n_in, void* d_out, int out_size, void* d_ws, size_t ws_size, hipStream_t stream) {
    static int grid = 0;
    if (grid == 0) {
        if (n_in != 25 || in_sizes[0] != TL * DM || out_size != TL * DM || ws_size < WS_END) { fprintf(stderr, "kernel_launch: unexpected problem shape / workspace (n_in %d, in0 %d, out %d, ws %zu, need %zu); nothing launched\n", n_in, n_in > 0 ? in_sizes[0] : -1, out_size, ws_size, (size_t)WS_END); grid = -1; return; }
        int dev = 0, cus = 0, per_cu = 0;
        if (hipGetDevice(&dev) != hipSuccess || hipDeviceGetAttribute(&cus, hipDeviceAttributeMultiprocessorCount, dev) != hipSuccess) { grid = -1; return; }
        if (hipFuncSetAttribute((const void*)mega_fwd, hipFuncAttributeMaxDynamicSharedMemorySize, LDS_BYTES) != hipSuccess) { fprintf(stderr, "kernel_launch: hipFuncSetAttribute failed\n"); grid = -1; return; }
        if (hipOccupancyMaxActiveBlocksPerMultiprocessor(&per_cu, (const void*)mega_fwd, NWAVES * 64, LDS_BYTES) != hipSuccess || per_cu < 1) fprintf(stderr, "kernel_launch: occupancy query reports %d per CU\n", per_cu);
        (void)hipGetLastError();
        grid = cus;
    }
    if (grid < 0) return;
    if (hipMemsetAsync((char*)d_ws + WS_CTL, 0, CTL_ZERO_BYTES, stream) != hipSuccess) return;
    Args a{};
    for (int i = 0; i < 25; ++i) a.in[i] = (const float*)d_in[i];
    a.out = (float*)d_out; a.ws = (unsigned char*)d_ws;
#if MK_SINGLE
    a.ph_lo = 0; a.ph_hi = NPHASES; a.li = 0;
    hipLaunchKernelGGL(mega_fwd, dim3(grid), dim3(NWAVES * 64), LDS_BYTES, stream, a);
#else
    for (int p = 0; p <= DBG_LAST_PHASE && p < NPHASES; ++p) { a.ph_lo = p; a.ph_hi = p + 1; a.li = p;
        hipLaunchKernelGGL(mega_fwd, dim3(grid), dim3(NWAVES * 64), LDS_BYTES, stream, a); }
#endif
}
```

```cpp
#include <hip/hip_runtime.h>
#include <hip/hip_bf16.h>
#include <cstdio>
#include <cstdint>
#include <cmath>

#ifndef MK_SINGLE
#define MK_SINGLE 1
#endif

constexpr int DM = 1024, NBATCH = 8, SEQ = 4096, CTXL = 256;
constexpr int TL = NBATCH * SEQ;
constexpr int TC = NBATCH * CTXL;
constexpr int T0 = TL + TC;
constexpr int LKV = CTXL + SEQ;
constexpr float EPSN = 1e-6f;
constexpr int NEXP = 64, TOPK = 6;
constexpr int NCH = 2;
constexpr int CAP = T0 / NCH;

namespace pg8 {
#define PG8_LAS __attribute__((address_space(3)))
#define PG8_GAS __attribute__((address_space(1)))
typedef unsigned short bf16_t;
typedef short bf16x8 __attribute__((ext_vector_type(8)));
typedef float f32x4 __attribute__((ext_vector_type(4)));
typedef unsigned u32x4 __attribute__((ext_vector_type(4)));
constexpr int BM = 256, BK = 64, HALF = 128, HTB = HALF * BK * 2, STAGE_BYTES = 8 * HTB;

__host__ __device__ __forceinline__ int lds_byte(int r, int c) { const int st = (r >> 4) * 2 + (c >> 5), rr = r & 15, cc = c & 31, ob = rr * 64 + cc * 2; return st * 1024 + (ob ^ (((ob >> 9) & 1) << 5)); }
__host__ __device__ __forceinline__ void stage_rc(int b, int& R, int& C) { const int st = b / 1024, sb = b % 1024, swz = sb ^ (((sb >> 9) & 1) << 5); R = (st >> 1) * 16 + swz / 64; C = (st & 1) * 32 + (swz % 64) / 2; }
__host__ __device__ __forceinline__ int perm32(int rho) { const int n = rho >> 4, i = rho & 15; return 8 * (i >> 2) + 4 * n + (i & 3); }

struct Unit { unsigned A, B; int pm, pn, aux; };

__device__ __forceinline__ unsigned cvt_pk_bf16(float lo, float hi) { unsigned r; asm volatile("v_cvt_pk_bf16_f32 %0, %1, %2" : "=v"(r) : "v"(lo), "v"(hi)); return r; }
__device__ __forceinline__ u32x4 pack8(const f32x4& a, const f32x4& b) { u32x4 w; w.x = cvt_pk_bf16(a[0], a[1]); w.y = cvt_pk_bf16(a[2], a[3]); w.z = cvt_pk_bf16(b[0], b[1]); w.w = cvt_pk_bf16(b[2], b[3]); return w; }


template <class Epi, class Sched>
__device__ __forceinline__ void gemm_phase(PG8_LAS unsigned char* lds, const void* wsbase, const int K, const int ldb, const Sched& S, const Epi& E) {
    const __amdgpu_buffer_rsrc_t rsrc = __builtin_amdgcn_make_buffer_rsrc((void*)wsbase, 0, 0x7fffffff, 0x00020000);
    int tid_ = threadIdx.x; asm volatile("" : "+v"(tid_));
    const int tid = tid_, wid = __builtin_amdgcn_readfirstlane(tid >> 6), lane = tid & 63, wr = wid >> 2, wc = wid & 3, fr = lane & 15, fq = lane >> 4;
    const int nt = K / BK;
    unsigned voffB[2];
#pragma unroll
    for (int i = 0; i < 2; ++i) { int R, C; stage_rc(tid * 16 + i * 8192, R, C); const int Rb = (R & ~31) + perm32(R & 31); voffB[i] = (unsigned)(Rb * ldb + C) * 2u; }
    const unsigned kstep = (unsigned)(BK * 2);
    const unsigned hstepB = (unsigned)HALF * ldb * 2;
    const unsigned ldsw = (unsigned)wid * 1024u;
    const int aoff = lds_byte(wr * 64 + fr, fq * 8), boff = lds_byte(wc * 32 + fr, fq * 8);
#define PG8_SA(b, h) (((b) * 2 + (h)) * HTB)
#define PG8_SB(b, h) ((4 + (b) * 2 + (h)) * HTB)
#define PG8_STG(bufoff, gbase, v0, v1) do { \
        __builtin_amdgcn_raw_ptr_buffer_load_lds(rsrc, (PG8_LAS unsigned*)(lds + (bufoff) + ldsw), 16, (v0), (gbase), 0, 0); \
        __builtin_amdgcn_raw_ptr_buffer_load_lds(rsrc, (PG8_LAS unsigned*)(lds + (bufoff) + ldsw + 8192), 16, (v1), (gbase), 0, 0); } while (0)
#define PG8_STGB(bufoff, gbase) PG8_STG(bufoff, gbase, voffB[0], voffB[1])
#define PG8_LDA(dst, b, h) do { _Pragma("unroll") for (int m = 0; m < 4; ++m) _Pragma("unroll") for (int k = 0; k < 2; ++k) dst[m][k] = *(const PG8_LAS bf16x8*)(lds + PG8_SA(b, h) + aoff + m * 2048 + k * 1024); } while (0)
#define PG8_LDB(dst, b, h) do { _Pragma("unroll") for (int n = 0; n < 2; ++n) _Pragma("unroll") for (int k = 0; k < 2; ++k) dst[n][k] = *(const PG8_LAS bf16x8*)(lds + PG8_SB(b, h) + boff + n * 2048 + k * 1024); } while (0)
#define PG8_MMA(ai, bj, At, Bt) do { __builtin_amdgcn_s_setprio(1); _Pragma("unroll") for (int m = 0; m < 4; ++m) _Pragma("unroll") for (int n = 0; n < 2; ++n) _Pragma("unroll") for (int k = 0; k < 2; ++k) \
        acc[ai][bj][m][n] = __builtin_amdgcn_mfma_f32_16x16x32_bf16(Bt[n][k], At[m][k], acc[ai][bj][m][n], 0, 0, 0); __builtin_amdgcn_s_setprio(0); } while (0)
#define PG8_WAIT_V(n) asm volatile("s_waitcnt vmcnt(" #n ")" ::: "memory")
#define PG8_WAIT_L(n) asm volatile("s_waitcnt lgkmcnt(" #n ")" ::: "memory")
#define PG8_BAR __builtin_amdgcn_s_barrier()
#define PG8_SCHED __builtin_amdgcn_sched_barrier(0)
    Unit cur, nxt; int ui = 0;
    if (!S.next(0, cur)) return;
    f32x4 acc[2][2][4][2];
#pragma unroll
    for (int a = 0; a < 2; ++a)
#pragma unroll
        for (int b = 0; b < 2; ++b)
#pragma unroll
            for (int m = 0; m < 4; ++m)
#pragma unroll
                for (int n = 0; n < 2; ++n) acc[a][b][m][n] = (f32x4){0.f, 0.f, 0.f, 0.f};
    bf16x8 At[4][2], B0[2][2], B1[2][2];
    unsigned vAc[2][2], vAn[2][2];
    S.aoffs(cur, vAc);
    unsigned cA = cur.A, cB = cur.B;
    PG8_STGB(PG8_SB(0, 0), cB); PG8_STGB(PG8_SB(0, 1), cB + hstepB); PG8_STG(PG8_SA(0, 0), cA, vAc[0][0], vAc[0][1]); PG8_STG(PG8_SA(0, 1), cA, vAc[1][0], vAc[1][1]);
    if (wr == 1) PG8_BAR;
    PG8_WAIT_V(2); PG8_BAR;
    PG8_STGB(PG8_SB(1, 0), cB + kstep); PG8_STG(PG8_SA(1, 0), cA + kstep, vAc[0][0], vAc[0][1]); PG8_STGB(PG8_SB(1, 1), cB + hstepB + kstep);
    PG8_WAIT_V(6); PG8_BAR;
    for (;;) {
        const bool has_next = S.next(ui + 1, nxt);
        if constexpr (Sched::GATHER) {
            if (has_next) S.aoffs(nxt, vAn);
            else {
#pragma unroll
                for (int h = 0; h < 2; ++h)
#pragma unroll
                    for (int i = 0; i < 2; ++i) vAn[h][i] = vAc[h][i]; } }
        const unsigned nA = has_next ? nxt.A : cA, nB = has_next ? nxt.B : cB;
        for (int t = 0; t < nt; t += 2) {
            const bool last = (t == nt - 2);
            const unsigned a1 = cA + (unsigned)(t + 1) * kstep;
            const unsigned a2 = last ? nA : cA + (unsigned)(t + 2) * kstep, b2 = last ? nB : cB + (unsigned)(t + 2) * kstep;
            const unsigned a3 = a2 + kstep, b3 = b2 + kstep;
            unsigned w00 = vAc[0][0], w01 = vAc[0][1], w10 = vAc[1][0], w11 = vAc[1][1];
            if constexpr (Sched::GATHER) { w00 = last ? vAn[0][0] : w00; w01 = last ? vAn[0][1] : w01; w10 = last ? vAn[1][0] : w10; w11 = last ? vAn[1][1] : w11; }
            PG8_LDB(B0, 0, 0); PG8_LDB(B1, 0, 1); PG8_SCHED; PG8_LDA(At, 0, 0); PG8_STG(PG8_SA(1, 1), a1, vAc[1][0], vAc[1][1]);
            PG8_WAIT_V(8); PG8_WAIT_L(0); PG8_BAR; PG8_MMA(0, 0, At, B0); PG8_MMA(0, 1, At, B1); PG8_BAR; PG8_SCHED;
            PG8_LDA(At, 0, 1); PG8_STGB(PG8_SB(0, 0), b2); PG8_STGB(PG8_SB(0, 1), b2 + hstepB); PG8_STG(PG8_SA(0, 0), a2, w00, w01);
            PG8_WAIT_V(8); PG8_WAIT_L(0); PG8_BAR; PG8_MMA(1, 0, At, B0); PG8_MMA(1, 1, At, B1); PG8_BAR; PG8_SCHED;
            PG8_LDB(B0, 1, 0); PG8_LDB(B1, 1, 1); PG8_SCHED; PG8_LDA(At, 1, 0); PG8_STG(PG8_SA(0, 1), a2, w10, w11);
            PG8_WAIT_V(8); PG8_WAIT_L(0); PG8_BAR; PG8_MMA(0, 0, At, B0); PG8_MMA(0, 1, At, B1); PG8_BAR; PG8_SCHED;
            PG8_LDA(At, 1, 1); PG8_STGB(PG8_SB(1, 0), b3); PG8_STGB(PG8_SB(1, 1), b3 + hstepB); PG8_STG(PG8_SA(1, 0), a3, w00, w01);
            PG8_WAIT_V(8); PG8_WAIT_L(0); PG8_BAR; PG8_MMA(1, 0, At, B0); PG8_MMA(1, 1, At, B1); PG8_BAR; PG8_SCHED;
        }
        if (wr == 0) PG8_BAR;
        { int t2 = threadIdx.x; asm volatile("" : "+v"(t2)); const int l2 = t2 & 63, w2 = __builtin_amdgcn_readfirstlane(t2 >> 6);
          E(acc, cur, w2 >> 2, w2 & 3, l2 & 15, l2 >> 4); }
        if (!has_next) break;
#pragma unroll
        for (int a = 0; a < 2; ++a)
#pragma unroll
            for (int b = 0; b < 2; ++b)
#pragma unroll
                for (int m = 0; m < 4; ++m)
#pragma unroll
                    for (int n = 0; n < 2; ++n) acc[a][b][m][n] = (f32x4){0.f, 0.f, 0.f, 0.f};
        cur = nxt; cA = nA; cB = nB; ++ui;
        if constexpr (Sched::GATHER) {
#pragma unroll
            for (int h = 0; h < 2; ++h)
#pragma unroll
                for (int i = 0; i < 2; ++i) vAc[h][i] = vAn[h][i]; }
        if (wr == 1) PG8_BAR;
    }
    PG8_WAIT_V(0);
    PG8_BAR;
#undef PG8_SA
#undef PG8_SB
#undef PG8_STG
#undef PG8_STGB
#undef PG8_LDA
#undef PG8_LDB
#undef PG8_MMA
#undef PG8_WAIT_V
#undef PG8_WAIT_L
#undef PG8_BAR
#undef PG8_SCHED
}

struct DenseOrder {
    static constexpr bool GATHER = false;
    unsigned A, B; int lda, ldb, nM, nN, pn0, nwg, G, c;
    __device__ __forceinline__ void init(size_t A_, int lda_, size_t B_, int ldb_, int nM_, int nN_, int pn0_, int G_, int c_) { A = (unsigned)A_; B = (unsigned)B_; lda = lda_; ldb = ldb_; nM = nM_; nN = nN_; pn0 = pn0_; nwg = nM * nN; G = G_; c = c_; }
    __device__ __forceinline__ bool next(int i, Unit& u) const {
        const long L = (long)i * G + c; if (L >= nwg) return false;
        int wgid = (int)L; { const int q = nwg / 8, r = nwg % 8, xcd = wgid % 8, off = wgid / 8; wgid = (xcd < r ? xcd * (q + 1) : r * (q + 1) + (xcd - r) * q) + off; }
        const int nig = 8 * nN, gid = wgid / nig, fm = gid * 8, gsz = (nM - fm) < 8 ? (nM - fm) : 8;
        u.pm = fm + ((wgid % nig) % gsz); u.pn = (wgid % nig) / gsz + pn0; u.aux = 0;
        u.A = A + (unsigned)u.pm * 256u * lda * 2u; u.B = B + (unsigned)u.pn * 256u * ldb * 2u; return true;
    }
    __device__ __forceinline__ void aoffs(const Unit&, unsigned (&v)[2][2]) const {
        int tid = threadIdx.x; asm volatile("" : "+v"(tid));
#pragma unroll
        for (int i = 0; i < 2; ++i) { int R, C; stage_rc(tid * 16 + i * 8192, R, C);
#pragma unroll
            for (int h = 0; h < 2; ++h) v[h][i] = (unsigned)((h * 128 + R) * lda + C) * 2u; }
    }
};

struct EpiBf16 {
    bf16_t* O; int ldc, coff;
    __device__ __forceinline__ void operator()(const f32x4 (&acc)[2][2][4][2], const Unit& u, int wr, int wc, int fr, int fq) const {
        const int row0 = u.pm * BM + wr * 64 + fr, col0 = coff + u.pn * BM + wc * 32 + 8 * fq;
#pragma unroll
        for (int ai = 0; ai < 2; ++ai)
#pragma unroll
            for (int m = 0; m < 4; ++m) { bf16_t* rowp = O + (size_t)(row0 + ai * HALF + m * 16) * ldc + col0;
#pragma unroll
                for (int bj = 0; bj < 2; ++bj) *(PG8_GAS u32x4*)(rowp + bj * HALF) = pack8(acc[ai][bj][m][0], acc[ai][bj][m][1]); }
    }
};
__device__ __forceinline__ float sigm(float x) { return 1.f / (1.f + __expf(-x)); }
struct EpiSwiglu {
    bf16_t* H; int ldh;
    __device__ __forceinline__ void operator()(const f32x4 (&acc)[2][2][4][2], const Unit& u, int wr, int wc, int fr, int fq) const {
        const int row0 = u.pm * BM + wr * 64 + fr, col0 = u.pn * HALF + wc * 32 + 8 * fq;
#pragma unroll
        for (int ai = 0; ai < 2; ++ai)
#pragma unroll
            for (int m = 0; m < 4; ++m) { f32x4 o[2];
#pragma unroll
                for (int n = 0; n < 2; ++n)
#pragma unroll
                    for (int j = 0; j < 4; ++j) { const float g = acc[ai][0][m][n][j]; o[n][j] = g * sigm(g) * acc[ai][1][m][n][j]; }
                *(PG8_GAS u32x4*)(H + (size_t)(row0 + ai * HALF + m * 16) * ldh + col0) = pack8(o[0], o[1]); }
    }
};
struct EpiGlu {
    bf16_t* AGLU;
    __device__ __forceinline__ void operator()(const f32x4 (&acc)[2][2][4][2], const Unit& u, int wr, int wc, int fr, int fq) const {
        const int row0 = u.pm * BM + wr * 64 + fr, col0 = u.pn * HALF + wc * 32 + 8 * fq;
#pragma unroll
        for (int ai = 0; ai < 2; ++ai)
#pragma unroll
            for (int m = 0; m < 4; ++m) { f32x4 o[2];
#pragma unroll
                for (int n = 0; n < 2; ++n)
#pragma unroll
                    for (int j = 0; j < 4; ++j) o[n][j] = acc[ai][0][m][n][j] * sigm(acc[ai][1][m][n][j]);
                *(PG8_GAS u32x4*)(AGLU + (size_t)(row0 + ai * HALF + m * 16) * 512 + col0) = pack8(o[0], o[1]); }
    }
};
struct EpiFT {
    bf16_t* FT; bf16_t* FTC;
    __device__ __forceinline__ void operator()(const f32x4 (&acc)[2][2][4][2], const Unit& u, int wr, int wc, int fr, int fq) const {
        const int rb = u.pm * BM; bf16_t* base; int L, l0;
        if (rb < TL) { base = FT + (size_t)(rb / SEQ) * 512 * SEQ; L = SEQ; l0 = rb % SEQ; } else { base = FTC + (size_t)((rb - TL) / CTXL) * 512 * CTXL; L = CTXL; l0 = 0; }
        const int ch0 = (u.pn - 4) * BM + wc * 32 + 8 * fq;
        bf16_t* lanep = base + (size_t)ch0 * L + l0 + wr * 64 + fr;
#pragma unroll
        for (int ai = 0; ai < 2; ++ai)
#pragma unroll
            for (int m = 0; m < 4; ++m)
#pragma unroll
                for (int bj = 0; bj < 2; ++bj)
#pragma unroll
                    for (int n = 0; n < 2; ++n) { const unsigned p0 = cvt_pk_bf16(acc[ai][bj][m][n][0], acc[ai][bj][m][n][1]), p1 = cvt_pk_bf16(acc[ai][bj][m][n][2], acc[ai][bj][m][n][3]);
                        PG8_GAS bf16_t* d = (PG8_GAS bf16_t*)(lanep + (size_t)(bj * HALF + 4 * n) * L + (ai * HALF + m * 16));
                        d[0] = (bf16_t)(p0 & 0xffffu); d[(size_t)L] = (bf16_t)(p0 >> 16); d[(size_t)2 * L] = (bf16_t)(p1 & 0xffffu); d[(size_t)3 * L] = (bf16_t)(p1 >> 16); }
    }
};
template <int L> struct EpiDft {
    bf16_t* FF; int tok0;
    __device__ __forceinline__ void operator()(const f32x4 (&acc)[2][2][4][2], const Unit& u, int wr, int wc, int fr, int fq) const {
        constexpr int H = L / 2;
        const size_t tokbase = (size_t)tok0 + (size_t)u.aux * L;
        const int c0 = wc * 32 + 8 * fq;
#pragma unroll
        for (int ai = 0; ai < 2; ++ai)
#pragma unroll
            for (int m = 0; m < 4; ++m) { const int r = u.pm * BM + ai * HALF + wr * 64 + m * 16 + fr; const int part = r > H ? 1 : 0, k = part ? r - H : r;
#pragma unroll
                for (int bj = 0; bj < 2; ++bj) { const int g = 2 * u.pn + bj; const f32x4 a0 = acc[ai][bj][m][0], a1 = acc[ai][bj][m][1];
                    const u32x4 pos = pack8(a0, a1);
                    bf16_t* d1 = FF + (tokbase + k) * 1024 + g * 256 + part * 128 + c0; *(PG8_GAS u32x4*)d1 = pos;
                    if (k != 0 && k != H) { bf16_t* d2 = FF + (tokbase + (L - k)) * 1024 + g * 256 + part * 128 + c0; u32x4 w = pos; if (part) { w.x ^= 0x80008000u; w.y ^= 0x80008000u; w.z ^= 0x80008000u; w.w ^= 0x80008000u; } *(PG8_GAS u32x4*)d2 = w; }
                    else if (!part) { bf16_t* d3 = FF + (tokbase + k) * 1024 + g * 256 + 128 + c0; *(PG8_GAS u32x4*)d3 = (u32x4){0u, 0u, 0u, 0u}; } } }
    }
};
constexpr float QSCALE = 0.125f * 1.4426950408889634f;
struct EpiQkv {
    bf16_t* Q; bf16_t* KA; bf16_t* VA; const float* rc; const float* rs; int is_ctx;
    __device__ __forceinline__ void operator()(const f32x4 (&acc)[2][2][4][2], const Unit& u, int wr, int wc, int fr, int fq) const {
        const int kind = u.pn >> 2, pt = u.pn & 3;
        const int rb = u.pm * BM;
        const int b = is_ctx ? rb / CTXL : rb / SEQ, s0 = is_ctx ? 0 : rb % SEQ;
        const size_t kvrow0 = (size_t)b * LKV + (is_ctx ? 0 : CTXL) + s0;
        const int lr0 = wr * 64 + fr;
        if (kind == 2) {
            const int col0 = pt * BM + wc * 32 + 8 * fq;
#pragma unroll
            for (int ai = 0; ai < 2; ++ai)
#pragma unroll
                for (int m = 0; m < 4; ++m) { bf16_t* rowp = VA + (kvrow0 + lr0 + ai * HALF + m * 16) * 1024 + col0;
#pragma unroll
                    for (int bj = 0; bj < 2; ++bj) *(PG8_GAS u32x4*)(rowp + bj * HALF) = pack8(acc[ai][bj][m][0], acc[ai][bj][m][1]); }
        } else {
            const int head = 2 * pt + (wc >> 1), comp = wc & 1, colb = head * 128 + comp * 64 + 8 * fq;
            const float sc = kind == 0 ? QSCALE : 1.f;
#pragma unroll
            for (int ai = 0; ai < 2; ++ai)
#pragma unroll
                for (int m = 0; m < 4; ++m) { const int lr = lr0 + ai * HALF + m * 16;
                    f32x4 o1[2], o2[2];
                    if (!is_ctx) { const float* pc = rc + (size_t)(s0 + lr) * 32 + 8 * fq; const float* ps = rs + (size_t)(s0 + lr) * 32 + 8 * fq;
#pragma unroll
                        for (int n = 0; n < 2; ++n) { const f32x4 cv = *(const PG8_GAS f32x4*)(pc + 4 * n), sv = *(const PG8_GAS f32x4*)(ps + 4 * n); const f32x4 x1 = acc[ai][0][m][n], x2 = acc[ai][1][m][n];
                            o1[n] = (x1 * cv - x2 * sv) * sc; o2[n] = (x2 * cv + x1 * sv) * sc; }
                    } else { o1[0] = acc[ai][0][m][0]; o1[1] = acc[ai][0][m][1]; o2[0] = acc[ai][1][m][0]; o2[1] = acc[ai][1][m][1]; }
                    bf16_t* d = (kind == 0 ? Q + (size_t)(rb + lr) * 1024 : KA + (kvrow0 + lr) * 1024) + colb;
                    *(u32x4*)d = pack8(o1[0], o1[1]); *(PG8_GAS u32x4*)(d + 32) = pack8(o2[0], o2[1]); }
        }
    }
};
}

namespace attn_body {
using bf16=__hip_bfloat16;
using bf16x8=__attribute__((ext_vector_type(8)))short;
using s16x4=__attribute__((ext_vector_type(4)))short;
using f32x16=__attribute__((ext_vector_type(16)))float;
using u32x4=__attribute__((ext_vector_type(4)))unsigned;
constexpr int D=64,DM=1024,DMO=2048;
constexpr int NW=8,NMAIN=4,QBLK=32,QB=QBLK*NMAIN,KVBLK=64;
constexpr int ATTN_PITCH=DM, ATTN_UNIT_ROWS=QB;
__device__ __forceinline__ int crow(int r,int hi){return (r&3)+8*(r>>2)+4*hi;}
#define SBAR() __builtin_amdgcn_sched_barrier(0)

constexpr int NSLOT=3, SLOTB=8192;
constexpr int LDS_K=0, LDS_V=NSLOT*SLOTB, LDS_P=LDS_V+NSLOT*2*SLOTB, LDS_WS=LDS_P+4*4096, LDS_FLAG=LDS_WS+NW*64*4, LDS_OST=LDS_FLAG+64, LDS_BYTES=LDS_OST+NW*4096;
constexpr float C2=0.125f*1.4426950408889634f;
__device__ __forceinline__ void glds16(const void*gsrc,unsigned lds_dst){unsigned keep;
  asm volatile("s_mov_b32 %0, m0\n\ts_mov_b32 m0, %2\n\ts_nop 0\n\tglobal_load_lds_dwordx4 %1, off\n\ts_mov_b32 m0, %0":"=&s"(keep):"v"(gsrc),"s"(lds_dst):"memory");}
__device__ __forceinline__ float max3f(float a,float b,float c){float r;asm("v_max3_f32 %0, %1, %2, %3":"=v"(r):"v"(a),"v"(b),"v"(c));return r;}
__device__ __forceinline__ float max2f(float a,float b){float r;asm("v_max_f32_e32 %0, %1, %2":"=v"(r):"v"(a),"v"(b));return r;}
__device__ __forceinline__ float fadd_s(float a,float b){float r;asm("v_add_f32_e32 %0, %1, %2":"=v"(r):"v"(a),"v"(b));return r;}
__device__ __forceinline__ float fsub_s(float a,float b){float r;asm("v_sub_f32_e32 %0, %1, %2":"=v"(r):"v"(a),"v"(b));return r;}
typedef float f32x2_t __attribute__((ext_vector_type(2))); typedef __bf16 bf16x2_t __attribute__((ext_vector_type(2)));
__device__ __forceinline__ unsigned cvtpk_s(float lo,float hi){f32x2_t v={lo,hi};bf16x2_t b=__builtin_convertvector(v,bf16x2_t);return __builtin_bit_cast(unsigned,b);}
#define WAIT_BAR(N) asm volatile("s_waitcnt vmcnt(" #N ") lgkmcnt(0)\n\ts_barrier":::"memory")

__device__ __forceinline__ void qkt(f32x16&p0,f32x16&p1,const char*Kslot,const bf16x8*qr,const f32x16&negm,int r32,int hi){
  const char*kb=Kslot+hi*1024+r32*16;
  #pragma unroll
  for(int d0=0;d0<4;++d0){
    const bf16x8 b0=*reinterpret_cast<const bf16x8*>(kb+d0*2048);
    const bf16x8 b1=*reinterpret_cast<const bf16x8*>(kb+d0*2048+512);
    if(d0==0){p0=__builtin_amdgcn_mfma_f32_32x32x16_bf16(b0,qr[0],negm,0,0,0);p1=__builtin_amdgcn_mfma_f32_32x32x16_bf16(b1,qr[0],negm,0,0,0);}
    else{p0=__builtin_amdgcn_mfma_f32_32x32x16_bf16(b0,qr[d0],p0,0,0,0);p1=__builtin_amdgcn_mfma_f32_32x32x16_bf16(b1,qr[d0],p1,0,0,0);}}
}
typedef __attribute__((address_space(3))) const char* lds_cptr;
typedef short v4i16_t __attribute__((ext_vector_type(4)));
__device__ __forceinline__ void kload8(bf16x8*kf,lds_cptr kp){
  kf[0]=*(const __attribute__((address_space(3))) bf16x8*)(kp);      kf[1]=*(const __attribute__((address_space(3))) bf16x8*)(kp+512);
  kf[2]=*(const __attribute__((address_space(3))) bf16x8*)(kp+2048); kf[3]=*(const __attribute__((address_space(3))) bf16x8*)(kp+2560);
  kf[4]=*(const __attribute__((address_space(3))) bf16x8*)(kp+4096); kf[5]=*(const __attribute__((address_space(3))) bf16x8*)(kp+4608);
  kf[6]=*(const __attribute__((address_space(3))) bf16x8*)(kp+6144); kf[7]=*(const __attribute__((address_space(3))) bf16x8*)(kp+6656);
}
__device__ __forceinline__ void kload2(bf16x8*kf,lds_cptr kp,int j){ kf[2*j]=*(const __attribute__((address_space(3))) bf16x8*)(kp+j*2048); kf[2*j+1]=*(const __attribute__((address_space(3))) bf16x8*)(kp+j*2048+512); }
__device__ __forceinline__ s16x4 vtr(lds_cptr p){ return __builtin_bit_cast(s16x4,__builtin_amdgcn_ds_read_tr16_b64_v4i16((__attribute__((address_space(3))) v4i16_t*)p)); }
__device__ __forceinline__ float rowmax(const f32x16&p0,const f32x16&p1){
  float a=max3f(p0[0],p0[1],p1[0]),b=max3f(p0[2],p0[3],p1[1]);a=max3f(a,p1[2],p1[3]);
  #pragma unroll
  for(int r=4;r<16;r+=4){a=max3f(a,p0[r],p0[r+1]);b=max3f(b,p0[r+2],p0[r+3]);a=max3f(a,p1[r],p1[r+1]);b=max3f(b,p1[r+2],p1[r+3]);}
  const float m=max2f(a,b);
  auto rr=__builtin_amdgcn_permlane32_swap(__float_as_uint(m),__float_as_uint(m),false,false);
  return max2f(__uint_as_float(rr[0]),__uint_as_float(rr[1]));
}
__device__ __forceinline__ void pv(f32x16*o,int vb,bf16x8 pa0,bf16x8 pa1,bf16x8 pa2,bf16x8 pa3){
  #pragma unroll
  for(int d0=0;d0<2;++d0){s16x4 lo[4],hi[4];
    #pragma unroll
    for(int ks=0;ks<4;++ks){
      asm volatile("ds_read_b64_tr_b16 %0,%1 offset:%c2":"=&v"(lo[ks]):"v"(vb),"i"(d0*4096+ks*1024):"memory");
      asm volatile("ds_read_b64_tr_b16 %0,%1 offset:%c2":"=&v"(hi[ks]):"v"(vb),"i"(d0*4096+ks*1024+512):"memory");}
    asm volatile("s_waitcnt lgkmcnt(0)":::"memory");SBAR();
    #define PK(k) (bf16x8){lo[k][0],lo[k][1],lo[k][2],lo[k][3],hi[k][0],hi[k][1],hi[k][2],hi[k][3]}
    o[d0]=__builtin_amdgcn_mfma_f32_32x32x16_bf16(pa0,PK(0),o[d0],0,0,0);
    o[d0]=__builtin_amdgcn_mfma_f32_32x32x16_bf16(pa1,PK(1),o[d0],0,0,0);
    o[d0]=__builtin_amdgcn_mfma_f32_32x32x16_bf16(pa2,PK(2),o[d0],0,0,0);
    o[d0]=__builtin_amdgcn_mfma_f32_32x32x16_bf16(pa3,PK(3),o[d0],0,0,0);
    #undef PK
  }
}

#ifndef ATTN_STORE16
#define ATTN_STORE16(p,v) __builtin_nontemporal_store((v),(__attribute__((address_space(1))) u32x4*)(p))
#endif
template<int THRL> __device__ __forceinline__ void attn_unit(const bf16*Qu,const bf16*__restrict__ Kh,const bf16*__restrict__ Vh,bf16*Ou,const int NT,char*shm){
  const int tid=threadIdx.x,lane=tid&63,r32=lane&31,hi=lane>>5; const int wid=__builtin_amdgcn_readfirstlane(tid>>6);
  const int pw_=wid&3;
  const bf16*Qw=Qu+(long)(pw_*QBLK)*DM;
  const unsigned lds0=(unsigned)(uintptr_t)shm;
  float*wsf=(float*)(shm+LDS_WS)+pw_*128;
  volatile __attribute__((address_space(3))) int*flagp=(volatile __attribute__((address_space(3))) int*)(shm+LDS_FLAG)+pw_;
  char*pbuf=shm+LDS_P+pw_*4096+lane*16;
  const bf16*ksrc=Kh+(long)lane*DM+wid*8;
  const bf16*vsrc=Vh+(long)(16*(wid&3)+(lane>>2))*DM+(wid>>2)*32+(lane&3)*8;
  const unsigned kdst=lds0+LDS_K+wid*1024, vdst=lds0+LDS_V+wid*1024;
  #define DMA_K(t,slot) glds16(ksrc+(long)(t)*KVBLK*DM,(unsigned)__builtin_amdgcn_readfirstlane(kdst+(slot)))
  #define DMA_V(t,slot) do{ glds16(vsrc+(long)(t)*KVBLK*DM,(unsigned)__builtin_amdgcn_readfirstlane(vdst+2*(slot))); glds16(vsrc+64+(long)(t)*KVBLK*DM,(unsigned)__builtin_amdgcn_readfirstlane(vdst+8192+2*(slot))); }while(0)
  const int vb0=(int)(lds0+LDS_V)+((lane>>4)&1)*32+(lane&3)*8+(4*hi+((lane&15)>>2))*64;
  const char*Kbase=shm+LDS_K; bf16x8 kf[8];
  const lds_cptr shm3=(lds_cptr)shm; const lds_cptr kp0=shm3+LDS_K+hi*1024+r32*16; const lds_cptr vp0=shm3+LDS_V+((lane>>4)&1)*32+(lane&3)*8+(4*hi+((lane&15)>>2))*64;
  DMA_K(0,0);DMA_V(0,0);DMA_K(1,SLOTB);
  int sl_prev=0,sl_cur=0,sl_next=SLOTB;
  #define ROT() do{sl_prev=sl_cur;sl_cur=sl_next;sl_next=(sl_next==(NSLOT-1)*SLOTB)?0:sl_next+SLOTB;}while(0)
  #define MIDBAR() asm volatile("s_waitcnt lgkmcnt(0)\n\ts_barrier":::"memory")
  #define ENDW(tt) do{ if((tt)+3<NT){WAIT_BAR(3);} else if((tt)+2<NT){WAIT_BAR(2);} else {WAIT_BAR(0);} }while(0)
  typedef __attribute__((address_space(3))) char* lds_ptr;
  const lds_ptr pb3=(lds_ptr)(pbuf);
  if(wid<NMAIN){
  bf16x8 qr[4];
  #pragma unroll
  for(int d0=0;d0<4;++d0)qr[d0]=__builtin_nontemporal_load((const __attribute__((address_space(1))) bf16x8*)(&Qw[(long)r32*DM+d0*16+hi*8]));
  float mhat=0.f,l_reg=0.f;f32x16 negm=f32x16{};asm volatile("":"+v"(negm));
  #define CMASK(P0,P1,t) do{}while(0)
  bool resc=false;
  #define START(P0,P1) do{ const float rm=rowmax(P0,P1); resc=false; \
    { const float dl=rm; mhat=fadd_s(mhat,dl); \
      _Pragma("unroll") for(int r=0;r<16;++r){P0[r]=fsub_s(P0[r],dl);P1[r]=fsub_s(P1[r],dl);} \
      _Pragma("unroll") for(int r=0;r<16;++r)negm[r]=-mhat; asm volatile("":"+v"(negm)); } \
    _Pragma("unroll") for(int r=0;r<16;++r)P0[r]=__builtin_amdgcn_exp2f(P0[r]); }while(0)
  #define RESC(par) do{}while(0)
  f32x16 pA0,pA1,pB0,pB1;
  DMA_K(2,2*SLOTB);
  WAIT_BAR(4);
  qkt(pA0,pA1,Kbase,qr,negm,r32,hi);asm volatile("s_nop 15\n\ts_nop 7":"+v"(pA0),"+v"(pA1));CMASK(pA0,pA1,0);
  START(pA0,pA1);
  _Pragma("unroll") for(int r=0;r<16;++r)pA1[r]=__builtin_amdgcn_exp2f(pA1[r]);
  WAIT_BAR(0);
  DMA_K(3,0);DMA_V(1,SLOTB);
  ROT();
  kload8(kf,kp0+sl_cur);
  WAIT_BAR(3);
  u32x4 pw0,pw1,pw2,pw3;
  #define PKW(P,B) cvtpk_s(P[B],P[B+1])
  #define PAF(k) __builtin_bit_cast(bf16x8,pw##k)
  #define VFR(i) (bf16x8){vlo[i][0],vlo[i][1],vlo[i][2],vlo[i][3],vhi[i][0],vhi[i][1],vhi[i][2],vhi[i][3]}
  #define PIN(x) asm volatile("":"+v"(x))
  #define MX3(a,b,c) __builtin_fmaxf(__builtin_fmaxf((a),(b)),(c))
  #define GAPA(MF,A0,A1,A2,A3,W0,W1,PW) do{ MF; sacc+=A0; sacc+=A1; sacc+=A2; sacc+=A3; PIN(sacc); W0; W1; PIN(PW); SBAR(); }while(0)
  #define EX(v) __builtin_amdgcn_exp2f(v)
  #define GAPB(X,B) do{ X[B]=EX(X[B]); X[B+1]=EX(X[B+1]); X[B+2]=EX(X[B+2]); X[B+3]=EX(X[B+3]); PIN(X); SBAR(); }while(0)
  #define VRD(i) do{ vlo[i]=vtr(vp_+(((i)>>2)*4096+((i)&3)*1024)); vhi[i]=vtr(vp_+(((i)>>2)*4096+((i)&3)*1024+512)); }while(0)
  #define KRD(G,j) do{ if(G){ kload2(kf,kp0+sl_next,j); SBAR(); } }while(0)
  #define STEP(C0,C1,P0,P1,t,GK,GV,GL) do{ SBAR(); \
    float sacc=(P0[0]+P0[1]); \
    GAPA(C0=__builtin_amdgcn_mfma_f32_32x32x16_bf16(kf[0],qr[0],negm,0,0,0), P0[2],P0[3],P0[4],P0[5],     pw0[0]=PKW(P0,0), pw0[1]=PKW(P0,2), pw0); \
    GAPA(C1=__builtin_amdgcn_mfma_f32_32x32x16_bf16(kf[1],qr[0],negm,0,0,0), P0[6],P0[7],P0[8],P0[9],     pw0[2]=PKW(P0,4), pw0[3]=PKW(P0,6), pw0); \
    GAPA(C0=__builtin_amdgcn_mfma_f32_32x32x16_bf16(kf[2],qr[1],C0,0,0,0),   P0[10],P0[11],P0[12],P0[13], pw1[0]=PKW(P0,8), pw1[1]=PKW(P0,10), pw1); \
    GAPA(C1=__builtin_amdgcn_mfma_f32_32x32x16_bf16(kf[3],qr[1],C1,0,0,0),   P0[14],P0[15],P1[0],P1[1],   pw1[2]=PKW(P0,12),pw1[3]=PKW(P0,14), pw1); \
    GAPA(C0=__builtin_amdgcn_mfma_f32_32x32x16_bf16(kf[4],qr[2],C0,0,0,0),   P1[2],P1[3],P1[4],P1[5],     pw2[0]=PKW(P1,0), pw2[1]=PKW(P1,2), pw2); \
    GAPA(C1=__builtin_amdgcn_mfma_f32_32x32x16_bf16(kf[5],qr[2],C1,0,0,0),   P1[6],P1[7],P1[8],P1[9],     pw2[2]=PKW(P1,4), pw2[3]=PKW(P1,6), pw2); \
    GAPA(C0=__builtin_amdgcn_mfma_f32_32x32x16_bf16(kf[6],qr[3],C0,0,0,0),   P1[10],P1[11],P1[12],P1[13], pw3[0]=PKW(P1,8), pw3[1]=PKW(P1,10), pw3); \
    GAPA(C1=__builtin_amdgcn_mfma_f32_32x32x16_bf16(kf[7],qr[3],C1,0,0,0),   P1[14],P1[15],0.f,0.f,       pw3[2]=PKW(P1,12),pw3[3]=PKW(P1,14), pw3); \
    l_reg+=sacc; \
    *(__attribute__((address_space(3))) u32x4*)(pb3)=pw0; *(__attribute__((address_space(3))) u32x4*)(pb3+1024)=pw1; *(__attribute__((address_space(3))) u32x4*)(pb3+2048)=pw2; *(__attribute__((address_space(3))) u32x4*)(pb3+3072)=pw3; \
    if(GK){DMA_K((t)+3,sl_cur);} if(GV){DMA_V((t)+1,sl_next);} \
    CMASK(C0,C1,t); \
    { float a=MX3(C0[0],C0[1],C1[0]),b=MX3(C0[2],C0[3],C1[1]); a=MX3(a,C1[2],C1[3]); \
      _Pragma("unroll") for(int r=4;r<16;r+=4){a=MX3(a,C0[r],C0[r+1]);b=MX3(b,C0[r+2],C0[r+3]);a=MX3(a,C1[r],C1[r+1]);b=MX3(b,C1[r+2],C1[r+3]);} \
      float rm=__builtin_fmaxf(a,b); { auto rr=__builtin_amdgcn_permlane32_swap(__float_as_uint(rm),__float_as_uint(rm),false,false); rm=__builtin_fmaxf(__uint_as_float(rr[0]),__uint_as_float(rr[1])); } \
      resc=false; \
      if(__builtin_expect(__any(rm>(float)THRL),0)){ const float dl=__builtin_fmaxf(rm,0.f); mhat+=dl; \
        _Pragma("unroll") for(int r=0;r<16;++r){C0[r]-=dl;C1[r]-=dl;} \
        _Pragma("unroll") for(int r=0;r<16;++r)negm[r]=-mhat; asm volatile("":"+v"(negm)); \
        const float f=__builtin_amdgcn_exp2f(-dl); l_reg*=f; if(hi==0)wsf[((t)&1)*32+r32]=f; resc=true; } } \
    if(lane==0)flagp[((t)&1)*4]=resc?1:0; \
    MIDBAR();   \
    SBAR(); \
    GAPB(C0,0); \
    GAPB(C0,4); \
    KRD(GL,0); GAPB(C0,8); \
    KRD(GL,1); GAPB(C0,12); \
    KRD(GL,2); GAPB(C1,0); \
    KRD(GL,3); GAPB(C1,4); \
    GAPB(C1,8); \
    GAPB(C1,12); \
    }while(0)
  int t=1;
  for(;t+5<NT;t+=2){
    STEP(pB0,pB1,pA0,pA1,t,true,true,true);     WAIT_BAR(3); RESC(1); ROT();
    STEP(pA0,pA1,pB0,pB1,t+1,true,true,true);   WAIT_BAR(3); RESC(0); ROT();
  }
  for(;t+1<NT;t+=2){
    STEP(pB0,pB1,pA0,pA1,t,(t+3<NT),(t+1<NT),(t+1<NT));       ENDW(t);   RESC(1); ROT();
    STEP(pA0,pA1,pB0,pB1,t+1,(t+4<NT),(t+2<NT),(t+2<NT));     ENDW(t+1); RESC(0); ROT();
  }
  STEP(pB0,pB1,pA0,pA1,NT-1,false,false,false); RESC(1);
  { float sacc=pB0[0]+pB0[1]; _Pragma("unroll") for(int r=2;r<16;++r)sacc+=pB0[r]; _Pragma("unroll") for(int r=0;r<16;++r)sacc+=pB1[r]; l_reg+=sacc;
    pw0=(u32x4){PKW(pB0,0),PKW(pB0,2),PKW(pB0,4),PKW(pB0,6)};pw1=(u32x4){PKW(pB0,8),PKW(pB0,10),PKW(pB0,12),PKW(pB0,14)};pw2=(u32x4){PKW(pB1,0),PKW(pB1,2),PKW(pB1,4),PKW(pB1,6)};pw3=(u32x4){PKW(pB1,8),PKW(pB1,10),PKW(pB1,12),PKW(pB1,14)};
    *(__attribute__((address_space(3))) u32x4*)(pb3)=pw0; *(__attribute__((address_space(3))) u32x4*)(pb3+1024)=pw1; *(__attribute__((address_space(3))) u32x4*)(pb3+2048)=pw2; *(__attribute__((address_space(3))) u32x4*)(pb3+3072)=pw3;
    MIDBAR(); }
  #undef PKW
  #undef PAF
  #undef VFR
  #undef PIN
  #undef MX3
  #undef GAPA
  #undef GAPB
  #undef EX
  #undef VRD
  #undef KRD
  #undef STEP
  {auto rr=__builtin_amdgcn_permlane32_swap(__float_as_uint(l_reg),__float_as_uint(l_reg),false,false);l_reg=__uint_as_float(rr[0])+__uint_as_float(rr[1]);}
  if(hi==0)wsf[64+r32]=l_reg;asm volatile("s_waitcnt lgkmcnt(0)\n\ts_barrier":::"memory");
  }else{
    f32x16 o2[4];o2[0]=f32x16{};o2[1]=f32x16{};o2[2]=f32x16{};o2[3]=f32x16{};
    const lds_cptr vq0=vp0;
    DMA_K(2,2*SLOTB);
    WAIT_BAR(4);
    WAIT_BAR(0);
    DMA_K(3,0);DMA_V(1,SLOTB);
    ROT();
    WAIT_BAR(3);
    #define HRESC(par) do{ if(flagp[(par)*4]){ _Pragma("unroll") for(int d_=0;d_<4;++d_) _Pragma("unroll") for(int r=0;r<16;++r)o2[d_][r]*=wsf[(par)*32+crow(r,hi)]; } }while(0)
    #define HVF(i) (bf16x8){hl[i][0],hl[i][1],hl[i][2],hl[i][3],hh[i][0],hh[i][1],hh[i][2],hh[i][3]}
    #define HPV(vbase) do{ s16x4 hl[16],hh[16]; const lds_cptr vp_=(vbase); \
      _Pragma("unroll") for(int i=0;i<16;++i){ hl[i]=vtr(vp_+((i>>2)*4096+(i&3)*1024)); hh[i]=vtr(vp_+((i>>2)*4096+(i&3)*1024+512)); } \
      MIDBAR(); \
      const bf16x8 pa0=*(const __attribute__((address_space(3))) bf16x8*)(pb3),pa1=*(const __attribute__((address_space(3))) bf16x8*)(pb3+1024),pa2=*(const __attribute__((address_space(3))) bf16x8*)(pb3+2048),pa3=*(const __attribute__((address_space(3))) bf16x8*)(pb3+3072); \
      o2[0]=__builtin_amdgcn_mfma_f32_32x32x16_bf16(pa0,HVF(0),o2[0],0,0,0); o2[1]=__builtin_amdgcn_mfma_f32_32x32x16_bf16(pa0,HVF(4),o2[1],0,0,0); o2[2]=__builtin_amdgcn_mfma_f32_32x32x16_bf16(pa0,HVF(8),o2[2],0,0,0); o2[3]=__builtin_amdgcn_mfma_f32_32x32x16_bf16(pa0,HVF(12),o2[3],0,0,0); o2[0]=__builtin_amdgcn_mfma_f32_32x32x16_bf16(pa1,HVF(1),o2[0],0,0,0); o2[1]=__builtin_amdgcn_mfma_f32_32x32x16_bf16(pa1,HVF(5),o2[1],0,0,0); o2[2]=__builtin_amdgcn_mfma_f32_32x32x16_bf16(pa1,HVF(9),o2[2],0,0,0); o2[3]=__builtin_amdgcn_mfma_f32_32x32x16_bf16(pa1,HVF(13),o2[3],0,0,0); o2[0]=__builtin_amdgcn_mfma_f32_32x32x16_bf16(pa2,HVF(2),o2[0],0,0,0); o2[1]=__builtin_amdgcn_mfma_f32_32x32x16_bf16(pa2,HVF(6),o2[1],0,0,0); o2[2]=__builtin_amdgcn_mfma_f32_32x32x16_bf16(pa2,HVF(10),o2[2],0,0,0); o2[3]=__builtin_amdgcn_mfma_f32_32x32x16_bf16(pa2,HVF(14),o2[3],0,0,0); o2[0]=__builtin_amdgcn_mfma_f32_32x32x16_bf16(pa3,HVF(3),o2[0],0,0,0); o2[1]=__builtin_amdgcn_mfma_f32_32x32x16_bf16(pa3,HVF(7),o2[1],0,0,0); o2[2]=__builtin_amdgcn_mfma_f32_32x32x16_bf16(pa3,HVF(11),o2[2],0,0,0); o2[3]=__builtin_amdgcn_mfma_f32_32x32x16_bf16(pa3,HVF(15),o2[3],0,0,0); }while(0)
    #define HSTEP(t,GK,GV) do{ if((t)>1){ HRESC(((t)-1)&1); } \
      if(GK){DMA_K((t)+3,sl_cur);} if(GV){DMA_V((t)+1,sl_next);} \
      HPV(vq0+2*sl_prev); }while(0)
    int t=1;
    for(;t+5<NT;t+=2){
      HSTEP(t,true,true);     WAIT_BAR(3); ROT();
      HSTEP(t+1,true,true);   WAIT_BAR(3); ROT();
    }
    for(;t+1<NT;t+=2){
      HSTEP(t,(t+3<NT),(t+1<NT));       ENDW(t);   ROT();
      HSTEP(t+1,(t+4<NT),(t+2<NT));     ENDW(t+1); ROT();
    }
    HSTEP(NT-1,false,false);
    { s16x4 hl[16],hh[16]; const lds_cptr vp_=vq0+2*sl_cur;
      _Pragma("unroll") for(int i=0;i<16;++i){ hl[i]=vtr(vp_+((i>>2)*4096+(i&3)*1024)); hh[i]=vtr(vp_+((i>>2)*4096+(i&3)*1024+512)); }
      MIDBAR();
      HRESC((NT-1)&1);
      const bf16x8 pa0=*(const __attribute__((address_space(3))) bf16x8*)(pb3),pa1=*(const __attribute__((address_space(3))) bf16x8*)(pb3+1024),pa2=*(const __attribute__((address_space(3))) bf16x8*)(pb3+2048),pa3=*(const __attribute__((address_space(3))) bf16x8*)(pb3+3072);
      o2[0]=__builtin_amdgcn_mfma_f32_32x32x16_bf16(pa0,HVF(0),o2[0],0,0,0); o2[1]=__builtin_amdgcn_mfma_f32_32x32x16_bf16(pa0,HVF(4),o2[1],0,0,0); o2[2]=__builtin_amdgcn_mfma_f32_32x32x16_bf16(pa0,HVF(8),o2[2],0,0,0); o2[3]=__builtin_amdgcn_mfma_f32_32x32x16_bf16(pa0,HVF(12),o2[3],0,0,0); o2[0]=__builtin_amdgcn_mfma_f32_32x32x16_bf16(pa1,HVF(1),o2[0],0,0,0); o2[1]=__builtin_amdgcn_mfma_f32_32x32x16_bf16(pa1,HVF(5),o2[1],0,0,0); o2[2]=__builtin_amdgcn_mfma_f32_32x32x16_bf16(pa1,HVF(9),o2[2],0,0,0); o2[3]=__builtin_amdgcn_mfma_f32_32x32x16_bf16(pa1,HVF(13),o2[3],0,0,0); o2[0]=__builtin_amdgcn_mfma_f32_32x32x16_bf16(pa2,HVF(2),o2[0],0,0,0); o2[1]=__builtin_amdgcn_mfma_f32_32x32x16_bf16(pa2,HVF(6),o2[1],0,0,0); o2[2]=__builtin_amdgcn_mfma_f32_32x32x16_bf16(pa2,HVF(10),o2[2],0,0,0); o2[3]=__builtin_amdgcn_mfma_f32_32x32x16_bf16(pa2,HVF(14),o2[3],0,0,0); o2[0]=__builtin_amdgcn_mfma_f32_32x32x16_bf16(pa3,HVF(3),o2[0],0,0,0); o2[1]=__builtin_amdgcn_mfma_f32_32x32x16_bf16(pa3,HVF(7),o2[1],0,0,0); o2[2]=__builtin_amdgcn_mfma_f32_32x32x16_bf16(pa3,HVF(11),o2[2],0,0,0); o2[3]=__builtin_amdgcn_mfma_f32_32x32x16_bf16(pa3,HVF(15),o2[3],0,0,0); }
    asm volatile("s_waitcnt lgkmcnt(0)\n\ts_barrier":::"memory");
    float rli[16];
    #pragma unroll
    for(int r=0;r<16;++r)rli[r]=__builtin_amdgcn_rcpf(wsf[64+crow(r,hi)]);
    bf16*Ow=Ou+(long)(pw_*QBLK)*DMO;
    #pragma unroll
    for(int hf=0;hf<2;++hf){ bf16*stg=(bf16*)(shm+LDS_OST)+wid*2048;
      #pragma unroll
      for(int r=0;r<16;++r){const int orow=crow(r,hi);
        #pragma unroll
        for(int d0=0;d0<2;++d0)stg[orow*64+d0*32+r32]=__float2bfloat16(o2[2*hf+d0][r]*rli[r]);}
      asm volatile("s_waitcnt lgkmcnt(0)":::"memory");
      #pragma unroll
      for(int i=0;i<4;++i){const int row=i*8+(lane>>3),ch=lane&7; const u32x4 v=*(const u32x4*)(stg+row*64+ch*8); ATTN_STORE16(Ow+(long)row*DMO+hf*64+ch*8,v);}
      asm volatile("s_waitcnt lgkmcnt(0)":::"memory"); }
    #undef HRESC
    #undef HVF
    #undef HPV
    #undef HSTEP
  }
  asm volatile("s_waitcnt lgkmcnt(0)\n\ts_barrier":::"memory");
  #undef DMA_K
  #undef DMA_V
  #undef CMASK
  #undef START
  #undef RESC
  #undef ROT
  #undef MIDBAR
  #undef ENDW
}
constexpr int ATTN_LDS_BYTES=LDS_BYTES;
#undef SBAR
#undef WAIT_BAR
}

constexpr int NWAVES = 8;
#ifndef DBG_LAST_PHASE
#define DBG_LAST_PHASE 25
#endif
constexpr int NPHASES = 26;

constexpr size_t MiB = 1u << 20;
constexpr size_t WS_CTL = 0, CTL_ZERO_BYTES = 1 * MiB;
constexpr size_t WS_MOD = 1 * MiB;
constexpr size_t WS_ROPE = 2 * MiB;
constexpr size_t WS_WIN = 3 * MiB;
constexpr size_t WS_WOUT = 6 * MiB;
constexpr size_t WS_WQKV = 8 * MiB;
constexpr size_t WS_WDAO = 14 * MiB;
constexpr size_t WS_SHUP = 16 * MiB;
constexpr size_t WS_SHDN = 18 * MiB;
constexpr size_t WS_WRT = 19 * MiB;
constexpr size_t WS_TABC = 19 * MiB + 512 * 1024;
constexpr size_t WS_BD = 20 * MiB;
constexpr size_t WS_LIST = 21 * MiB;
constexpr size_t WS_TOKSLOT = 29 * MiB + 512 * 1024;
constexpr size_t WS_TOKGATE = 30 * MiB + 768 * 1024;
constexpr size_t WS_CTXRES = 32 * MiB;
constexpr size_t WS_WEDN = 40 * MiB;
constexpr size_t WS_WEUP = 72 * MiB;
constexpr size_t WS_HX = 136 * MiB;
constexpr size_t WS_HID = 204 * MiB;
constexpr size_t WS_YEXP = 272 * MiB;
constexpr size_t WS_END = 542 * MiB;
constexpr size_t WS_TAB = 204 * MiB;
constexpr size_t WS_AGLU = 236 * MiB;
constexpr size_t WS_FT = 272 * MiB;
constexpr size_t WS_FTC = 304 * MiB;
constexpr size_t WS_FF = 306 * MiB;
constexpr size_t WS_MIX = 374 * MiB;
constexpr size_t WS_Y = 442 * MiB;
constexpr size_t WS_TOKLO = 272 * MiB;
constexpr size_t WS_Q = 204 * MiB;
constexpr size_t WS_OC = 272 * MiB;
constexpr size_t WS_KALL = 400 * MiB;
constexpr size_t WS_VALL = 468 * MiB;
constexpr size_t WS_Y1 = 400 * MiB;
static_assert(WS_LIST + (size_t)NCH * 64 * CAP * 4 <= WS_TOKSLOT && WS_TOKSLOT + (size_t)T0 * 32 <= WS_TOKGATE && WS_TOKGATE + (size_t)T0 * 32 <= WS_CTXRES, "lists");
constexpr int CW_TMO = 0, CW_CODE = 1, CW_BAR = 4096, CW_CNT = 16384, CNT_STRIDE = 64;

constexpr int RING_OFF = 0, RING_BYTES = 131072;
constexpr int LDSCTL_OFF = RING_BYTES, MISC_OFF = LDSCTL_OFF + 320, INPTR_OFF = LDSCTL_OFF + 512, TBL_OFF = LDSCTL_OFF + 1024;
constexpr int LDS_BYTES = 147456;

#define GAS __attribute__((address_space(1)))
#define LAS __attribute__((address_space(3)))
typedef unsigned short bf16;
typedef unsigned v4u __attribute__((ext_vector_type(4)));
typedef unsigned v2u __attribute__((ext_vector_type(2)));
typedef float f32x4 __attribute__((ext_vector_type(4)));
typedef short bf16x8 __attribute__((ext_vector_type(8)));
typedef GAS unsigned gu32;
#define RLX_AGENT __ATOMIC_RELAXED, __HIP_MEMORY_SCOPE_AGENT
#define LDS_WAIT() asm volatile("s_waitcnt lgkmcnt(0)" ::: "memory")
#define VM_WAIT() asm volatile("s_waitcnt vmcnt(0)" ::: "memory")
__device__ __forceinline__ unsigned f2bf(float f) { unsigned u = __builtin_bit_cast(unsigned, f); return (u + 0x7fffu + ((u >> 16) & 1u)) >> 16; }
__device__ __forceinline__ float bf2f(unsigned b) { return __builtin_bit_cast(float, b << 16); }
__device__ __forceinline__ unsigned pk2(float lo, float hi) { return f2bf(lo) | (f2bf(hi) << 16); }

#define XB_TMO      128
#define XB_XCNT(j)  (256  + 64 * (j))
#define XB_XSUB(j)  (1280 + 64 * (j))
#define XB_XGEN(j)  (2304 + 64 * (j))
#define XB_TOP      3328
#define XB_TOPGEN   3392
#define XCD_BAR_WORDS 3456
#define XB_SPIN_CAP (1u << 18)

__device__ __forceinline__ unsigned xb_ld(unsigned* p)              { return __hip_atomic_load(p, __ATOMIC_RELAXED, __HIP_MEMORY_SCOPE_AGENT); }
__device__ __forceinline__ unsigned xb_add(unsigned* p, unsigned v) { return __hip_atomic_fetch_add(p, v, __ATOMIC_RELAXED, __HIP_MEMORY_SCOPE_AGENT); }
__device__ __forceinline__ unsigned xb_xcc_id() { return (unsigned)__builtin_amdgcn_s_getreg((3 << 11) | 20) & 0xFu; }
#define XB_SPIN(cond, bar) do { unsigned _sp = 0; while (cond) { __builtin_amdgcn_s_sleep(1); \
    if ((++_sp & 255u) == 0u) { if (xb_ld(&(bar)[XB_TMO])) break; if (_sp > XB_SPIN_CAP) { atomicAdd(&(bar)[XB_TMO], 1u); break; } } } } while (0)

struct XcdBarrier {
    unsigned* bar; unsigned x;
    volatile LAS unsigned* st;
};

__device__ __forceinline__ XcdBarrier xcd_barrier_post(unsigned* bar, volatile LAS unsigned* st) {
    XcdBarrier b; b.bar = bar; b.x = xb_xcc_id(); b.st = st;
    if (threadIdx.x == 0) (void)xb_add(&bar[XB_XCNT(b.x)], 1u);
    return b;
}
__device__ __forceinline__ void xcd_barrier_complete(unsigned* bar, unsigned x, unsigned& nloc, unsigned& nx) {
    const unsigned G = gridDim.x * gridDim.y * gridDim.z;
    unsigned sum, cnt, mine, sp = 0u;
    for (;;) {
        sum = 0u; cnt = 0u; mine = 0u;
#pragma unroll
        for (unsigned j = 0; j < 16; ++j) { const unsigned c = xb_ld(&bar[XB_XCNT(j)]); sum += c; cnt += (c > 0u) ? 1u : 0u; mine = (j == x) ? c : mine; }
        if (sum == G) break;
        __builtin_amdgcn_s_sleep(1);
        if ((++sp & 255u) == 0u) { if (xb_ld(&bar[XB_TMO])) break; if (sp > XB_SPIN_CAP) { atomicAdd(&bar[XB_TMO], 1u); break; } }
    }
    nloc = mine > 0u ? mine : 1u; nx = cnt > 0u ? cnt : 1u;
}

__device__ __forceinline__ void xcd_barrier(const XcdBarrier& b) {
    asm volatile("s_waitcnt vmcnt(0)" ::: "memory");
    __syncthreads();
    if (threadIdx.x == 0) {
        unsigned* bar = b.bar;
        __builtin_amdgcn_s_waitcnt(0);
        unsigned nloc = b.st[0], nx = b.st[1];
        if (nloc == 0u) { xcd_barrier_complete(bar, b.x, nloc, nx); b.st[0] = nloc; b.st[1] = nx; }
        const unsigned old = xb_add(&bar[XB_XSUB(b.x)], 1u);
        const unsigned gen = old / nloc;
        if (old + 1u == (gen + 1u) * nloc) {
            __builtin_amdgcn_fence(__ATOMIC_RELEASE, "agent");
            asm volatile("s_waitcnt vmcnt(0)" ::: "memory");
            const unsigned og = xb_add(&bar[XB_TOP], 1u);
            const unsigned tg = og / nx;
            if (og + 1u == (tg + 1u) * nx) xb_add(&bar[XB_TOPGEN], 1u);
            else XB_SPIN(xb_ld(&bar[XB_TOPGEN]) == tg, bar);
            __builtin_amdgcn_fence(__ATOMIC_ACQUIRE, "agent");
            xb_add(&bar[XB_XGEN(b.x)], 1u);
            asm volatile("s_waitcnt vmcnt(0)" ::: "memory");
        } else {
            XB_SPIN(xb_ld(&bar[XB_XGEN(b.x)]) == gen, bar);
            __builtin_amdgcn_fence(__ATOMIC_ACQUIRE, "agent");
            asm volatile("s_waitcnt vmcnt(0)" ::: "memory");
        }
    }
    __syncthreads();
}

struct Frame {
    LAS unsigned char* lds;
    volatile LAS unsigned* MISC;
    gu32* ctl;
    unsigned char* ws;
    int tid, lane, wave, vcu, G;
    float* out;
};
template <class T> __device__ __forceinline__ T* wsp(const Frame& F, size_t off) { return (T*)(F.ws + off); }
enum { I_X = 0, I_C, I_CTX, I_CCTX, I_ADAW, I_ADAB, I_NORMG, I_WIN, I_CONVW, I_CONVB, I_LNG, I_LNB, I_WOUT, I_WQKV, I_LAMBDA, I_SUBLNG, I_DAWOUT, I_RTW, I_RTB, I_WGATE, I_WUP, I_WDOWN, I_SHG, I_SHU, I_SHD };
__device__ __forceinline__ const float* inp(const Frame& F, int i) { const LAS unsigned* t = (const LAS unsigned*)(F.lds + INPTR_OFF) + 2 * i;
    const unsigned lo = __builtin_amdgcn_readfirstlane(t[0]), hi = __builtin_amdgcn_readfirstlane(t[1]); return (const float*)(const GAS float*)(((unsigned long long)hi << 32) | lo); }
#define FENCE(F) do { int t_ = threadIdx.x; asm volatile("" : "+v"(t_)); F.tid = t_; F.lane = t_ & 63; F.wave = __builtin_amdgcn_readfirstlane(t_ >> 6); asm volatile("" : "+s"(F.ws), "+s"(F.out), "+s"(F.ctl) :: "memory"); F.ws = (unsigned char*)(GAS unsigned char*)F.ws; F.out = (float*)(GAS float*)F.out; } while (0)

__device__ __forceinline__ float wave_sum(float v) {
#pragma unroll
    for (int o = 1; o < 64; o <<= 1) v += __shfl_xor(v, o);
    return v;
}
__device__ __forceinline__ void ldrow_f32(const float* p, int lane, f32x4 (&v)[4]) { const GAS f32x4* q = (const GAS f32x4*)p + lane;
#pragma unroll
    for (int j = 0; j < 4; ++j) v[j] = q[64 * j]; }
__device__ __forceinline__ void ldrow_bf16(const bf16* p, int lane, f32x4 (&v)[4]) { const GAS v2u* q = (const GAS v2u*)p + lane;
#pragma unroll
    for (int j = 0; j < 4; ++j) { const v2u w = q[64 * j]; v[j] = (f32x4){bf2f(w.x & 0xffffu), bf2f(w.x >> 16), bf2f(w.y & 0xffffu), bf2f(w.y >> 16)}; } }
__device__ __forceinline__ void strow_f32(float* p, int lane, const f32x4 (&v)[4]) { GAS f32x4* q = (GAS f32x4*)p + lane;
#pragma unroll
    for (int j = 0; j < 4; ++j) q[64 * j] = v[j]; }
__device__ __forceinline__ void strow_bf16(bf16* p, int lane, const f32x4 (&v)[4]) { GAS v2u* q = (GAS v2u*)p + lane;
#pragma unroll
    for (int j = 0; j < 4; ++j) q[64 * j] = (v2u){pk2(v[j].x, v[j].y), pk2(v[j].z, v[j].w)}; }
__device__ __forceinline__ float rstd_of(const f32x4 (&v)[4]) { float s = 0.f;
#pragma unroll
    for (int j = 0; j < 4; ++j) s += (v[j].x * v[j].x + v[j].y * v[j].y) + (v[j].z * v[j].z + v[j].w * v[j].w);
    return rsqrtf(wave_sum(s) * (1.f / DM) + EPSN); }
__device__ __forceinline__ void modnorm(const f32x4 (&v)[4], float rstd, const float* g, const float* shift, const float* scale, int lane, f32x4 (&o)[4]) {
    f32x4 gg[4], sh[4], sc[4]; ldrow_f32(g, lane, gg); ldrow_f32(shift, lane, sh); ldrow_f32(scale, lane, sc);
#pragma unroll
    for (int j = 0; j < 4; ++j) o[j] = v[j] * rstd * gg[j] * (sc[j] + 1.f) + sh[j]; }
__device__ __forceinline__ const float* modp(const Frame& F, int layer, int rb, int j) { return wsp<const float>(F, WS_MOD) + ((size_t)(layer * 9 + rb) * 6 + j) * 1024; }
__device__ __forceinline__ int rowbatch(int row) { return row < TL ? row / SEQ : 8; }

__device__ __forceinline__ int maprow(int mode, int n) {
    if (mode == 1) { if (n < 512) return 256 * (n >> 7) + (n & 127); if (n < 1024) { const int q = n - 512; return 256 * (q >> 7) + 128 + (q & 127); } return n; }
    if (mode == 2) { if (n < 2048) { const int blk = n >> 10, q = n & 1023, h = q >> 7, comp = (q >> 6) & 1, d = q & 63, bj = d >> 5, dd = d & 31, g = (h & 1) * 2 + comp; return blk * 1024 + 256 * (h >> 1) + 128 * bj + 32 * g + dd; } return n; }
    if (mode == 3) return 256 * (n >> 7) + (n & 127);
    if (mode == 4) return 256 * (n >> 7) + 128 + (n & 127);
    return n;
}
__device__ __forceinline__ void p0_transpose_item(const float* W, int K, int N, bf16* WT, int mode, LAS float* scr, int item, int lane) {
    const int nblk = N / 32, kb = item / nblk, nb = item % nblk, k0 = 64 * kb, n0 = 32 * nb;
#pragma unroll 8
    for (int i = 0; i < 32; ++i) { const int kk = 2 * i + (lane >> 5); scr[kk * 33 + (lane & 31)] = ((const GAS float*)W)[(size_t)(k0 + kk) * N + n0 + (lane & 31)]; }
    LDS_WAIT(); asm volatile("" ::: "memory");
    const int c = lane & 7;
#pragma unroll
    for (int j = 0; j < 4; ++j) { const int n = (lane >> 3) + 8 * j; const LAS float* s = scr + (8 * c) * 33 + n;
        v4u o; o.x = pk2(s[0 * 33], s[1 * 33]); o.y = pk2(s[2 * 33], s[3 * 33]); o.z = pk2(s[4 * 33], s[5 * 33]); o.w = pk2(s[6 * 33], s[7 * 33]);
        *(GAS v4u*)(WT + (size_t)maprow(mode, n0 + n) * K + k0 + 8 * c) = o; }
    LDS_WAIT(); asm volatile("" ::: "memory");
}
__device__ __forceinline__ void p0_router_item(const float* W, bf16* HI, bf16* LO, LAS float* scr, int item, int lane) {
    const int kb = item >> 1, nb = item & 1, k0 = 64 * kb, n0 = 32 * nb;
#pragma unroll 8
    for (int i = 0; i < 32; ++i) { const int kk = 2 * i + (lane >> 5); scr[kk * 33 + (lane & 31)] = ((const GAS float*)W)[(size_t)(k0 + kk) * 64 + n0 + (lane & 31)]; }
    LDS_WAIT(); asm volatile("" ::: "memory");
    const int c = lane & 7;
#pragma unroll
    for (int j = 0; j < 4; ++j) { const int n = (lane >> 3) + 8 * j; const LAS float* s = scr + (8 * c) * 33 + n;
        unsigned h[8], l[8];
#pragma unroll
        for (int q = 0; q < 8; ++q) { const float w = s[q * 33]; h[q] = f2bf(w); l[q] = f2bf(w - bf2f(h[q])); }
        v4u oh, ol; oh.x = h[0] | (h[1] << 16); oh.y = h[2] | (h[3] << 16); oh.z = h[4] | (h[5] << 16); oh.w = h[6] | (h[7] << 16);
        ol.x = l[0] | (l[1] << 16); ol.y = l[2] | (l[3] << 16); ol.z = l[4] | (l[5] << 16); ol.w = l[6] | (l[7] << 16);
        *(GAS v4u*)(HI + (size_t)(n0 + n) * 1024 + k0 + 8 * c) = oh; *(GAS v4u*)(LO + (size_t)(n0 + n) * 1024 + k0 + 8 * c) = ol; }
    LDS_WAIT(); asm volatile("" ::: "memory");
}
__device__ __forceinline__ void convert_experts(Frame& F, int layer) {
    LAS float* scr = (LAS float*)(F.lds + RING_OFF + F.wave * 16384);
    const int gw = F.vcu * NWAVES + F.wave, NGW = F.G * NWAVES;
    bf16* UP = wsp<bf16>(F, WS_WEUP); bf16* DN = wsp<bf16>(F, WS_WEDN);
    for (int it = gw; it < 64 * 384; it += NGW) {
        const int e = it / 384, r = it % 384; const size_t eo = (size_t)(layer * 64 + e) * 1024 * 256;
        if (r < 128) p0_transpose_item(inp(F, I_WGATE) + eo, 1024, 256, UP + (size_t)e * 512 * 1024, 3, scr, r, F.lane);
        else if (r < 256) p0_transpose_item(inp(F, I_WUP) + eo, 1024, 256, UP + (size_t)e * 512 * 1024, 4, scr, r - 128, F.lane);
        else p0_transpose_item(inp(F, I_WDOWN) + eo, 256, 1024, DN + (size_t)e * 1024 * 256, 0, scr, r - 256, F.lane);
    }
}
__device__ __forceinline__ float silu(float v) { return v / (1.f + __expf(-v)); }

__device__ __forceinline__ void p0_prologue(Frame& F) {
    __syncthreads();
#ifndef P0_PARTS
#define P0_PARTS 15
#endif
    if (P0_PARTS & 1)
    {
        LAS float* sc = (LAS float*)(F.lds);
        LAS float* part = (LAS float*)(F.lds + 40960);
        for (int i = F.tid; i < 9 * 1024; i += 512) { const int r = i >> 10, k = i & 1023; sc[i] = silu(r < 8 ? inp(F, I_C)[r * 1024 + k] : inp(F, I_CCTX)[k]); }
        __syncthreads();
        for (int item = F.vcu; item < 192; item += F.G) {
            const int layer = item / 96, col = (item % 96) * 64 + F.lane;
            const float* W = inp(F, I_ADAW) + (size_t)layer * 1024 * 6144 + col;
            float a[9];
#pragma unroll
            for (int r = 0; r < 9; ++r) a[r] = 0.f;
#pragma unroll 8
            for (int kk = 0; kk < 128; ++kk) { const int k = F.wave * 128 + kk; const float w = W[(size_t)k * 6144];
#pragma unroll
                for (int r = 0; r < 9; ++r) a[r] += sc[r * 1024 + k] * w; }
#pragma unroll
            for (int r = 0; r < 9; ++r) part[(F.wave * 9 + r) * 64 + F.lane] = a[r];
            __syncthreads();
            for (int i = F.tid; i < 576; i += 512) { const int r = i >> 6, l = i & 63; float s = 0.f;
#pragma unroll
                for (int w = 0; w < 8; ++w) s += part[(w * 9 + r) * 64 + l];
                const int cc = (item % 96) * 64 + l;
                wsp<float>(F, WS_MOD)[(size_t)(layer * 9 + r) * 6144 + cc] = s + inp(F, I_ADAB)[layer * 6144 + cc]; }
            __syncthreads();
        }
        __syncthreads();
    }
    LAS float* scr = (LAS float*)(F.lds + RING_OFF + F.wave * 16384);
    const int gw = F.vcu * NWAVES + F.wave, NGW = F.G * NWAVES;
    constexpr int NI_IN = 16 * 48, NI_OUT = 16 * 32, NI_QKV = 16 * 96, NI_DAO = 16 * 32, NI_SHG = 16 * 8, NI_SHD = 4 * 32, NI_RT = 32;
    constexpr int NI_TAB = 4096, NI_TABC = 256, NI_BD = 512, NI_ROPE = 2048;
    constexpr int NITEMS = NI_IN + NI_OUT + NI_QKV + NI_DAO + 4 * NI_SHG + 2 * NI_SHD + 2 * NI_RT + NI_TAB + NI_TABC + NI_BD + NI_ROPE;
#ifndef P0_IT_LO
#define P0_IT_LO 0
#define P0_IT_HI 1000000
#endif
    if (P0_PARTS & 2)
    for (int it = gw; it < NITEMS; it += NGW) {
        int r = it; if (it < P0_IT_LO || it >= P0_IT_HI) continue;
        if (r < NI_IN) { p0_transpose_item(inp(F, I_WIN), 1024, 1536, wsp<bf16>(F, WS_WIN), 1, scr, r, F.lane); continue; } r -= NI_IN;
        if (r < NI_OUT) { p0_transpose_item(inp(F, I_WOUT), 1024, 1024, wsp<bf16>(F, WS_WOUT), 0, scr, r, F.lane); continue; } r -= NI_OUT;
        if (r < NI_QKV) { p0_transpose_item(inp(F, I_WQKV), 1024, 3072, wsp<bf16>(F, WS_WQKV), 2, scr, r, F.lane); continue; } r -= NI_QKV;
        if (r < NI_DAO) { p0_transpose_item(inp(F, I_DAWOUT), 1024, 1024, wsp<bf16>(F, WS_WDAO), 0, scr, r, F.lane); continue; } r -= NI_DAO;
        if (r < 4 * NI_SHG) { const int l = r / (2 * NI_SHG), q = r % (2 * NI_SHG);
            if (q < NI_SHG) p0_transpose_item(inp(F, I_SHG) + (size_t)l * 1024 * 256, 1024, 256, wsp<bf16>(F, WS_SHUP) + (size_t)l * 512 * 1024, 3, scr, q, F.lane);
            else p0_transpose_item(inp(F, I_SHU) + (size_t)l * 1024 * 256, 1024, 256, wsp<bf16>(F, WS_SHUP) + (size_t)l * 512 * 1024, 4, scr, q - NI_SHG, F.lane);
            continue; } r -= 4 * NI_SHG;
        if (r < 2 * NI_SHD) { const int l = r / NI_SHD; p0_transpose_item(inp(F, I_SHD) + (size_t)l * 256 * 1024, 256, 1024, wsp<bf16>(F, WS_SHDN) + (size_t)l * 1024 * 256, 0, scr, r % NI_SHD, F.lane); continue; } r -= 2 * NI_SHD;
        if (r < 2 * NI_RT) { const int l = r / NI_RT; bf16* base = wsp<bf16>(F, WS_WRT) + (size_t)l * 2 * 64 * 1024; p0_router_item(inp(F, I_RTW) + (size_t)l * 1024 * 64, base, base + 64 * 1024, scr, r % NI_RT, F.lane); continue; } r -= 2 * NI_RT;
        if (r < NI_TAB) {
            const int kk = r <= 2048 ? r : r - 2048; bf16* row = wsp<bf16>(F, WS_TAB) + (size_t)r * 4096;
            for (int q = 0; q < 8; ++q) { const int l0 = q * 512 + F.lane * 8; unsigned h[8];
#pragma unroll
                for (int i = 0; i < 8; ++i) { const int idx = (kk * (l0 + i)) & 4095; float s, c; sincospif((float)idx * (1.f / 2048.f), &s, &c); h[i] = f2bf((r <= 2048 ? c : -s) * (1.f / 64.f)); }
                *(GAS v4u*)(row + l0) = (v4u){h[0] | (h[1] << 16), h[2] | (h[3] << 16), h[4] | (h[5] << 16), h[6] | (h[7] << 16)}; }
            continue; } r -= NI_TAB;
        if (r < NI_TABC) { const int kk = r <= 128 ? r : r - 128; bf16* row = wsp<bf16>(F, WS_TABC) + (size_t)r * 256; const int l0 = F.lane * 4; unsigned h[4];
#pragma unroll
            for (int i = 0; i < 4; ++i) { const int idx = (kk * (l0 + i)) & 255; float s, c; sincospif((float)idx * (1.f / 128.f), &s, &c); h[i] = f2bf((r <= 128 ? c : -s) * (1.f / 16.f)); }
            *(GAS v2u*)(row + l0) = (v2u){h[0] | (h[1] << 16), h[2] | (h[3] << 16)};
            continue; } r -= NI_TABC;
        if (r < NI_BD) { const int g = r >> 7, m = r & 127; bf16* row = wsp<bf16>(F, WS_BD) + (size_t)r * 1024; const int c0 = F.lane * 16; unsigned h[16];
#pragma unroll
            for (int i = 0; i < 16; ++i) { const int col = c0 + i, g2 = col >> 8, part = (col >> 7) & 1, cc = col & 127; const int idx = (m * cc) & 127; float s, c; sincospif((float)idx * (1.f / 64.f), &s, &c);
                h[i] = g2 == g ? f2bf((part ? s : c) * 0.08838834764831845f) : 0u; }
            *(GAS v4u*)(row + c0) = (v4u){h[0] | (h[1] << 16), h[2] | (h[3] << 16), h[4] | (h[5] << 16), h[6] | (h[7] << 16)};
            *(GAS v4u*)(row + c0 + 8) = (v4u){h[8] | (h[9] << 16), h[10] | (h[11] << 16), h[12] | (h[13] << 16), h[14] | (h[15] << 16)};
            continue; } r -= NI_BD;
        { const int s = r * 2 + (F.lane >> 5), dd = F.lane & 31, i = dd & 15; const float inv = powf(10000.f, -(float)i * (1.f / 16.f)); const float pos = (float)(dd < 16 ? s / 64 : s % 64); const float ang = pos * inv;
          wsp<float>(F, WS_ROPE)[s * 32 + dd] = cosf(ang); wsp<float>(F, WS_ROPE + 512 * 1024)[s * 32 + dd] = sinf(ang); }
    }
    if (P0_PARTS & 4) convert_experts(F, 0);
#if DBG_LAST_PHASE < 6
    if (P0_PARTS & 8)
    for (int m = gw; m < TL; m += NGW) { f32x4 v[4]; ldrow_f32(inp(F, I_X) + (size_t)m * DM, F.lane, v); strow_f32(F.out + (size_t)m * DM, F.lane, v); }
#endif
}

__device__ __forceinline__ void phase_modnorm0(Frame& F) {
    const int gw = F.vcu * NWAVES + F.wave, NGW = F.G * NWAVES;
    for (int row = gw; row < T0; row += NGW) {
        const int rb = rowbatch(row); const float* xr = row < TL ? inp(F, I_X) + (size_t)row * DM : inp(F, I_CTX) + (size_t)(row - TL) * DM;
        f32x4 v[4], o[4]; ldrow_f32(xr, F.lane, v);
        modnorm(v, rstd_of(v), inp(F, I_NORMG), modp(F, 0, rb, 0), modp(F, 0, rb, 1), F.lane, o);
        strow_bf16(wsp<bf16>(F, WS_HX) + (size_t)row * DM, F.lane, o);
    }
}
__device__ __forceinline__ void phase_e2(Frame& F, int layer) {
    const int gw = F.vcu * NWAVES + F.wave, NGW = F.G * NWAVES;
    const int nrows = layer == 0 ? T0 : TL;
    const bf16* Y = wsp<const bf16>(F, layer == 0 ? WS_Y : WS_Y1);
    const float* g1 = inp(F, I_NORMG) + (layer * 4 + 1) * 1024; const float* g2 = inp(F, I_NORMG) + (layer * 4 + 2) * 1024;
    for (int row = gw; row < nrows; row += NGW) {
        const int rb = rowbatch(row);
        const float* xr = layer == 0 ? (row < TL ? inp(F, I_X) + (size_t)row * DM : inp(F, I_CTX) + (size_t)(row - TL) * DM) : F.out + (size_t)row * DM;
        float* xo = row < TL ? F.out + (size_t)row * DM : wsp<float>(F, WS_CTXRES) + (size_t)(row - TL) * DM;
        f32x4 x[4], y[4], gg[4], mm[4]; ldrow_f32(xr, F.lane, x); ldrow_bf16(Y + (size_t)row * DM, F.lane, y);
        const float ry = rstd_of(y); ldrow_f32(g1, F.lane, gg); ldrow_f32(modp(F, layer, rb, 2), F.lane, mm);
#pragma unroll
        for (int j = 0; j < 4; ++j) x[j] = x[j] + mm[j] * (y[j] * ry * gg[j]);
        strow_f32(xo, F.lane, x);
        f32x4 t[4]; modnorm(x, rstd_of(x), g2, modp(F, layer, rb, 3), modp(F, layer, rb, 4), F.lane, t);
        GAS v2u* qh = (GAS v2u*)(wsp<bf16>(F, WS_HX) + (size_t)row * DM) + F.lane; GAS v2u* ql = (GAS v2u*)(wsp<bf16>(F, WS_TOKLO) + (size_t)row * DM) + F.lane;
#pragma unroll
        for (int j = 0; j < 4; ++j) { unsigned h[4], l[4];
#pragma unroll
            for (int i = 0; i < 4; ++i) { h[i] = f2bf(t[j][i]); l[i] = f2bf(t[j][i] - bf2f(h[i])); }
            qh[64 * j] = (v2u){h[0] | (h[1] << 16), h[2] | (h[3] << 16)}; ql[64 * j] = (v2u){l[0] | (l[1] << 16), l[2] | (l[3] << 16)}; }
    }
}
__device__ __forceinline__ void phase_e4(Frame& F, int layer, int chunk, int CT, bool dry = false) {
    const int gw = F.vcu * NWAVES + F.wave, NGW = F.G * NWAVES;
    const LAS int* tbs = (const LAS int*)(F.lds + TBL_OFF + 4096);
    const int NBr = tbs[64], cstart = chunk * CT;
    const bf16* YE = wsp<const bf16>(F, WS_YEXP);
    const GAS int* TS = (const GAS int*)wsp<const int>(F, WS_TOKSLOT); const GAS float* TG = (const GAS float*)wsp<const float>(F, WS_TOKGATE);
    const float* g3 = inp(F, I_NORMG) + (layer * 4 + 3) * 1024;
    for (int t = cstart + gw; t < cstart + CT; t += NGW) {
        const int rb = rowbatch(t);
        f32x4 y[4], v[4]; ldrow_bf16(YE + ((size_t)256 * NBr + (t - cstart)) * DM, F.lane, y);
#pragma unroll
        for (int k = 0; k < TOPK; ++k) { const int s = __builtin_amdgcn_readfirstlane(TS[t * 8 + k]); const float gt = __builtin_bit_cast(float, __builtin_amdgcn_readfirstlane(__builtin_bit_cast(int, TG[t * 8 + k])));
            const size_t row = (size_t)256 * tbs[s >> 20] + (s & 0xfffff); ldrow_bf16(YE + row * DM, F.lane, v);
#pragma unroll
            for (int j = 0; j < 4; ++j) y[j] = y[j] + v[j] * gt; }
        float* xo = t < TL ? F.out + (size_t)t * DM : wsp<float>(F, WS_CTXRES) + (size_t)(t - TL) * DM;
        f32x4 x[4], gg[4], mm[4]; ldrow_f32(xo, F.lane, x);
        const float ry = rstd_of(y); ldrow_f32(g3, F.lane, gg); ldrow_f32(modp(F, layer, rb, 5), F.lane, mm);
#pragma unroll
        for (int j = 0; j < 4; ++j) x[j] = x[j] + mm[j] * (y[j] * ry * gg[j]);
        if (dry) { if (x[0].x == 1.2345e30f) strow_f32(xo, F.lane, x); continue; }
        strow_f32(xo, F.lane, x);
        if (layer == 0) { f32x4 h[4]; modnorm(x, rstd_of(x), inp(F, I_NORMG) + 4 * 1024, modp(F, 1, rb, 0), modp(F, 1, rb, 1), F.lane, h); strow_bf16(wsp<bf16>(F, WS_HX) + (size_t)t * DM, F.lane, h); }
    }
}
__device__ __forceinline__ void phase_combine(Frame& F) {
    const int gw = F.vcu * NWAVES + F.wave, NGW = F.G * NWAVES;
    const float lam_init = 0.8f - 0.6f * expf(-0.3f);
    float s01 = 0.f, s23 = 0.f;
    for (int i = 0; i < 64; ++i) { s01 += inp(F, I_LAMBDA)[i] * inp(F, I_LAMBDA)[64 + i]; s23 += inp(F, I_LAMBDA)[128 + i] * inp(F, I_LAMBDA)[192 + i]; }
    const float lam = expf(s01) - expf(s23) + lam_init, post = 1.f - lam_init;
    const bf16* OC = wsp<const bf16>(F, WS_OC); bf16* AO = wsp<bf16>(F, WS_Q);
    const int h = F.lane >> 3, e0 = (F.lane & 7) * 16;
    float sg[16];
#pragma unroll
    for (int i = 0; i < 16; ++i) sg[i] = inp(F, I_SUBLNG)[e0 + i] * post;
    for (int t = gw; t < TL; t += NGW) {
        const bf16* p = OC + (size_t)t * 2048 + h * 256 + e0;
        const v4u a0 = *(const GAS v4u*)p, a1 = *(const GAS v4u*)(p + 8), b0 = *(const GAS v4u*)(p + 128), b1 = *(const GAS v4u*)(p + 136);
        const unsigned aw[8] = {a0.x, a0.y, a0.z, a0.w, a1.x, a1.y, a1.z, a1.w}, bw[8] = {b0.x, b0.y, b0.z, b0.w, b1.x, b1.y, b1.z, b1.w};
        float d[16]; float ss = 0.f;
#pragma unroll
        for (int i = 0; i < 8; ++i) { d[2 * i] = bf2f(aw[i] & 0xffffu) - lam * bf2f(bw[i] & 0xffffu); d[2 * i + 1] = bf2f(aw[i] >> 16) - lam * bf2f(bw[i] >> 16); ss += d[2 * i] * d[2 * i] + d[2 * i + 1] * d[2 * i + 1]; }
        ss += __shfl_xor(ss, 1); ss += __shfl_xor(ss, 2); ss += __shfl_xor(ss, 4);
        const float rstd = rsqrtf(ss * (1.f / 128.f) + EPSN);
        unsigned w[8];
#pragma unroll
        for (int i = 0; i < 8; ++i) w[i] = pk2(d[2 * i] * rstd * sg[2 * i], d[2 * i + 1] * rstd * sg[2 * i + 1]);
        bf16* q = AO + (size_t)t * DM + h * 128 + e0;
        *(GAS v4u*)q = (v4u){w[0], w[1], w[2], w[3]}; *(GAS v4u*)(q + 8) = (v4u){w[4], w[5], w[6], w[7]};
    }
}

__device__ __forceinline__ void phase_conv(Frame& F) {
    const int c = F.tid;
    float w[31];
#pragma unroll
    for (int j = 0; j < 31; ++j) w[j] = inp(F, I_CONVW)[j * 512 + c];
    const float bias = inp(F, I_CONVB)[c], lg = inp(F, I_LNG)[c], lb = inp(F, I_LNB)[c];
    LAS bf16* tile = (LAS bf16*)(F.lds);
    const bf16* AG = wsp<const bf16>(F, WS_AGLU); bf16* MIX = wsp<bf16>(F, WS_MIX);
    for (int ti = F.vcu; ti < 544; ti += F.G) {
        int rowbase, L, p0;
        if (ti < 512) { rowbase = (ti >> 6) * SEQ; p0 = (ti & 63) * 64; L = SEQ; } else { const int q = ti - 512; rowbase = TL + (q >> 2) * CTXL; p0 = (q & 3) * 64; L = CTXL; }
        __syncthreads();
        for (int rr = F.wave; rr < 94; rr += 8) { const int p = p0 - 15 + rr; v4u val = (v4u){0u, 0u, 0u, 0u};
            if (p >= 0 && p < L) val = *(const GAS v4u*)(AG + (size_t)(rowbase + p) * 512 + F.lane * 8);
            *(LAS v4u*)(tile + rr * 512 + F.lane * 8) = val; }
        __syncthreads();
        for (int ch = 0; ch < 8; ++ch) {
            float in[38];
#pragma unroll
            for (int i = 0; i < 38; ++i) in[i] = bf2f(tile[(ch * 8 + i) * 512 + c]);
#pragma unroll
            for (int q = 0; q < 8; ++q) { float a = bias;
#pragma unroll
                for (int j = 0; j < 31; ++j) a += w[j] * in[q + j];
                const float mean = wave_sum(a) * (1.f / 64.f), d = a - mean, var = wave_sum(d * d) * (1.f / 64.f);
                const float z = d * rsqrtf(var + EPSN) * lg + lb;
                ((GAS bf16*)MIX)[(size_t)(rowbase + p0 + ch * 8 + q) * DM + c] = (bf16)f2bf(silu(z)); }
        }
    }
    __syncthreads();
}

__device__ __forceinline__ void phase_router(Frame& F, int layer, int ntok, int CT, int cnt_off = 0) {
    typedef float f4 __attribute__((ext_vector_type(4)));
    const int gw = F.vcu * NWAVES + F.wave, NGW = F.G * NWAVES;
    LAS float* lg = (LAS float*)(F.lds + RING_OFF + F.wave * 20480);
    const bf16* TH = wsp<const bf16>(F, WS_HX); const bf16* TLo = wsp<const bf16>(F, WS_TOKLO);
    const bf16* WH = wsp<const bf16>(F, WS_WRT) + (size_t)layer * 2 * 64 * 1024; const bf16* WL = WH + 64 * 1024;
    const float* rbias = inp(F, I_RTB) + layer * 64;
    unsigned* cnt = (unsigned*)(F.ctl + CW_CNT) + layer * NCH * 64 * CNT_STRIDE + cnt_off;
    int* LIST = wsp<int>(F, WS_LIST); int* TS = wsp<int>(F, WS_TOKSLOT); float* TG = wsp<float>(F, WS_TOKGATE);
    const int lr = F.lane & 15, lq = F.lane >> 4;
    for (int task = F.wave * F.G + F.vcu; task < ntok / 64; task += NGW) {
        const int t0 = task * 64;
        f4 acc[4][4];
#pragma unroll
        for (int m = 0; m < 4; ++m)
#pragma unroll
            for (int n = 0; n < 4; ++n) acc[m][n] = (f4){0.f, 0.f, 0.f, 0.f};
        const bf16* ah = TH + (size_t)(t0 + lr) * DM + 8 * lq; const bf16* al = TLo + (size_t)(t0 + lr) * DM + 8 * lq;
        const bf16* bh = WH + (size_t)lr * DM + 8 * lq; const bf16* bl = WL + (size_t)lr * DM + 8 * lq;
        for (int ks = 0; ks < 32; ++ks) { const int k0 = ks * 32;
            bf16x8 xh[4], xl[4], wh[4], wl[4];
#pragma unroll
            for (int m = 0; m < 4; ++m) { xh[m] = *(const GAS bf16x8*)(ah + (size_t)m * 16 * DM + k0); xl[m] = *(const GAS bf16x8*)(al + (size_t)m * 16 * DM + k0); }
#pragma unroll
            for (int n = 0; n < 4; ++n) { wh[n] = *(const GAS bf16x8*)(bh + (size_t)n * 16 * DM + k0); wl[n] = *(const GAS bf16x8*)(bl + (size_t)n * 16 * DM + k0); }
#pragma unroll
            for (int m = 0; m < 4; ++m)
#pragma unroll
                for (int n = 0; n < 4; ++n) {
                    acc[m][n] = __builtin_amdgcn_mfma_f32_16x16x32_bf16(xh[m], wh[n], acc[m][n], 0, 0, 0);
                    acc[m][n] = __builtin_amdgcn_mfma_f32_16x16x32_bf16(xl[m], wh[n], acc[m][n], 0, 0, 0);
                    acc[m][n] = __builtin_amdgcn_mfma_f32_16x16x32_bf16(xh[m], wl[n], acc[m][n], 0, 0, 0); } }
#pragma unroll
        for (int m = 0; m < 4; ++m)
#pragma unroll
            for (int n = 0; n < 4; ++n)
#pragma unroll
                for (int j = 0; j < 4; ++j) lg[(m * 16 + 4 * lq + j) * 65 + n * 16 + lr] = acc[m][n][j];
        LDS_WAIT(); asm volatile("" ::: "memory");
        {
            const int t = t0 + F.lane;
            float v[64];
#pragma unroll
            for (int e = 0; e < 64; ++e) v[e] = 1.f / (1.f + expf(-lg[F.lane * 65 + e])) + rbias[e];
            float gs[8];
#pragma unroll
            for (int g = 0; g < 8; ++g) { float m1 = -INFINITY, m2 = -INFINITY;
#pragma unroll
                for (int i = 0; i < 8; ++i) { const float xx = v[8 * g + i]; m2 = fmaxf(m2, fminf(m1, xx)); m1 = fmaxf(m1, xx); }
                gs[g] = m1 + m2; }
#pragma unroll
            for (int g = 0; g < 8; ++g) { int rank = 0;
#pragma unroll
                for (int g2 = 0; g2 < 8; ++g2) rank += (gs[g2] > gs[g] || (gs[g2] == gs[g] && g2 < g)) ? 1 : 0;
                if (rank >= 4) {
#pragma unroll
                    for (int i = 0; i < 8; ++i) v[8 * g + i] = -INFINITY; } }
            int se[TOPK]; float ss[TOPK]; float ssum = 0.f;
#pragma unroll
            for (int k = 0; k < TOPK; ++k) { float best = -INFINITY; int bi = 0;
#pragma unroll
                for (int e = 0; e < 64; ++e) { const bool gt = v[e] > best; best = gt ? v[e] : best; bi = gt ? e : bi; }
#pragma unroll
                for (int e = 0; e < 64; ++e) v[e] = (e == bi) ? -INFINITY : v[e];
                const float bs = 1.f / (1.f + expf(-lg[F.lane * 65 + bi]));
                se[k] = bi; ss[k] = bs; ssum += bs; }
            const int chunk = t0 / CT; const float inv = 2.5f / ssum;
            LAS unsigned* hist = (LAS unsigned*)(lg + 64 * 65); LAS unsigned* hbase = hist + 64;
            hist[F.lane] = 0u; LDS_WAIT(); asm volatile("" ::: "memory");
            unsigned lrank[TOPK];
#pragma unroll
            for (int k = 0; k < TOPK; ++k) lrank[k] = __hip_atomic_fetch_add(hist + se[k], 1u, __ATOMIC_RELAXED, __HIP_MEMORY_SCOPE_WORKGROUP);
            LDS_WAIT(); asm volatile("" ::: "memory");
            { const unsigned tot = hist[F.lane]; unsigned base = 0u; if (tot) base = __hip_atomic_fetch_add(cnt + (chunk * 64 + F.lane) * CNT_STRIDE, tot, RLX_AGENT); hbase[F.lane] = base; }
            LDS_WAIT(); asm volatile("" ::: "memory");
#pragma unroll
            for (int k = 0; k < TOPK; ++k) { const int e = se[k]; const unsigned pos = hbase[e] + lrank[k];
                ((GAS int*)LIST)[((size_t)chunk * 64 + e) * CAP + pos] = t; ((GAS int*)TS)[t * 8 + k] = (e << 20) | (int)pos; ((GAS float*)TG)[t * 8 + k] = ss[k] * inv; }
        }
        LDS_WAIT(); asm volatile("" ::: "memory");
    }
}

template <bool GATHER_> struct MoeOrder {
    static constexpr bool GATHER = GATHER_;
    const LAS int* tb; int NBr, NBt, NPN, G, vcu;
    unsigned Asrc; int lda;
    unsigned Bexp, bstride, Bsh; int ldb;
    const int* list; const unsigned* cnt; int cstart;
    __device__ __forceinline__ bool next(int i, pg8::Unit& u) const {
        const int L = i * G + vcu; if (L >= NBt * NPN) return false;
        const int blk = L / NPN, pn = L - blk * NPN; u.pm = blk; u.pn = pn;
        if (blk < NBr) { const int w = tb[blk]; u.aux = w; u.B = Bexp + (unsigned)(w >> 16) * bstride + (unsigned)pn * 256u * ldb * 2u; }
        else { u.aux = -1; u.B = Bsh + (unsigned)pn * 256u * ldb * 2u; }
        u.A = GATHER ? Asrc : Asrc + (unsigned)blk * 256u * lda * 2u; return true;
    }
    __device__ __forceinline__ void aoffs(const pg8::Unit& u, unsigned (&v)[2][2]) const {
        int tid = threadIdx.x; asm volatile("" : "+v"(tid));
#pragma unroll
        for (int i = 0; i < 2; ++i) { int R, C; pg8::stage_rc(tid * 16 + i * 8192, R, C);
#pragma unroll
            for (int h = 0; h < 2; ++h) { const int r = h * 128 + R;
                if constexpr (!GATHER) v[h][i] = (unsigned)(r * lda + C) * 2u;
                else { int tok;
                    if (u.aux >= 0) { const int e = u.aux >> 16, pos = (u.aux & 0xffff) * 256 + r; tok = pos < (int)((const GAS unsigned*)cnt)[e * CNT_STRIDE] ? ((const GAS int*)list)[(size_t)e * CAP + pos] : cstart; }
                    else tok = cstart + (u.pm - NBr) * 256 + r;
                    v[h][i] = (unsigned)(tok * lda + C) * 2u; } } }
    }
};
__device__ __forceinline__ void moe_tables(Frame& F, const unsigned* cnt) {
    LAS int* tb = (LAS int*)(F.lds + TBL_OFF); LAS int* tbs = (LAS int*)(F.lds + TBL_OFF + 4096);
    __syncthreads();
    if (F.wave == 0) { const int c = (int)cnt[F.lane * CNT_STRIDE]; const int nb = (c + 255) >> 8; int inc = nb;
#pragma unroll
        for (int o = 1; o < 64; o <<= 1) { const int t = __shfl_up(inc, o); if (F.lane >= o) inc += t; }
        const int start = inc - nb; tbs[F.lane] = start; if (F.lane == 63) tbs[64] = inc;
        for (int j = 0; j < nb; ++j) tb[start + j] = (F.lane << 16) | j; }
    __syncthreads();
}

struct DftOrder {
    static constexpr bool GATHER = false;
    unsigned TAB, FT; int L, nM, G, vcu;
    __device__ __forceinline__ bool next(int i, pg8::Unit& u) const {
        const int U = i * G + vcu; if (U >= NBATCH * nM * 2) return false;
        const int b = U / (nM * 2), r = U % (nM * 2); u.pm = r >> 1; u.pn = r & 1; u.aux = b;
        u.A = TAB + (unsigned)u.pm * 256u * L * 2u; u.B = FT + ((unsigned)b * 512u + u.pn * 256u) * L * 2u; return true;
    }
    __device__ __forceinline__ void aoffs(const pg8::Unit&, unsigned (&v)[2][2]) const {
        int tid = threadIdx.x; asm volatile("" : "+v"(tid));
#pragma unroll
        for (int i = 0; i < 2; ++i) { int R, C; pg8::stage_rc(tid * 16 + i * 8192, R, C);
#pragma unroll
            for (int h = 0; h < 2; ++h) v[h][i] = (unsigned)((h * 128 + R) * L + C) * 2u; }
    }
};

struct Args { const float* in[25]; float* out; unsigned char* ws; int ph_lo, ph_hi, li, pad; };
#ifndef REPEAT_MASK
#define REPEAT_MASK 0u
#endif
#define IN(k) (lo <= (k) && (k) < hi && (k) <= DBG_LAST_PHASE)
#define REPS(k) for (int rep_ = 0; rep_ <= (int)((REPEAT_MASK >> (k)) & 1u); ++rep_)
#define SEAM(k) do { if (lo <= (k) && (k) + 1 < hi) xcd_barrier(bar); } while (0)

template <int LAYER, int CHUNK> __device__ __forceinline__ void moe_chunk(Frame& F, const XcdBarrier& bar, const int lo, const int hi) {
    constexpr int pb = 6 + 12 * LAYER, p = pb + 2 + 3 * CHUNK, ntok = LAYER == 0 ? T0 : TL, CT = ntok / NCH;
    if (IN(p)) REPS(p) { FENCE(F);
        const unsigned* cnt = (const unsigned*)(F.ctl + CW_CNT) + (LAYER * NCH + CHUNK) * 64 * CNT_STRIDE; const int* list = wsp<const int>(F, WS_LIST) + (size_t)CHUNK * 64 * CAP;
        const LAS int* tb = (const LAS int*)(F.lds + TBL_OFF); const LAS int* tbs = (const LAS int*)(F.lds + TBL_OFF + 4096);
        moe_tables(F, cnt); const int NBr = tbs[64];
        MoeOrder<true> S{tb, NBr, NBr + CT / 256, 2, F.G, F.vcu, (unsigned)WS_HX, 1024, (unsigned)WS_WEUP, 512u * 1024u * 2u, (unsigned)WS_SHUP + (unsigned)LAYER * 512u * 1024u * 2u, 1024, list, cnt, CHUNK * CT};
        pg8::EpiSwiglu E{wsp<bf16>(F, WS_HID), 256}; pg8::gemm_phase(F.lds + RING_OFF, F.ws, 1024, 1024, S, E); } SEAM(p);
    if (IN(p + 1)) REPS(p + 1) { FENCE(F);
        const unsigned* cnt = (const unsigned*)(F.ctl + CW_CNT) + (LAYER * NCH + CHUNK) * 64 * CNT_STRIDE; const int* list = wsp<const int>(F, WS_LIST) + (size_t)CHUNK * 64 * CAP;
        const LAS int* tb = (const LAS int*)(F.lds + TBL_OFF); const LAS int* tbs = (const LAS int*)(F.lds + TBL_OFF + 4096);
        moe_tables(F, cnt); const int NBr = tbs[64];
        MoeOrder<false> S{tb, NBr, NBr + CT / 256, 4, F.G, F.vcu, (unsigned)WS_HID, 256, (unsigned)WS_WEDN, 1024u * 256u * 2u, (unsigned)WS_SHDN + (unsigned)LAYER * 1024u * 256u * 2u, 256, list, cnt, CHUNK * CT};
        pg8::EpiBf16 E{wsp<bf16>(F, WS_YEXP), 1024, 0}; pg8::gemm_phase(F.lds + RING_OFF, F.ws, 256, 256, S, E); } SEAM(p + 1);
    if (IN(p + 2)) REPS(p + 2) { FENCE(F);
        const unsigned* cnt = (const unsigned*)(F.ctl + CW_CNT) + (LAYER * NCH + CHUNK) * 64 * CNT_STRIDE;
        moe_tables(F, cnt);
#ifdef E4_TIMING
        phase_e4(F, LAYER, CHUNK, CT, true); FENCE(F);
#endif
        phase_e4(F, LAYER, CHUNK, CT); } SEAM(p + 2);
}
template <int LAYER> __device__ __forceinline__ void moe_part(Frame& F, const XcdBarrier& bar, const int lo, const int hi) {
    constexpr int pb = 6 + 12 * LAYER, ntok = LAYER == 0 ? T0 : TL, CT = ntok / NCH;
    if (IN(pb)) REPS(pb) { FENCE(F); phase_e2(F, LAYER); } SEAM(pb);
    if (IN(pb + 1)) { FENCE(F);
#ifdef ROUTER_TIMING
        phase_router(F, LAYER, ntok, CT, 4 * 64 * CNT_STRIDE); FENCE(F);
#endif
        phase_router(F, LAYER, ntok, CT); } SEAM(pb + 1);
    moe_chunk<LAYER, 0>(F, bar, lo, hi);
    moe_chunk<LAYER, 1>(F, bar, lo, hi);
}

__global__ void __launch_bounds__(NWAVES * 64, 2) mega_fwd(Args args) {
    extern __shared__ __attribute__((aligned(16))) unsigned char lds[];
    Frame F;
    F.lds = (LAS unsigned char*)lds;
    F.MISC = (volatile LAS unsigned*)(F.lds + MISC_OFF);
    F.tid = threadIdx.x; F.lane = F.tid & 63; F.wave = __builtin_amdgcn_readfirstlane(F.tid >> 6);
    F.G = gridDim.x; { const int bx = blockIdx.x; F.vcu = (F.G % 8 == 0) ? (bx % 8) * (F.G / 8) + bx / 8 : bx; }
    F.ws = args.ws; F.ctl = (gu32*)(args.ws + WS_CTL); F.out = args.out;
    for (int u = F.tid; u < (LDS_BYTES - LDSCTL_OFF) / 4; u += NWAVES * 64) ((LAS unsigned*)(F.lds + LDSCTL_OFF))[u] = 0u;
    __syncthreads();
    if (F.tid < 25) { const unsigned long long pv = (unsigned long long)args.in[F.tid]; LAS unsigned* t = (LAS unsigned*)(F.lds + INPTR_OFF) + 2 * F.tid; t[0] = (unsigned)pv; t[1] = (unsigned)(pv >> 32); }
    __syncthreads();
    XcdBarrier bar; bar.bar = (unsigned*)(F.ctl + CW_BAR); bar.x = 0; bar.st = nullptr;
#if MK_SINGLE
    bar = xcd_barrier_post((unsigned*)(F.ctl + CW_BAR), F.MISC + 8);
#endif
    const int lo = args.ph_lo, hi = args.ph_hi;
    const int bx = (int)blockIdx.x;

    if (IN(0)) REPS(0) { FENCE(F); p0_prologue(F); } SEAM(0);
    if (IN(1)) REPS(1) { FENCE(F); phase_modnorm0(F); } SEAM(1);
    if (IN(2)) REPS(2) { FENCE(F);
        { pg8::DenseOrder S; S.init((unsigned)WS_HX, 1024, (unsigned)WS_WIN, 1024, T0 / 256, 4, 0, F.G, bx); pg8::EpiGlu E{wsp<bf16>(F, WS_AGLU)}; pg8::gemm_phase(F.lds + RING_OFF, F.ws, 1024, 1024, S, E); }
        FENCE(F);
        { pg8::DenseOrder S; S.init((unsigned)WS_HX, 1024, (unsigned)WS_WIN, 1024, T0 / 256, 2, 4, F.G, bx); pg8::EpiFT E{wsp<bf16>(F, WS_FT), wsp<bf16>(F, WS_FTC)}; pg8::gemm_phase(F.lds + RING_OFF, F.ws, 1024, 1024, S, E); } } SEAM(2);
    if (IN(3)) REPS(3) { FENCE(F); phase_conv(F);
        { DftOrder S{(unsigned)WS_TAB, (unsigned)WS_FT, SEQ, SEQ / 256, F.G, F.vcu}; pg8::EpiDft<SEQ> E{wsp<bf16>(F, WS_FF), 0}; pg8::gemm_phase(F.lds + RING_OFF, F.ws, SEQ, SEQ, S, E); }
        FENCE(F);
        { DftOrder S{(unsigned)WS_TABC, (unsigned)WS_FTC, CTXL, 1, F.G, F.vcu}; pg8::EpiDft<CTXL> E{wsp<bf16>(F, WS_FF), TL}; pg8::gemm_phase(F.lds + RING_OFF, F.ws, CTXL, CTXL, S, E); } } SEAM(3);
    if (IN(4)) REPS(4) { FENCE(F); pg8::DenseOrder S; S.init((unsigned)WS_FF, 1024, (unsigned)WS_BD, 1024, T0 / 256, 2, 0, F.G, bx);
        pg8::EpiBf16 E{wsp<bf16>(F, WS_MIX), 1024, 512}; pg8::gemm_phase(F.lds + RING_OFF, F.ws, 1024, 1024, S, E); } SEAM(4);
    if (IN(5)) REPS(5) { FENCE(F); pg8::DenseOrder S; S.init((unsigned)WS_MIX, 1024, (unsigned)WS_WOUT, 1024, T0 / 256, 4, 0, F.G, bx);
        pg8::EpiBf16 E{wsp<bf16>(F, WS_Y), 1024, 0}; pg8::gemm_phase(F.lds + RING_OFF, F.ws, 1024, 1024, S, E); } SEAM(5);
    moe_part<0>(F, bar, lo, hi);
    if (IN(14)) REPS(14) { FENCE(F);
        { pg8::DenseOrder S; S.init((unsigned)WS_HX, 1024, (unsigned)WS_WQKV, 1024, TL / 256, 12, 0, F.G, bx);
          pg8::EpiQkv E{wsp<bf16>(F, WS_Q), wsp<bf16>(F, WS_KALL), wsp<bf16>(F, WS_VALL), wsp<float>(F, WS_ROPE), wsp<float>(F, WS_ROPE + 512 * 1024), 0}; pg8::gemm_phase(F.lds + RING_OFF, F.ws, 1024, 1024, S, E); }
        FENCE(F);
        { pg8::DenseOrder S; S.init((unsigned)(WS_HX + (size_t)TL * 2048), 1024, (unsigned)WS_WQKV, 1024, TC / 256, 8, 4, F.G, bx);
          pg8::EpiQkv E{wsp<bf16>(F, WS_Q), wsp<bf16>(F, WS_KALL), wsp<bf16>(F, WS_VALL), wsp<float>(F, WS_ROPE), wsp<float>(F, WS_ROPE + 512 * 1024), 1}; pg8::gemm_phase(F.lds + RING_OFF, F.ws, 1024, 1024, S, E); }
    } SEAM(14);
    if (IN(15)) REPS(15) { FENCE(F);
        const attn_body::bf16* Q = wsp<const attn_body::bf16>(F, WS_Q); const attn_body::bf16* KA = wsp<const attn_body::bf16>(F, WS_KALL); const attn_body::bf16* VA = wsp<const attn_body::bf16>(F, WS_VALL);
        attn_body::bf16* OC = wsp<attn_body::bf16>(F, WS_OC);
        for (int i = 0;; ++i) { int bh, cc, qb;
            if (F.G == 256) { if (i >= 16) break; const int xg = F.vcu >> 5, ci = F.vcu & 31, un = (i & 1) * 32 + ci; bh = xg * 8 + (i >> 1); cc = un >> 5; qb = un & 31; }
            else { const int u = i * F.G + F.vcu; if (u >= 64 * 2 * (SEQ / 128)) break; bh = u >> 6; cc = (u >> 5) & 1; qb = u & 31; }
            const int b = bh >> 3, h = bh & 7;
            attn_body::attn_unit<8>(Q + ((size_t)b * SEQ + qb * 128) * 1024 + h * 128 + cc * 64, KA + (size_t)b * LKV * 1024 + h * 128 + cc * 64, VA + (size_t)b * LKV * 1024 + h * 128,
                                    OC + ((size_t)b * SEQ + qb * 128) * 2048 + h * 256 + cc * 128, LKV / 64, (char*)lds + RING_OFF); }
    } SEAM(15);
    if (IN(16)) REPS(16) { FENCE(F); phase_combine(F); FENCE(F); convert_experts(F, 1); } SEAM(16);
    if (IN(17)) REPS(17) { FENCE(F); pg8::DenseOrder S; S.init((unsigned)WS_Q, 1024, (unsigned)WS_WDAO, 1024, TL / 256, 4, 0, F.G, bx);
        pg8::EpiBf16 E{wsp<bf16>(F, WS_Y1), 1024, 0}; pg8::gemm_phase(F.lds + RING_OFF, F.ws, 1024, 1024, S, E); } SEAM(17);
    moe_part<1>(F, bar, lo, hi);
}
#undef IN
#undef SEAM

extern "C" void kernel_launch(void* const* d_in, const int* in_sizes, int n_in, void* d_out, int out_size, void* d_ws, size_t ws_size, hipStream_t stream) {
    static int grid = 0;
    if (grid == 0) {
        if (n_in != 25 || in_sizes[0] != TL * DM || out_size != TL * DM || ws_size < WS_END) { fprintf(stderr, "kernel_launch: unexpected problem shape / workspace (n_in %d, in0 %d, out %d, ws %zu, need %zu); nothing launched\n", n_in, n_in > 0 ? in_sizes[0] : -1, out_size, ws_size, (size_t)WS_END); grid = -1; return; }
        int dev = 0, cus = 0, per_cu = 0;
        if (hipGetDevice(&dev) != hipSuccess || hipDeviceGetAttribute(&cus, hipDeviceAttributeMultiprocessorCount, dev) != hipSuccess) { grid = -1; return; }
        if (hipFuncSetAttribute((const void*)mega_fwd, hipFuncAttributeMaxDynamicSharedMemorySize, LDS_BYTES) != hipSuccess) { fprintf(stderr, "kernel_launch: hipFuncSetAttribute failed\n"); grid = -1; return; }
        if (hipOccupancyMaxActiveBlocksPerMultiprocessor(&per_cu, (const void*)mega_fwd, NWAVES * 64, LDS_BYTES) != hipSuccess || per_cu < 1) fprintf(stderr, "kernel_launch: occupancy query reports %d per CU\n", per_cu);
        (void)hipGetLastError();
        grid = cus;
    }
    if (grid < 0) return;
    if (hipMemsetAsync((char*)d_ws + WS_CTL, 0, CTL_ZERO_BYTES, stream) != hipSuccess) return;
    Args a{};
    for (int i = 0; i < 25; ++i) a.in[i] = (const float*)d_in[i];
    a.out = (float*)d_out; a.ws = (unsigned char*)d_ws;
#if MK_SINGLE
    a.ph_lo = 0; a.ph_hi = NPHASES; a.li = 0;
    hipLaunchKernelGGL(mega_fwd, dim3(grid), dim3(NWAVES * 64), LDS_BYTES, stream, a);
#else
    for (int p = 0; p <= DBG_LAST_PHASE && p < NPHASES; ++p) { a.ph_lo = p; a.ph_hi = p + 1; a.li = p;
        hipLaunchKernelGGL(mega_fwd, dim3(grid), dim3(NWAVES * 64), LDS_BYTES, stream, a); }
#endif
}
```

```cpp
#include <hip/hip_runtime.h>
#include <hip/hip_bf16.h>
#include <cstdio>
#include <cstdint>
#include <cmath>

#ifndef MK_SINGLE
#define MK_SINGLE 1
#endif

constexpr int DM = 1024, NBATCH = 8, SEQ = 4096, CTXL = 256;
constexpr int TL = NBATCH * SEQ;
constexpr int TC = NBATCH * CTXL;
constexpr int T0 = TL + TC;
constexpr int LKV = CTXL + SEQ;
constexpr float EPSN = 1e-6f;
constexpr int NEXP = 64, TOPK = 6;
constexpr int NCH = 2;
constexpr int CAP = T0 / NCH;

namespace pg8 {
#define PG8_LAS __attribute__((address_space(3)))
#define PG8_GAS __attribute__((address_space(1)))
typedef unsigned short bf16_t;
typedef short bf16x8 __attribute__((ext_vector_type(8)));
typedef float f32x4 __attribute__((ext_vector_type(4)));
typedef unsigned u32x4 __attribute__((ext_vector_type(4)));
constexpr int BM = 256, BK = 64, HALF = 128, HTB = HALF * BK * 2, STAGE_BYTES = 8 * HTB;

__host__ __device__ __forceinline__ int lds_byte(int r, int c) { const int st = (r >> 4) * 2 + (c >> 5), rr = r & 15, cc = c & 31, ob = rr * 64 + cc * 2; return st * 1024 + (ob ^ (((ob >> 9) & 1) << 5)); }
__host__ __device__ __forceinline__ void stage_rc(int b, int& R, int& C) { const int st = b / 1024, sb = b % 1024, swz = sb ^ (((sb >> 9) & 1) << 5); R = (st >> 1) * 16 + swz / 64; C = (st & 1) * 32 + (swz % 64) / 2; }
__host__ __device__ __forceinline__ int perm32(int rho) { const int n = rho >> 4, i = rho & 15; return 8 * (i >> 2) + 4 * n + (i & 3); }

struct Unit { unsigned A, B; int pm, pn, aux; };

__device__ __forceinline__ unsigned cvt_pk_bf16(float lo, float hi) { unsigned r; asm volatile("v_cvt_pk_bf16_f32 %0, %1, %2" : "=v"(r) : "v"(lo), "v"(hi)); return r; }
__device__ __forceinline__ u32x4 pack8(const f32x4& a, const f32x4& b) { u32x4 w; w.x = cvt_pk_bf16(a[0], a[1]); w.y = cvt_pk_bf16(a[2], a[3]); w.z = cvt_pk_bf16(b[0], b[1]); w.w = cvt_pk_bf16(b[2], b[3]); return w; }


template <class Epi, class Sched>
__device__ __forceinline__ void gemm_phase(PG8_LAS unsigned char* lds, const void* wsbase, const int K, const int ldb, const Sched& S, const Epi& E) {
    const __amdgpu_buffer_rsrc_t rsrc = __builtin_amdgcn_make_buffer_rsrc((void*)wsbase, 0, 0x7fffffff, 0x00020000);
    int tid_ = threadIdx.x; asm volatile("" : "+v"(tid_));
    const int tid = tid_, wid = __builtin_amdgcn_readfirstlane(tid >> 6), lane = tid & 63, wr = wid >> 2, wc = wid & 3, fr = lane & 15, fq = lane >> 4;
    const int nt = K / BK;
    unsigned voffB[2];
#pragma unroll
    for (int i = 0; i < 2; ++i) { int R, C; stage_rc(tid * 16 + i * 8192, R, C); const int Rb = (R & ~31) + perm32(R & 31); voffB[i] = (unsigned)(Rb * ldb + C) * 2u; }
    const unsigned kstep = (unsigned)(BK * 2);
    const unsigned hstepB = (unsigned)HALF * ldb * 2;
    const unsigned ldsw = (unsigned)wid * 1024u;
    const int aoff = lds_byte(wr * 64 + fr, fq * 8), boff = lds_byte(wc * 32 + fr, fq * 8);
#define PG8_SA(b, h) (((b) * 2 + (h)) * HTB)
#define PG8_SB(b, h) ((4 + (b) * 2 + (h)) * HTB)
#define PG8_STG(bufoff, gbase, v0, v1) do { \
        __builtin_amdgcn_raw_ptr_buffer_load_lds(rsrc, (PG8_LAS unsigned*)(lds + (bufoff) + ldsw), 16, (v0), (gbase), 0, 0); \
        __builtin_amdgcn_raw_ptr_buffer_load_lds(rsrc, (PG8_LAS unsigned*)(lds + (bufoff) + ldsw + 8192), 16, (v1), (gbase), 0, 0); } while (0)
#define PG8_STGB(bufoff, gbase) PG8_STG(bufoff, gbase, voffB[0], voffB[1])
#define PG8_LDA(dst, b, h) do { _Pragma("unroll") for (int m = 0; m < 4; ++m) _Pragma("unroll") for (int k = 0; k < 2; ++k) dst[m][k] = *(const PG8_LAS bf16x8*)(lds + PG8_SA(b, h) + aoff + m * 2048 + k * 1024); } while (0)
#define PG8_LDB(dst, b, h) do { _Pragma("unroll") for (int n = 0; n < 2; ++n) _Pragma("unroll") for (int k = 0; k < 2; ++k) dst[n][k] = *(const PG8_LAS bf16x8*)(lds + PG8_SB(b, h) + boff + n * 2048 + k * 1024); } while (0)
#define PG8_MMA(ai, bj, At, Bt) do { __builtin_amdgcn_s_setprio(1); _Pragma("unroll") for (int m = 0; m < 4; ++m) _Pragma("unroll") for (int n = 0; n < 2; ++n) _Pragma("unroll") for (int k = 0; k < 2; ++k) \
        acc[ai][bj][m][n] = __builtin_amdgcn_mfma_f32_16x16x32_bf16(Bt[n][k], At[m][k], acc[ai][bj][m][n], 0, 0, 0); __builtin_amdgcn_s_setprio(0); } while (0)
#define PG8_WAIT_V(n) asm volatile("s_waitcnt vmcnt(" #n ")" ::: "memory")
#define PG8_WAIT_L(n) asm volatile("s_waitcnt lgkmcnt(" #n ")" ::: "memory")
#define PG8_BAR __builtin_amdgcn_s_barrier()
#define PG8_SCHED __builtin_amdgcn_sched_barrier(0)
    Unit cur, nxt; int ui = 0;
    if (!S.next(0, cur)) return;
    f32x4 acc[2][2][4][2];
#pragma unroll
    for (int a = 0; a < 2; ++a)
#pragma unroll
        for (int b = 0; b < 2; ++b)
#pragma unroll
            for (int m = 0; m < 4; ++m)
#pragma unroll
                for (int n = 0; n < 2; ++n) acc[a][b][m][n] = (f32x4){0.f, 0.f, 0.f, 0.f};
    bf16x8 At[4][2], B0[2][2], B1[2][2];
    unsigned vAc[2][2], vAn[2][2];
    S.aoffs(cur, vAc);
    unsigned cA = cur.A, cB = cur.B;
    PG8_STGB(PG8_SB(0, 0), cB); PG8_STGB(PG8_SB(0, 1), cB + hstepB); PG8_STG(PG8_SA(0, 0), cA, vAc[0][0], vAc[0][1]); PG8_STG(PG8_SA(0, 1), cA, vAc[1][0], vAc[1][1]);
    if (wr == 1) PG8_BAR;
    PG8_WAIT_V(2); PG8_BAR;
    PG8_STGB(PG8_SB(1, 0), cB + kstep); PG8_STG(PG8_SA(1, 0), cA + kstep, vAc[0][0], vAc[0][1]); PG8_STGB(PG8_SB(1, 1), cB + hstepB + kstep);
    PG8_WAIT_V(6); PG8_BAR;
    for (;;) {
        const bool has_next = S.next(ui + 1, nxt);
        if constexpr (Sched::GATHER) {
            if (has_next) S.aoffs(nxt, vAn);
            else {
#pragma unroll
                for (int h = 0; h < 2; ++h)
#pragma unroll
                    for (int i = 0; i < 2; ++i) vAn[h][i] = vAc[h][i]; } }
        const unsigned nA = has_next ? nxt.A : cA, nB = has_next ? nxt.B : cB;
        for (int t = 0; t < nt; t += 2) {
            const bool last = (t == nt - 2);
            const unsigned a1 = cA + (unsigned)(t + 1) * kstep;
            const unsigned a2 = last ? nA : cA + (unsigned)(t + 2) * kstep, b2 = last ? nB : cB + (unsigned)(t + 2) * kstep;
            const unsigned a3 = a2 + kstep, b3 = b2 + kstep;
            unsigned w00 = vAc[0][0], w01 = vAc[0][1], w10 = vAc[1][0], w11 = vAc[1][1];
            if constexpr (Sched::GATHER) { w00 = last ? vAn[0][0] : w00; w01 = last ? vAn[0][1] : w01; w10 = last ? vAn[1][0] : w10; w11 = last ? vAn[1][1] : w11; }
            PG8_LDB(B0, 0, 0); PG8_LDB(B1, 0, 1); PG8_SCHED; PG8_LDA(At, 0, 0); PG8_STG(PG8_SA(1, 1), a1, vAc[1][0], vAc[1][1]);
            PG8_WAIT_V(8); PG8_WAIT_L(0); PG8_BAR; PG8_MMA(0, 0, At, B0); PG8_MMA(0, 1, At, B1); PG8_BAR; PG8_SCHED;
            PG8_LDA(At, 0, 1); PG8_STGB(PG8_SB(0, 0), b2); PG8_STGB(PG8_SB(0, 1), b2 + hstepB); PG8_STG(PG8_SA(0, 0), a2, w00, w01);
            PG8_WAIT_V(8); PG8_WAIT_L(0); PG8_BAR; PG8_MMA(1, 0, At, B0); PG8_MMA(1, 1, At, B1); PG8_BAR; PG8_SCHED;
            PG8_LDB(B0, 1, 0); PG8_LDB(B1, 1, 1); PG8_SCHED; PG8_LDA(At, 1, 0); PG8_STG(PG8_SA(0, 1), a2, w10, w11);
            PG8_WAIT_V(8); PG8_WAIT_L(0); PG8_BAR; PG8_MMA(0, 0, At, B0); PG8_MMA(0, 1, At, B1); PG8_BAR; PG8_SCHED;
            PG8_LDA(At, 1, 1); PG8_STGB(PG8_SB(1, 0), b3); PG8_STGB(PG8_SB(1, 1), b3 + hstepB); PG8_STG(PG8_SA(1, 0), a3, w00, w01);
            PG8_WAIT_V(8); PG8_WAIT_L(0); PG8_BAR; PG8_MMA(1, 0, At, B0); PG8_MMA(1, 1, At, B1); PG8_BAR; PG8_SCHED;
        }
        if (wr == 0) PG8_BAR;
        { int t2 = threadIdx.x; asm volatile("" : "+v"(t2)); const int l2 = t2 & 63, w2 = __builtin_amdgcn_readfirstlane(t2 >> 6);
          E(acc, cur, w2 >> 2, w2 & 3, l2 & 15, l2 >> 4); }
        if (!has_next) break;
#pragma unroll
        for (int a = 0; a < 2; ++a)
#pragma unroll
            for (int b = 0; b < 2; ++b)
#pragma unroll
                for (int m = 0; m < 4; ++m)
#pragma unroll
                    for (int n = 0; n < 2; ++n) acc[a][b][m][n] = (f32x4){0.f, 0.f, 0.f, 0.f};
        cur = nxt; cA = nA; cB = nB; ++ui;
        if constexpr (Sched::GATHER) {
#pragma unroll
            for (int h = 0; h < 2; ++h)
#pragma unroll
                for (int i = 0; i < 2; ++i) vAc[h][i] = vAn[h][i]; }
        if (wr == 1) PG8_BAR;
    }
    PG8_WAIT_V(0);
    PG8_BAR;
#undef PG8_SA
#undef PG8_SB
#undef PG8_STG
#undef PG8_STGB
#undef PG8_LDA
#undef PG8_LDB
#undef PG8_MMA
#undef PG8_WAIT_V
#undef PG8_WAIT_L
#undef PG8_BAR
#undef PG8_SCHED
}

struct DenseOrder {
    static constexpr bool GATHER = false;
    unsigned A, B; int lda, ldb, nM, nN, pn0, nwg, G, c;
    __device__ __forceinline__ void init(size_t A_, int lda_, size_t B_, int ldb_, int nM_, int nN_, int pn0_, int G_, int c_) { A = (unsigned)A_; B = (unsigned)B_; lda = lda_; ldb = ldb_; nM = nM_; nN = nN_; pn0 = pn0_; nwg = nM * nN; G = G_; c = c_; }
    __device__ __forceinline__ bool next(int i, Unit& u) const {
        const long L = (long)i * G + c; if (L >= nwg) return false;
        int wgid = (int)L; { const int q = nwg / 8, r = nwg % 8, xcd = wgid % 8, off = wgid / 8; wgid = (xcd < r ? xcd * (q + 1) : r * (q + 1) + (xcd - r) * q) + off; }
        const int nig = 8 * nN, gid = wgid / nig, fm = gid * 8, gsz = (nM - fm) < 8 ? (nM - fm) : 8;
        u.pm = fm + ((wgid % nig) % gsz); u.pn = (wgid % nig) / gsz + pn0; u.aux = 0;
        u.A = A + (unsigned)u.pm * 256u * lda * 2u; u.B = B + (unsigned)u.pn * 256u * ldb * 2u; return true;
    }
    __device__ __forceinline__ void aoffs(const Unit&, unsigned (&v)[2][2]) const {
        int tid = threadIdx.x; asm volatile("" : "+v"(tid));
#pragma unroll
        for (int i = 0; i < 2; ++i) { int R, C; stage_rc(tid * 16 + i * 8192, R, C);
#pragma unroll
            for (int h = 0; h < 2; ++h) v[h][i] = (unsigned)((h * 128 + R) * lda + C) * 2u; }
    }
};

struct EpiBf16 {
    bf16_t* O; int ldc, coff;
    __device__ __forceinline__ void operator()(const f32x4 (&acc)[2][2][4][2], const Unit& u, int wr, int wc, int fr, int fq) const {
        const int row0 = u.pm * BM + wr * 64 + fr, col0 = coff + u.pn * BM + wc * 32 + 8 * fq;
#pragma unroll
        for (int ai = 0; ai < 2; ++ai)
#pragma unroll
            for (int m = 0; m < 4; ++m) { bf16_t* rowp = O + (size_t)(row0 + ai * HALF + m * 16) * ldc + col0;
#pragma unroll
                for (int bj = 0; bj < 2; ++bj) *(PG8_GAS u32x4*)(rowp + bj * HALF) = pack8(acc[ai][bj][m][0], acc[ai][bj][m][1]); }
    }
};
__device__ __forceinline__ float sigm(float x) { return 1.f / (1.f + __expf(-x)); }
struct EpiSwiglu {
    bf16_t* H; int ldh;
    __device__ __forceinline__ void operator()(const f32x4 (&acc)[2][2][4][2], const Unit& u, int wr, int wc, int fr, int fq) const {
        const int row0 = u.pm * BM + wr * 64 + fr, col0 = u.pn * HALF + wc * 32 + 8 * fq;
#pragma unroll
        for (int ai = 0; ai < 2; ++ai)
#pragma unroll
            for (int m = 0; m < 4; ++m) { f32x4 o[2];
#pragma unroll
                for (int n = 0; n < 2; ++n)
#pragma unroll
                    for (int j = 0; j < 4; ++j) { const float g = acc[ai][0][m][n][j]; o[n][j] = g * sigm(g) * acc[ai][1][m][n][j]; }
                *(PG8_GAS u32x4*)(H + (size_t)(row0 + ai * HALF + m * 16) * ldh + col0) = pack8(o[0], o[1]); }
    }
};
struct EpiGlu {
    bf16_t* AGLU;
    __device__ __forceinline__ void operator()(const f32x4 (&acc)[2][2][4][2], const Unit& u, int wr, int wc, int fr, int fq) const {
        const int row0 = u.pm * BM + wr * 64 + fr, col0 = u.pn * HALF + wc * 32 + 8 * fq;
#pragma unroll
        for (int ai = 0; ai < 2; ++ai)
#pragma unroll
            for (int m = 0; m < 4; ++m) { f32x4 o[2];
#pragma unroll
                for (int n = 0; n < 2; ++n)
#pragma unroll
                    for (int j = 0; j < 4; ++j) o[n][j] = acc[ai][0][m][n][j] * sigm(acc[ai][1][m][n][j]);
                *(PG8_GAS u32x4*)(AGLU + (size_t)(row0 + ai * HALF + m * 16) * 512 + col0) = pack8(o[0], o[1]); }
    }
};
struct EpiFT {
    bf16_t* FT; bf16_t* FTC;
    __device__ __forceinline__ void operator()(const f32x4 (&acc)[2][2][4][2], const Unit& u, int wr, int wc, int fr, int fq) const {
        const int rb = u.pm * BM; bf16_t* base; int L, l0;
        if (rb < TL) { base = FT + (size_t)(rb / SEQ) * 512 * SEQ; L = SEQ; l0 = rb % SEQ; } else { base = FTC + (size_t)((rb - TL) / CTXL) * 512 * CTXL; L = CTXL; l0 = 0; }
        const int ch0 = (u.pn - 4) * BM + wc * 32 + 8 * fq;
        bf16_t* lanep = base + (size_t)ch0 * L + l0 + wr * 64 + fr;
#pragma unroll
        for (int ai = 0; ai < 2; ++ai)
#pragma unroll
            for (int m = 0; m < 4; ++m)
#pragma unroll
                for (int bj = 0; bj < 2; ++bj)
#pragma unroll
                    for (int n = 0; n < 2; ++n) { const unsigned p0 = cvt_pk_bf16(acc[ai][bj][m][n][0], acc[ai][bj][m][n][1]), p1 = cvt_pk_bf16(acc[ai][bj][m][n][2], acc[ai][bj][m][n][3]);
                        PG8_GAS bf16_t* d = (PG8_GAS bf16_t*)(lanep + (size_t)(bj * HALF + 4 * n) * L + (ai * HALF + m * 16));
                        d[0] = (bf16_t)(p0 & 0xffffu); d[(size_t)L] = (bf16_t)(p0 >> 16); d[(size_t)2 * L] = (bf16_t)(p1 & 0xffffu); d[(size_t)3 * L] = (bf16_t)(p1 >> 16); }
    }
};
template <int L> struct EpiDft {
    bf16_t* FF; int tok0;
    __device__ __forceinline__ void operator()(const f32x4 (&acc)[2][2][4][2], const Unit& u, int wr, int wc, int fr, int fq) const {
        constexpr int H = L / 2;
        const size_t tokbase = (size_t)tok0 + (size_t)u.aux * L;
        const int c0 = wc * 32 + 8 * fq;
#pragma unroll
        for (int ai = 0; ai < 2; ++ai)
#pragma unroll
            for (int m = 0; m < 4; ++m) { const int r = u.pm * BM + ai * HALF + wr * 64 + m * 16 + fr; const int part = r > H ? 1 : 0, k = part ? r - H : r;
#pragma unroll
                for (int bj = 0; bj < 2; ++bj) { const int g = 2 * u.pn + bj; const f32x4 a0 = acc[ai][bj][m][0], a1 = acc[ai][bj][m][1];
                    const u32x4 pos = pack8(a0, a1);
                    bf16_t* d1 = FF + (tokbase + k) * 1024 + g * 256 + part * 128 + c0; *(PG8_GAS u32x4*)d1 = pos;
                    if (k != 0 && k != H) { bf16_t* d2 = FF + (tokbase + (L - k)) * 1024 + g * 256 + part * 128 + c0; u32x4 w = pos; if (part) { w.x ^= 0x80008000u; w.y ^= 0x80008000u; w.z ^= 0x80008000u; w.w ^= 0x80008000u; } *(PG8_GAS u32x4*)d2 = w; }
                    else if (!part) { bf16_t* d3 = FF + (tokbase + k) * 1024 + g * 256 + 128 + c0; *(PG8_GAS u32x4*)d3 = (u32x4){0u, 0u, 0u, 0u}; } } }
    }
};
constexpr float QSCALE = 0.125f * 1.4426950408889634f;
struct EpiQkv {
    bf16_t* Q; bf16_t* KA; bf16_t* VA; const float* rc; const float* rs; int is_ctx;
    __device__ __forceinline__ void operator()(const f32x4 (&acc)[2][2][4][2], const Unit& u, int wr, int wc, int fr, int fq) const {
        const int kind = u.pn >> 2, pt = u.pn & 3;
        const int rb = u.pm * BM;
        const int b = is_ctx ? rb / CTXL : rb / SEQ, s0 = is_ctx ? 0 : rb % SEQ;
        const size_t kvrow0 = (size_t)b * LKV + (is_ctx ? 0 : CTXL) + s0;
        const int lr0 = wr * 64 + fr;
        if (kind == 2) {
            const int col0 = pt * BM + wc * 32 + 8 * fq;
#pragma unroll
            for (int ai = 0; ai < 2; ++ai)
#pragma unroll
                for (int m = 0; m < 4; ++m) { bf16_t* rowp = VA + (kvrow0 + lr0 + ai * HALF + m * 16) * 1024 + col0;
#pragma unroll
                    for (int bj = 0; bj < 2; ++bj) *(PG8_GAS u32x4*)(rowp + bj * HALF) = pack8(acc[ai][bj][m][0], acc[ai][bj][m][1]); }
        } else {
            const int head = 2 * pt + (wc >> 1), comp = wc & 1, colb = head * 128 + comp * 64 + 8 * fq;
            const float sc = kind == 0 ? QSCALE : 1.f;
#pragma unroll
            for (int ai = 0; ai < 2; ++ai)
#pragma unroll
                for (int m = 0; m < 4; ++m) { const int lr = lr0 + ai * HALF + m * 16;
                    f32x4 o1[2], o2[2];
                    if (!is_ctx) { const float* pc = rc + (size_t)(s0 + lr) * 32 + 8 * fq; const float* ps = rs + (size_t)(s0 + lr) * 32 + 8 * fq;
#pragma unroll
                        for (int n = 0; n < 2; ++n) { const f32x4 cv = *(const PG8_GAS f32x4*)(pc + 4 * n), sv = *(const PG8_GAS f32x4*)(ps + 4 * n); const f32x4 x1 = acc[ai][0][m][n], x2 = acc[ai][1][m][n];
                            o1[n] = (x1 * cv - x2 * sv) * sc; o2[n] = (x2 * cv + x1 * sv) * sc; }
                    } else { o1[0] = acc[ai][0][m][0]; o1[1] = acc[ai][0][m][1]; o2[0] = acc[ai][1][m][0]; o2[1] = acc[ai][1][m][1]; }
                    bf16_t* d = (kind == 0 ? Q + (size_t)(rb + lr) * 1024 : KA + (kvrow0 + lr) * 1024) + colb;
                    *(u32x4*)d = pack8(o1[0], o1[1]); *(PG8_GAS u32x4*)(d + 32) = pack8(o2[0], o2[1]); }
        }
    }
};
}

namespace attn_body {
using bf16=__hip_bfloat16;
using bf16x8=__attribute__((ext_vector_type(8)))short;
using s16x4=__attribute__((ext_vector_type(4)))short;
using f32x16=__attribute__((ext_vector_type(16)))float;
using u32x4=__attribute__((ext_vector_type(4)))unsigned;
constexpr int D=64,DM=1024,DMO=2048;
constexpr int NW=8,NMAIN=4,QBLK=32,QB=QBLK*NMAIN,KVBLK=64;
constexpr int ATTN_PITCH=DM, ATTN_UNIT_ROWS=QB;
__device__ __forceinline__ int crow(int r,int hi){return (r&3)+8*(r>>2)+4*hi;}
#define SBAR() __builtin_amdgcn_sched_barrier(0)

constexpr int NSLOT=3, SLOTB=8192;
constexpr int LDS_K=0, LDS_V=NSLOT*SLOTB, LDS_P=LDS_V+NSLOT*2*SLOTB, LDS_WS=LDS_P+4*4096, LDS_FLAG=LDS_WS+NW*64*4, LDS_OST=LDS_FLAG+64, LDS_BYTES=LDS_OST+NW*4096;
constexpr float C2=0.125f*1.4426950408889634f;
__device__ __forceinline__ void glds16(const void*gsrc,unsigned lds_dst){unsigned keep;
  asm volatile("s_mov_b32 %0, m0\n\ts_mov_b32 m0, %2\n\ts_nop 0\n\tglobal_load_lds_dwordx4 %1, off\n\ts_mov_b32 m0, %0":"=&s"(keep):"v"(gsrc),"s"(lds_dst):"memory");}
__device__ __forceinline__ float max3f(float a,float b,float c){float r;asm("v_max3_f32 %0, %1, %2, %3":"=v"(r):"v"(a),"v"(b),"v"(c));return r;}
__device__ __forceinline__ float max2f(float a,float b){float r;asm("v_max_f32_e32 %0, %1, %2":"=v"(r):"v"(a),"v"(b));return r;}
__device__ __forceinline__ float fadd_s(float a,float b){float r;asm("v_add_f32_e32 %0, %1, %2":"=v"(r):"v"(a),"v"(b));return r;}
__device__ __forceinline__ float fsub_s(float a,float b){float r;asm("v_sub_f32_e32 %0, %1, %2":"=v"(r):"v"(a),"v"(b));return r;}
typedef float f32x2_t __attribute__((ext_vector_type(2))); typedef __bf16 bf16x2_t __attribute__((ext_vector_type(2)));
__device__ __forceinline__ unsigned cvtpk_s(float lo,float hi){f32x2_t v={lo,hi};bf16x2_t b=__builtin_convertvector(v,bf16x2_t);return __builtin_bit_cast(unsigned,b);}
#define WAIT_BAR(N) asm volatile("s_waitcnt vmcnt(" #N ") lgkmcnt(0)\n\ts_barrier":::"memory")

__device__ __forceinline__ void qkt(f32x16&p0,f32x16&p1,const char*Kslot,const bf16x8*qr,const f32x16&negm,int r32,int hi){
  const char*kb=Kslot+hi*1024+r32*16;
  #pragma unroll
  for(int d0=0;d0<4;++d0){
    const bf16x8 b0=*reinterpret_cast<const bf16x8*>(kb+d0*2048);
    const bf16x8 b1=*reinterpret_cast<const bf16x8*>(kb+d0*2048+512);
    if(d0==0){p0=__builtin_amdgcn_mfma_f32_32x32x16_bf16(b0,qr[0],negm,0,0,0);p1=__builtin_amdgcn_mfma_f32_32x32x16_bf16(b1,qr[0],negm,0,0,0);}
    else{p0=__builtin_amdgcn_mfma_f32_32x32x16_bf16(b0,qr[d0],p0,0,0,0);p1=__builtin_amdgcn_mfma_f32_32x32x16_bf16(b1,qr[d0],p1,0,0,0);}}
}
typedef __attribute__((address_space(3))) const char* lds_cptr;
typedef short v4i16_t __attribute__((ext_vector_type(4)));
__device__ __forceinline__ void kload8(bf16x8*kf,lds_cptr kp){
  kf[0]=*(const __attribute__((address_space(3))) bf16x8*)(kp);      kf[1]=*(const __attribute__((address_space(3))) bf16x8*)(kp+512);
  kf[2]=*(const __attribute__((address_space(3))) bf16x8*)(kp+2048); kf[3]=*(const __attribute__((address_space(3))) bf16x8*)(kp+2560);
  kf[4]=*(const __attribute__((address_space(3))) bf16x8*)(kp+4096); kf[5]=*(const __attribute__((address_space(3))) bf16x8*)(kp+4608);
  kf[6]=*(const __attribute__((address_space(3))) bf16x8*)(kp+6144); kf[7]=*(const __attribute__((address_space(3))) bf16x8*)(kp+6656);
}
__device__ __forceinline__ void kload2(bf16x8*kf,lds_cptr kp,int j){ kf[2*j]=*(const __attribute__((address_space(3))) bf16x8*)(kp+j*2048); kf[2*j+1]=*(const __attribute__((address_space(3))) bf16x8*)(kp+j*2048+512); }
__device__ __forceinline__ s16x4 vtr(lds_cptr p){ return __builtin_bit_cast(s16x4,__builtin_amdgcn_ds_read_tr16_b64_v4i16((__attribute__((address_space(3))) v4i16_t*)p)); }
__device__ __forceinline__ float rowmax(const f32x16&p0,const f32x16&p1){
  float a=max3f(p0[0],p0[1],p1[0]),b=max3f(p0[2],p0[3],p1[1]);a=max3f(a,p1[2],p1[3]);
  #pragma unroll
  for(int r=4;r<16;r+=4){a=max3f(a,p0[r],p0[r+1]);b=max3f(b,p0[r+2],p0[r+3]);a=max3f(a,p1[r],p1[r+1]);b=max3f(b,p1[r+2],p1[r+3]);}
  const float m=max2f(a,b);
  auto rr=__builtin_amdgcn_permlane32_swap(__float_as_uint(m),__float_as_uint(m),false,false);
  return max2f(__uint_as_float(rr[0]),__uint_as_float(rr[1]));
}
__device__ __forceinline__ void pv(f32x16*o,int vb,bf16x8 pa0,bf16x8 pa1,bf16x8 pa2,bf16x8 pa3){
  #pragma unroll
  for(int d0=0;d0<2;++d0){s16x4 lo[4],hi[4];
    #pragma unroll
    for(int ks=0;ks<4;++ks){
      asm volatile("ds_read_b64_tr_b16 %0,%1 offset:%c2":"=&v"(lo[ks]):"v"(vb),"i"(d0*4096+ks*1024):"memory");
      asm volatile("ds_read_b64_tr_b16 %0,%1 offset:%c2":"=&v"(hi[ks]):"v"(vb),"i"(d0*4096+ks*1024+512):"memory");}
    asm volatile("s_waitcnt lgkmcnt(0)":::"memory");SBAR();
    #define PK(k) (bf16x8){lo[k][0],lo[k][1],lo[k][2],lo[k][3],hi[k][0],hi[k][1],hi[k][2],hi[k][3]}
    o[d0]=__builtin_amdgcn_mfma_f32_32x32x16_bf16(pa0,PK(0),o[d0],0,0,0);
    o[d0]=__builtin_amdgcn_mfma_f32_32x32x16_bf16(pa1,PK(1),o[d0],0,0,0);
    o[d0]=__builtin_amdgcn_mfma_f32_32x32x16_bf16(pa2,PK(2),o[d0],0,0,0);
    o[d0]=__builtin_amdgcn_mfma_f32_32x32x16_bf16(pa3,PK(3),o[d0],0,0,0);
    #undef PK
  }
}

#ifndef ATTN_STORE16
#define ATTN_STORE16(p,v) (*(__attribute__((address_space(1))) u32x4*)(p)=(v))
#endif
template<int THRL> __device__ __forceinline__ void attn_unit(const bf16*Qu,const bf16*__restrict__ Kh,const bf16*__restrict__ Vh,bf16*Ou,const int NT,char*shm){
  const int tid=threadIdx.x,lane=tid&63,r32=lane&31,hi=lane>>5; const int wid=__builtin_amdgcn_readfirstlane(tid>>6);
  const int pw_=wid&3;
  const bf16*Qw=Qu+(long)(pw_*QBLK)*DM;
  const unsigned lds0=(unsigned)(uintptr_t)shm;
  float*wsf=(float*)(shm+LDS_WS)+pw_*128;
  volatile __attribute__((address_space(3))) int*flagp=(volatile __attribute__((address_space(3))) int*)(shm+LDS_FLAG)+pw_;
  char*pbuf=shm+LDS_P+pw_*4096+lane*16;
  const bf16*ksrc=Kh+(long)lane*DM+wid*8;
  const bf16*vsrc=Vh+(long)(16*(wid&3)+(lane>>2))*DM+(wid>>2)*32+(lane&3)*8;
  const unsigned kdst=lds0+LDS_K+wid*1024, vdst=lds0+LDS_V+wid*1024;
  #define DMA_K(t,slot) glds16(ksrc+(long)(t)*KVBLK*DM,(unsigned)__builtin_amdgcn_readfirstlane(kdst+(slot)))
  #define DMA_V(t,slot) do{ glds16(vsrc+(long)(t)*KVBLK*DM,(unsigned)__builtin_amdgcn_readfirstlane(vdst+2*(slot))); glds16(vsrc+64+(long)(t)*KVBLK*DM,(unsigned)__builtin_amdgcn_readfirstlane(vdst+8192+2*(slot))); }while(0)
  const int vb0=(int)(lds0+LDS_V)+((lane>>4)&1)*32+(lane&3)*8+(4*hi+((lane&15)>>2))*64;
  const char*Kbase=shm+LDS_K; bf16x8 kf[8];
  const lds_cptr shm3=(lds_cptr)shm; const lds_cptr kp0=shm3+LDS_K+hi*1024+r32*16; const lds_cptr vp0=shm3+LDS_V+((lane>>4)&1)*32+(lane&3)*8+(4*hi+((lane&15)>>2))*64;
  DMA_K(0,0);DMA_V(0,0);DMA_K(1,SLOTB);
  int sl_prev=0,sl_cur=0,sl_next=SLOTB;
  #define ROT() do{sl_prev=sl_cur;sl_cur=sl_next;sl_next=(sl_next==(NSLOT-1)*SLOTB)?0:sl_next+SLOTB;}while(0)
  #define MIDBAR() asm volatile("s_waitcnt lgkmcnt(0)\n\ts_barrier":::"memory")
  #define ENDW(tt) do{ if((tt)+3<NT){WAIT_BAR(3);} else if((tt)+2<NT){WAIT_BAR(2);} else {WAIT_BAR(0);} }while(0)
  typedef __attribute__((address_space(3))) char* lds_ptr;
  const lds_ptr pb3=(lds_ptr)(pbuf);
  if(wid<NMAIN){
  bf16x8 qr[4];
  #pragma unroll
  for(int d0=0;d0<4;++d0)qr[d0]=*(const __attribute__((address_space(1))) bf16x8*)(&Qw[(long)r32*DM+d0*16+hi*8]);
  float mhat=0.f,l_reg=0.f;f32x16 negm=f32x16{};asm volatile("":"+v"(negm));
  #define CMASK(P0,P1,t) do{}while(0)
  bool resc=false;
  #define START(P0,P1) do{ const float rm=rowmax(P0,P1); resc=false; \
    { const float dl=rm; mhat=fadd_s(mhat,dl); \
      _Pragma("unroll") for(int r=0;r<16;++r){P0[r]=fsub_s(P0[r],dl);P1[r]=fsub_s(P1[r],dl);} \
      _Pragma("unroll") for(int r=0;r<16;++r)negm[r]=-mhat; asm volatile("":"+v"(negm)); } \
    _Pragma("unroll") for(int r=0;r<16;++r)P0[r]=__builtin_amdgcn_exp2f(P0[r]); }while(0)
  #define RESC(par) do{}while(0)
  f32x16 pA0,pA1,pB0,pB1;
  DMA_K(2,2*SLOTB);
  WAIT_BAR(4);
  qkt(pA0,pA1,Kbase,qr,negm,r32,hi);asm volatile("s_nop 15\n\ts_nop 7":"+v"(pA0),"+v"(pA1));CMASK(pA0,pA1,0);
  START(pA0,pA1);
  _Pragma("unroll") for(int r=0;r<16;++r)pA1[r]=__builtin_amdgcn_exp2f(pA1[r]);
  WAIT_BAR(0);
  DMA_K(3,0);DMA_V(1,SLOTB);
  ROT();
  kload8(kf,kp0+sl_cur);
  WAIT_BAR(3);
  u32x4 pw0,pw1,pw2,pw3;
  #define PKW(P,B) cvtpk_s(P[B],P[B+1])
  #define PAF(k) __builtin_bit_cast(bf16x8,pw##k)
  #define VFR(i) (bf16x8){vlo[i][0],vlo[i][1],vlo[i][2],vlo[i][3],vhi[i][0],vhi[i][1],vhi[i][2],vhi[i][3]}
  #define PIN(x) asm volatile("":"+v"(x))
  #define MX3(a,b,c) __builtin_fmaxf(__builtin_fmaxf((a),(b)),(c))
  #define GAPA(MF,A0,A1,A2,A3,W0,W1,PW) do{ MF; sacc+=A0; sacc+=A1; sacc+=A2; sacc+=A3; PIN(sacc); W0; W1; PIN(PW); SBAR(); }while(0)
  #define EX(v) __builtin_amdgcn_exp2f(v)
  #define GAPB(X,B) do{ X[B]=EX(X[B]); X[B+1]=EX(X[B+1]); X[B+2]=EX(X[B+2]); X[B+3]=EX(X[B+3]); PIN(X); SBAR(); }while(0)
  #define VRD(i) do{ vlo[i]=vtr(vp_+(((i)>>2)*4096+((i)&3)*1024)); vhi[i]=vtr(vp_+(((i)>>2)*4096+((i)&3)*1024+512)); }while(0)
  #define KRD(G,j) do{ if(G){ kload2(kf,kp0+sl_next,j); SBAR(); } }while(0)
  #define STEP(C0,C1,P0,P1,t,GK,GV,GL) do{ SBAR(); \
    float sacc=(P0[0]+P0[1]); \
    GAPA(C0=__builtin_amdgcn_mfma_f32_32x32x16_bf16(kf[0],qr[0],negm,0,0,0), P0[2],P0[3],P0[4],P0[5],     pw0[0]=PKW(P0,0), pw0[1]=PKW(P0,2), pw0); \
    GAPA(C1=__builtin_amdgcn_mfma_f32_32x32x16_bf16(kf[1],qr[0],negm,0,0,0), P0[6],P0[7],P0[8],P0[9],     pw0[2]=PKW(P0,4), pw0[3]=PKW(P0,6), pw0); \
    GAPA(C0=__builtin_amdgcn_mfma_f32_32x32x16_bf16(kf[2],qr[1],C0,0,0,0),   P0[10],P0[11],P0[12],P0[13], pw1[0]=PKW(P0,8), pw1[1]=PKW(P0,10), pw1); \
    GAPA(C1=__builtin_amdgcn_mfma_f32_32x32x16_bf16(kf[3],qr[1],C1,0,0,0),   P0[14],P0[15],P1[0],P1[1],   pw1[2]=PKW(P0,12),pw1[3]=PKW(P0,14), pw1); \
    GAPA(C0=__builtin_amdgcn_mfma_f32_32x32x16_bf16(kf[4],qr[2],C0,0,0,0),   P1[2],P1[3],P1[4],P1[5],     pw2[0]=PKW(P1,0), pw2[1]=PKW(P1,2), pw2); \
    GAPA(C1=__builtin_amdgcn_mfma_f32_32x32x16_bf16(kf[5],qr[2],C1,0,0,0),   P1[6],P1[7],P1[8],P1[9],     pw2[2]=PKW(P1,4), pw2[3]=PKW(P1,6), pw2); \
    GAPA(C0=__builtin_amdgcn_mfma_f32_32x32x16_bf16(kf[6],qr[3],C0,0,0,0),   P1[10],P1[11],P1[12],P1[13], pw3[0]=PKW(P1,8), pw3[1]=PKW(P1,10), pw3); \
    GAPA(C1=__builtin_amdgcn_mfma_f32_32x32x16_bf16(kf[7],qr[3],C1,0,0,0),   P1[14],P1[15],0.f,0.f,       pw3[2]=PKW(P1,12),pw3[3]=PKW(P1,14), pw3); \
    l_reg+=sacc; \
    *(__attribute__((address_space(3))) u32x4*)(pb3)=pw0; *(__attribute__((address_space(3))) u32x4*)(pb3+1024)=pw1; *(__attribute__((address_space(3))) u32x4*)(pb3+2048)=pw2; *(__attribute__((address_space(3))) u32x4*)(pb3+3072)=pw3; \
    if(GK){DMA_K((t)+3,sl_cur);} if(GV){DMA_V((t)+1,sl_next);} \
    CMASK(C0,C1,t); \
    { float a=MX3(C0[0],C0[1],C1[0]),b=MX3(C0[2],C0[3],C1[1]); a=MX3(a,C1[2],C1[3]); \
      _Pragma("unroll") for(int r=4;r<16;r+=4){a=MX3(a,C0[r],C0[r+1]);b=MX3(b,C0[r+2],C0[r+3]);a=MX3(a,C1[r],C1[r+1]);b=MX3(b,C1[r+2],C1[r+3]);} \
      float rm=__builtin_fmaxf(a,b); { auto rr=__builtin_amdgcn_permlane32_swap(__float_as_uint(rm),__float_as_uint(rm),false,false); rm=__builtin_fmaxf(__uint_as_float(rr[0]),__uint_as_float(rr[1])); } \
      resc=false; \
      if(__builtin_expect(__any(rm>(float)THRL),0)){ const float dl=__builtin_fmaxf(rm,0.f); mhat+=dl; \
        _Pragma("unroll") for(int r=0;r<16;++r){C0[r]-=dl;C1[r]-=dl;} \
        _Pragma("unroll") for(int r=0;r<16;++r)negm[r]=-mhat; asm volatile("":"+v"(negm)); \
        const float f=__builtin_amdgcn_exp2f(-dl); l_reg*=f; if(hi==0)wsf[((t)&1)*32+r32]=f; resc=true; } } \
    if(lane==0)flagp[((t)&1)*4]=resc?1:0; \
    MIDBAR();   \
    SBAR(); \
    GAPB(C0,0); \
    GAPB(C0,4); \
    KRD(GL,0); GAPB(C0,8); \
    KRD(GL,1); GAPB(C0,12); \
    KRD(GL,2); GAPB(C1,0); \
    KRD(GL,3); GAPB(C1,4); \
    GAPB(C1,8); \
    GAPB(C1,12); \
    }while(0)
  int t=1;
  for(;t+5<NT;t+=2){
    STEP(pB0,pB1,pA0,pA1,t,true,true,true);     WAIT_BAR(3); RESC(1); ROT();
    STEP(pA0,pA1,pB0,pB1,t+1,true,true,true);   WAIT_BAR(3); RESC(0); ROT();
  }
  for(;t+1<NT;t+=2){
    STEP(pB0,pB1,pA0,pA1,t,(t+3<NT),(t+1<NT),(t+1<NT));       ENDW(t);   RESC(1); ROT();
    STEP(pA0,pA1,pB0,pB1,t+1,(t+4<NT),(t+2<NT),(t+2<NT));     ENDW(t+1); RESC(0); ROT();
  }
  STEP(pB0,pB1,pA0,pA1,NT-1,false,false,false); RESC(1);
  { float sacc=pB0[0]+pB0[1]; _Pragma("unroll") for(int r=2;r<16;++r)sacc+=pB0[r]; _Pragma("unroll") for(int r=0;r<16;++r)sacc+=pB1[r]; l_reg+=sacc;
    pw0=(u32x4){PKW(pB0,0),PKW(pB0,2),PKW(pB0,4),PKW(pB0,6)};pw1=(u32x4){PKW(pB0,8),PKW(pB0,10),PKW(pB0,12),PKW(pB0,14)};pw2=(u32x4){PKW(pB1,0),PKW(pB1,2),PKW(pB1,4),PKW(pB1,6)};pw3=(u32x4){PKW(pB1,8),PKW(pB1,10),PKW(pB1,12),PKW(pB1,14)};
    *(__attribute__((address_space(3))) u32x4*)(pb3)=pw0; *(__attribute__((address_space(3))) u32x4*)(pb3+1024)=pw1; *(__attribute__((address_space(3))) u32x4*)(pb3+2048)=pw2; *(__attribute__((address_space(3))) u32x4*)(pb3+3072)=pw3;
    MIDBAR(); }
  #undef PKW
  #undef PAF
  #undef VFR
  #undef PIN
  #undef MX3
  #undef GAPA
  #undef GAPB
  #undef EX
  #undef VRD
  #undef KRD
  #undef STEP
  {auto rr=__builtin_amdgcn_permlane32_swap(__float_as_uint(l_reg),__float_as_uint(l_reg),false,false);l_reg=__uint_as_float(rr[0])+__uint_as_float(rr[1]);}
  if(hi==0)wsf[64+r32]=l_reg;asm volatile("s_waitcnt lgkmcnt(0)\n\ts_barrier":::"memory");
  }else{
    f32x16 o2[4];o2[0]=f32x16{};o2[1]=f32x16{};o2[2]=f32x16{};o2[3]=f32x16{};
    const lds_cptr vq0=vp0;
    DMA_K(2,2*SLOTB);
    WAIT_BAR(4);
    WAIT_BAR(0);
    DMA_K(3,0);DMA_V(1,SLOTB);
    ROT();
    WAIT_BAR(3);
    #define HRESC(par) do{ if(flagp[(par)*4]){ _Pragma("unroll") for(int d_=0;d_<4;++d_) _Pragma("unroll") for(int r=0;r<16;++r)o2[d_][r]*=wsf[(par)*32+crow(r,hi)]; } }while(0)
    #define HVF(i) (bf16x8){hl[i][0],hl[i][1],hl[i][2],hl[i][3],hh[i][0],hh[i][1],hh[i][2],hh[i][3]}
    #define HPV(vbase) do{ s16x4 hl[16],hh[16]; const lds_cptr vp_=(vbase); \
      _Pragma("unroll") for(int i=0;i<16;++i){ hl[i]=vtr(vp_+((i>>2)*4096+(i&3)*1024)); hh[i]=vtr(vp_+((i>>2)*4096+(i&3)*1024+512)); } \
      MIDBAR(); \
      const bf16x8 pa0=*(const __attribute__((address_space(3))) bf16x8*)(pb3),pa1=*(const __attribute__((address_space(3))) bf16x8*)(pb3+1024),pa2=*(const __attribute__((address_space(3))) bf16x8*)(pb3+2048),pa3=*(const __attribute__((address_space(3))) bf16x8*)(pb3+3072); \
      o2[0]=__builtin_amdgcn_mfma_f32_32x32x16_bf16(pa0,HVF(0),o2[0],0,0,0); o2[1]=__builtin_amdgcn_mfma_f32_32x32x16_bf16(pa0,HVF(4),o2[1],0,0,0); o2[2]=__builtin_amdgcn_mfma_f32_32x32x16_bf16(pa0,HVF(8),o2[2],0,0,0); o2[3]=__builtin_amdgcn_mfma_f32_32x32x16_bf16(pa0,HVF(12),o2[3],0,0,0); o2[0]=__builtin_amdgcn_mfma_f32_32x32x16_bf16(pa1,HVF(1),o2[0],0,0,0); o2[1]=__builtin_amdgcn_mfma_f32_32x32x16_bf16(pa1,HVF(5),o2[1],0,0,0); o2[2]=__builtin_amdgcn_mfma_f32_32x32x16_bf16(pa1,HVF(9),o2[2],0,0,0); o2[3]=__builtin_amdgcn_mfma_f32_32x32x16_bf16(pa1,HVF(13),o2[3],0,0,0); o2[0]=__builtin_amdgcn_mfma_f32_32x32x16_bf16(pa2,HVF(2),o2[0],0,0,0); o2[1]=__builtin_amdgcn_mfma_f32_32x32x16_bf16(pa2,HVF(6),o2[1],0,0,0); o2[2]=__builtin_amdgcn_mfma_f32_32x32x16_bf16(pa2,HVF(10),o2[2],0,0,0); o2[3]=__builtin_amdgcn_mfma_f32_32x32x16_bf16(pa2,HVF(14),o2[3],0,0,0); o2[0]=__builtin_amdgcn_mfma_f32_32x32x16_bf16(pa3,HVF(3),o2[0],0,0,0); o2[1]=__builtin_amdgcn_mfma_f32_32x32x16_bf16(pa3,HVF(7),o2[1],0,0,0); o2[2]=__builtin_amdgcn_mfma_f32_32x32x16_bf16(pa3,HVF(11),o2[2],0,0,0); o2[3]=__builtin_amdgcn_mfma_f32_32x32x16_bf16(pa3,HVF(15),o2[3],0,0,0); }while(0)
    #define HSTEP(t,GK,GV) do{ if((t)>1){ HRESC(((t)-1)&1); } \
      if(GK){DMA_K((t)+3,sl_cur);} if(GV){DMA_V((t)+1,sl_next);} \
      HPV(vq0+2*sl_prev); }while(0)
    int t=1;
    for(;t+5<NT;t+=2){
      HSTEP(t,true,true);     WAIT_BAR(3); ROT();
      HSTEP(t+1,true,true);   WAIT_BAR(3); ROT();
    }
    for(;t+1<NT;t+=2){
      HSTEP(t,(t+3<NT),(t+1<NT));       ENDW(t);   ROT();
      HSTEP(t+1,(t+4<NT),(t+2<NT));     ENDW(t+1); ROT();
    }
    HSTEP(NT-1,false,false);
    { s16x4 hl[16],hh[16]; const lds_cptr vp_=vq0+2*sl_cur;
      _Pragma("unroll") for(int i=0;i<16;++i){ hl[i]=vtr(vp_+((i>>2)*4096+(i&3)*1024)); hh[i]=vtr(vp_+((i>>2)*4096+(i&3)*1024+512)); }
      MIDBAR();
      HRESC((NT-1)&1);
      const bf16x8 pa0=*(const __attribute__((address_space(3))) bf16x8*)(pb3),pa1=*(const __attribute__((address_space(3))) bf16x8*)(pb3+1024),pa2=*(const __attribute__((address_space(3))) bf16x8*)(pb3+2048),pa3=*(const __attribute__((address_space(3))) bf16x8*)(pb3+3072);
      o2[0]=__builtin_amdgcn_mfma_f32_32x32x16_bf16(pa0,HVF(0),o2[0],0,0,0); o2[1]=__builtin_amdgcn_mfma_f32_32x32x16_bf16(pa0,HVF(4),o2[1],0,0,0); o2[2]=__builtin_amdgcn_mfma_f32_32x32x16_bf16(pa0,HVF(8),o2[2],0,0,0); o2[3]=__builtin_amdgcn_mfma_f32_32x32x16_bf16(pa0,HVF(12),o2[3],0,0,0); o2[0]=__builtin_amdgcn_mfma_f32_32x32x16_bf16(pa1,HVF(1),o2[0],0,0,0); o2[1]=__builtin_amdgcn_mfma_f32_32x32x16_bf16(pa1,HVF(5),o2[1],0,0,0); o2[2]=__builtin_amdgcn_mfma_f32_32x32x16_bf16(pa1,HVF(9),o2[2],0,0,0); o2[3]=__builtin_amdgcn_mfma_f32_32x32x16_bf16(pa1,HVF(13),o2[3],0,0,0); o2[0]=__builtin_amdgcn_mfma_f32_32x32x16_bf16(pa2,HVF(2),o2[0],0,0,0); o2[1]=__builtin_amdgcn_mfma_f32_32x32x16_bf16(pa2,HVF(6),o2[1],0,0,0); o2[2]=__builtin_amdgcn_mfma_f32_32x32x16_bf16(pa2,HVF(10),o2[2],0,0,0); o2[3]=__builtin_amdgcn_mfma_f32_32x32x16_bf16(pa2,HVF(14),o2[3],0,0,0); o2[0]=__builtin_amdgcn_mfma_f32_32x32x16_bf16(pa3,HVF(3),o2[0],0,0,0); o2[1]=__builtin_amdgcn_mfma_f32_32x32x16_bf16(pa3,HVF(7),o2[1],0,0,0); o2[2]=__builtin_amdgcn_mfma_f32_32x32x16_bf16(pa3,HVF(11),o2[2],0,0,0); o2[3]=__builtin_amdgcn_mfma_f32_32x32x16_bf16(pa3,HVF(15),o2[3],0,0,0); }
    asm volatile("s_waitcnt lgkmcnt(0)\n\ts_barrier":::"memory");
    float rli[16];
    #pragma unroll
    for(int r=0;r<16;++r)rli[r]=__builtin_amdgcn_rcpf(wsf[64+crow(r,hi)]);
    bf16*Ow=Ou+(long)(pw_*QBLK)*DMO;
    #pragma unroll
    for(int hf=0;hf<2;++hf){ bf16*stg=(bf16*)(shm+LDS_OST)+wid*2048;
      #pragma unroll
      for(int r=0;r<16;++r){const int orow=crow(r,hi);
        #pragma unroll
        for(int d0=0;d0<2;++d0)stg[orow*64+d0*32+r32]=__float2bfloat16(o2[2*hf+d0][r]*rli[r]);}
      asm volatile("s_waitcnt lgkmcnt(0)":::"memory");
      #pragma unroll
      for(int i=0;i<4;++i){const int row=i*8+(lane>>3),ch=lane&7; const u32x4 v=*(const u32x4*)(stg+row*64+ch*8); ATTN_STORE16(Ow+(long)row*DMO+hf*64+ch*8,v);}
      asm volatile("s_waitcnt lgkmcnt(0)":::"memory"); }
    #undef HRESC
    #undef HVF
    #undef HPV
    #undef HSTEP
  }
  asm volatile("s_waitcnt lgkmcnt(0)\n\ts_barrier":::"memory");
  #undef DMA_K
  #undef DMA_V
  #undef CMASK
  #undef START
  #undef RESC
  #undef ROT
  #undef MIDBAR
  #undef ENDW
}
constexpr int ATTN_LDS_BYTES=LDS_BYTES;
#undef SBAR
#undef WAIT_BAR
}

constexpr int NWAVES = 8;
#ifndef DBG_LAST_PHASE
#define DBG_LAST_PHASE 25
#endif
constexpr int NPHASES = 26;

constexpr size_t MiB = 1u << 20;
constexpr size_t WS_CTL = 0, CTL_ZERO_BYTES = 1 * MiB;
constexpr size_t WS_MOD = 1 * MiB;
constexpr size_t WS_ROPE = 2 * MiB;
constexpr size_t WS_WIN = 3 * MiB;
constexpr size_t WS_WOUT = 6 * MiB;
constexpr size_t WS_WQKV = 8 * MiB;
constexpr size_t WS_WDAO = 14 * MiB;
constexpr size_t WS_SHUP = 16 * MiB;
constexpr size_t WS_SHDN = 18 * MiB;
constexpr size_t WS_WRT = 19 * MiB;
constexpr size_t WS_TABC = 19 * MiB + 512 * 1024;
constexpr size_t WS_BD = 20 * MiB;
constexpr size_t WS_LIST = 21 * MiB;
constexpr size_t WS_TOKSLOT = 29 * MiB + 512 * 1024;
constexpr size_t WS_TOKGATE = 30 * MiB + 768 * 1024;
constexpr size_t WS_CTXRES = 32 * MiB;
constexpr size_t WS_WEDN = 40 * MiB;
constexpr size_t WS_WEUP = 72 * MiB;
constexpr size_t WS_HX = 136 * MiB;
constexpr size_t WS_HID = 204 * MiB;
constexpr size_t WS_YEXP = 272 * MiB;
constexpr size_t WS_END = 542 * MiB;
constexpr size_t WS_TAB = 204 * MiB;
constexpr size_t WS_AGLU = 236 * MiB;
constexpr size_t WS_FT = 272 * MiB;
constexpr size_t WS_FTC = 304 * MiB;
constexpr size_t WS_FF = 306 * MiB;
constexpr size_t WS_MIX = 374 * MiB;
constexpr size_t WS_Y = 442 * MiB;
constexpr size_t WS_TOKLO = 272 * MiB;
constexpr size_t WS_Q = 204 * MiB;
constexpr size_t WS_OC = 272 * MiB;
constexpr size_t WS_KALL = 400 * MiB;
constexpr size_t WS_VALL = 468 * MiB;
constexpr size_t WS_Y1 = 400 * MiB;
static_assert(WS_LIST + (size_t)NCH * 64 * CAP * 4 <= WS_TOKSLOT && WS_TOKSLOT + (size_t)T0 * 32 <= WS_TOKGATE && WS_TOKGATE + (size_t)T0 * 32 <= WS_CTXRES, "lists");
constexpr int CW_TMO = 0, CW_CODE = 1, CW_BAR = 4096, CW_CNT = 16384, CNT_STRIDE = 64;

constexpr int RING_OFF = 0, RING_BYTES = 131072;
constexpr int LDSCTL_OFF = RING_BYTES, MISC_OFF = LDSCTL_OFF + 320, INPTR_OFF = LDSCTL_OFF + 512, TBL_OFF = LDSCTL_OFF + 1024;
constexpr int LDS_BYTES = 147456;

#define GAS __attribute__((address_space(1)))
#define LAS __attribute__((address_space(3)))
typedef unsigned short bf16;
typedef unsigned v4u __attribute__((ext_vector_type(4)));
typedef unsigned v2u __attribute__((ext_vector_type(2)));
typedef float f32x4 __attribute__((ext_vector_type(4)));
typedef short bf16x8 __attribute__((ext_vector_type(8)));
typedef GAS unsigned gu32;
#define RLX_AGENT __ATOMIC_RELAXED, __HIP_MEMORY_SCOPE_AGENT
#define LDS_WAIT() asm volatile("s_waitcnt lgkmcnt(0)" ::: "memory")
#define VM_WAIT() asm volatile("s_waitcnt vmcnt(0)" ::: "memory")
__device__ __forceinline__ unsigned f2bf(float f) { unsigned u = __builtin_bit_cast(unsigned, f); return (u + 0x7fffu + ((u >> 16) & 1u)) >> 16; }
__device__ __forceinline__ float bf2f(unsigned b) { return __builtin_bit_cast(float, b << 16); }
__device__ __forceinline__ unsigned pk2(float lo, float hi) { return f2bf(lo) | (f2bf(hi) << 16); }

#define XB_TMO      128
#define XB_XCNT(j)  (256  + 64 * (j))
#define XB_XSUB(j)  (1280 + 64 * (j))
#define XB_XGEN(j)  (2304 + 64 * (j))
#define XB_TOP      3328
#define XB_TOPGEN   3392
#define XCD_BAR_WORDS 3456
#define XB_SPIN_CAP (1u << 18)

__device__ __forceinline__ unsigned xb_ld(unsigned* p)              { return __hip_atomic_load(p, __ATOMIC_RELAXED, __HIP_MEMORY_SCOPE_AGENT); }
__device__ __forceinline__ unsigned xb_add(unsigned* p, unsigned v) { return __hip_atomic_fetch_add(p, v, __ATOMIC_RELAXED, __HIP_MEMORY_SCOPE_AGENT); }
__device__ __forceinline__ unsigned xb_xcc_id() { return (unsigned)__builtin_amdgcn_s_getreg((3 << 11) | 20) & 0xFu; }
#define XB_SPIN(cond, bar) do { unsigned _sp = 0; while (cond) { __builtin_amdgcn_s_sleep(1); \
    if ((++_sp & 255u) == 0u) { if (xb_ld(&(bar)[XB_TMO])) break; if (_sp > XB_SPIN_CAP) { atomicAdd(&(bar)[XB_TMO], 1u); break; } } } } while (0)

struct XcdBarrier {
    unsigned* bar; unsigned x;
    volatile LAS unsigned* st;
};

__device__ __forceinline__ XcdBarrier xcd_barrier_post(unsigned* bar, volatile LAS unsigned* st) {
    XcdBarrier b; b.bar = bar; b.x = xb_xcc_id(); b.st = st;
    if (threadIdx.x == 0) (void)xb_add(&bar[XB_XCNT(b.x)], 1u);
    return b;
}
__device__ __forceinline__ void xcd_barrier_complete(unsigned* bar, unsigned x, unsigned& nloc, unsigned& nx) {
    const unsigned G = gridDim.x * gridDim.y * gridDim.z;
    unsigned sum, cnt, mine, sp = 0u;
    for (;;) {
        sum = 0u; cnt = 0u; mine = 0u;
#pragma unroll
        for (unsigned j = 0; j < 16; ++j) { const unsigned c = xb_ld(&bar[XB_XCNT(j)]); sum += c; cnt += (c > 0u) ? 1u : 0u; mine = (j == x) ? c : mine; }
        if (sum == G) break;
        __builtin_amdgcn_s_sleep(1);
        if ((++sp & 255u) == 0u) { if (xb_ld(&bar[XB_TMO])) break; if (sp > XB_SPIN_CAP) { atomicAdd(&bar[XB_TMO], 1u); break; } }
    }
    nloc = mine > 0u ? mine : 1u; nx = cnt > 0u ? cnt : 1u;
}

__device__ __forceinline__ void xcd_barrier(const XcdBarrier& b) {
    asm volatile("s_waitcnt vmcnt(0)" ::: "memory");
    __syncthreads();
    if (threadIdx.x == 0) {
        unsigned* bar = b.bar;
        __builtin_amdgcn_s_waitcnt(0);
        unsigned nloc = b.st[0], nx = b.st[1];
        if (nloc == 0u) { xcd_barrier_complete(bar, b.x, nloc, nx); b.st[0] = nloc; b.st[1] = nx; }
        const unsigned old = xb_add(&bar[XB_XSUB(b.x)], 1u);
        const unsigned gen = old / nloc;
        if (old + 1u == (gen + 1u) * nloc) {
            __builtin_amdgcn_fence(__ATOMIC_RELEASE, "agent");
            asm volatile("s_waitcnt vmcnt(0)" ::: "memory");
            const unsigned og = xb_add(&bar[XB_TOP], 1u);
            const unsigned tg = og / nx;
            if (og + 1u == (tg + 1u) * nx) xb_add(&bar[XB_TOPGEN], 1u);
            else XB_SPIN(xb_ld(&bar[XB_TOPGEN]) == tg, bar);
            __builtin_amdgcn_fence(__ATOMIC_ACQUIRE, "agent");
            xb_add(&bar[XB_XGEN(b.x)], 1u);
            asm volatile("s_waitcnt vmcnt(0)" ::: "memory");
        } else {
            XB_SPIN(xb_ld(&bar[XB_XGEN(b.x)]) == gen, bar);
            __builtin_amdgcn_fence(__ATOMIC_ACQUIRE, "agent");
            asm volatile("s_waitcnt vmcnt(0)" ::: "memory");
        }
    }
    __syncthreads();
}

struct Frame {
    LAS unsigned char* lds;
    volatile LAS unsigned* MISC;
    gu32* ctl;
    unsigned char* ws;
    int tid, lane, wave, vcu, G;
    float* out;
};
template <class T> __device__ __forceinline__ T* wsp(const Frame& F, size_t off) { return (T*)(F.ws + off); }
enum { I_X = 0, I_C, I_CTX, I_CCTX, I_ADAW, I_ADAB, I_NORMG, I_WIN, I_CONVW, I_CONVB, I_LNG, I_LNB, I_WOUT, I_WQKV, I_LAMBDA, I_SUBLNG, I_DAWOUT, I_RTW, I_RTB, I_WGATE, I_WUP, I_WDOWN, I_SHG, I_SHU, I_SHD };
__device__ __forceinline__ const float* inp(const Frame& F, int i) { const LAS unsigned* t = (const LAS unsigned*)(F.lds + INPTR_OFF) + 2 * i;
    const unsigned lo = __builtin_amdgcn_readfirstlane(t[0]), hi = __builtin_amdgcn_readfirstlane(t[1]); return (const float*)(const GAS float*)(((unsigned long long)hi << 32) | lo); }
#define FENCE(F) do { int t_ = threadIdx.x; asm volatile("" : "+v"(t_)); F.tid = t_; F.lane = t_ & 63; F.wave = __builtin_amdgcn_readfirstlane(t_ >> 6); asm volatile("" : "+s"(F.ws), "+s"(F.out), "+s"(F.ctl) :: "memory"); F.ws = (unsigned char*)(GAS unsigned char*)F.ws; F.out = (float*)(GAS float*)F.out; } while (0)

__device__ __forceinline__ float wave_sum(float v) {
#pragma unroll
    for (int o = 1; o < 64; o <<= 1) v += __shfl_xor(v, o);
    return v;
}
__device__ __forceinline__ void ldrow_f32(const float* p, int lane, f32x4 (&v)[4]) { const GAS f32x4* q = (const GAS f32x4*)p + lane;
#pragma unroll
    for (int j = 0; j < 4; ++j) v[j] = q[64 * j]; }
__device__ __forceinline__ void ldrow_bf16(const bf16* p, int lane, f32x4 (&v)[4]) { const GAS v2u* q = (const GAS v2u*)p + lane;
#pragma unroll
    for (int j = 0; j < 4; ++j) { const v2u w = q[64 * j]; v[j] = (f32x4){bf2f(w.x & 0xffffu), bf2f(w.x >> 16), bf2f(w.y & 0xffffu), bf2f(w.y >> 16)}; } }
__device__ __forceinline__ void strow_f32(float* p, int lane, const f32x4 (&v)[4]) { GAS f32x4* q = (GAS f32x4*)p + lane;
#pragma unroll
    for (int j = 0; j < 4; ++j) q[64 * j] = v[j]; }
__device__ __forceinline__ void strow_bf16(bf16* p, int lane, const f32x4 (&v)[4]) { GAS v2u* q = (GAS v2u*)p + lane;
#pragma unroll
    for (int j = 0; j < 4; ++j) q[64 * j] = (v2u){pk2(v[j].x, v[j].y), pk2(v[j].z, v[j].w)}; }
__device__ __forceinline__ float rstd_of(const f32x4 (&v)[4]) { float s = 0.f;
#pragma unroll
    for (int j = 0; j < 4; ++j) s += (v[j].x * v[j].x + v[j].y * v[j].y) + (v[j].z * v[j].z + v[j].w * v[j].w);
    return rsqrtf(wave_sum(s) * (1.f / DM) + EPSN); }
__device__ __forceinline__ void modnorm(const f32x4 (&v)[4], float rstd, const float* g, const float* shift, const float* scale, int lane, f32x4 (&o)[4]) {
    f32x4 gg[4], sh[4], sc[4]; ldrow_f32(g, lane, gg); ldrow_f32(shift, lane, sh); ldrow_f32(scale, lane, sc);
#pragma unroll
    for (int j = 0; j < 4; ++j) o[j] = v[j] * rstd * gg[j] * (sc[j] + 1.f) + sh[j]; }
__device__ __forceinline__ const float* modp(const Frame& F, int layer, int rb, int j) { return wsp<const float>(F, WS_MOD) + ((size_t)(layer * 9 + rb) * 6 + j) * 1024; }
__device__ __forceinline__ int rowbatch(int row) { return row < TL ? row / SEQ : 8; }

__device__ __forceinline__ int maprow(int mode, int n) {
    if (mode == 1) { if (n < 512) return 256 * (n >> 7) + (n & 127); if (n < 1024) { const int q = n - 512; return 256 * (q >> 7) + 128 + (q & 127); } return n; }
    if (mode == 2) { if (n < 2048) { const int blk = n >> 10, q = n & 1023, h = q >> 7, comp = (q >> 6) & 1, d = q & 63, bj = d >> 5, dd = d & 31, g = (h & 1) * 2 + comp; return blk * 1024 + 256 * (h >> 1) + 128 * bj + 32 * g + dd; } return n; }
    if (mode == 3) return 256 * (n >> 7) + (n & 127);
    if (mode == 4) return 256 * (n >> 7) + 128 + (n & 127);
    return n;
}
__device__ __forceinline__ void p0_transpose_item(const float* W, int K, int N, bf16* WT, int mode, LAS float* scr, int item, int lane) {
    (void)scr;
    const int nblk = N / 32, kb = item / nblk, nb = item % nblk, a = lane & 7, q = lane >> 3, k0 = 64 * kb + 8 * q, n0 = 32 * nb + 4 * a;
    const GAS f32x4* src = (const GAS f32x4*)(W + (size_t)k0 * N + n0);
    f32x4 r[8];
#pragma unroll
    for (int i = 0; i < 8; ++i) r[i] = src[(size_t)i * (N / 4)];
#pragma unroll
    for (int j = 0; j < 4; ++j) { v4u o; o.x = pk2(r[0][j], r[1][j]); o.y = pk2(r[2][j], r[3][j]); o.z = pk2(r[4][j], r[5][j]); o.w = pk2(r[6][j], r[7][j]);
        *(GAS v4u*)(WT + (size_t)maprow(mode, n0 + j) * K + k0) = o; }
}
__device__ __forceinline__ void p0_router_item(const float* W, bf16* HI, bf16* LO, LAS float* scr, int item, int lane) {
    const int kb = item >> 1, nb = item & 1, k0 = 64 * kb, n0 = 32 * nb;
#pragma unroll 8
    for (int i = 0; i < 32; ++i) { const int kk = 2 * i + (lane >> 5); scr[kk * 33 + (lane & 31)] = ((const GAS float*)W)[(size_t)(k0 + kk) * 64 + n0 + (lane & 31)]; }
    LDS_WAIT(); asm volatile("" ::: "memory");
    const int c = lane & 7;
#pragma unroll
    for (int j = 0; j < 4; ++j) { const int n = (lane >> 3) + 8 * j; const LAS float* s = scr + (8 * c) * 33 + n;
        unsigned h[8], l[8];
#pragma unroll
        for (int q = 0; q < 8; ++q) { const float w = s[q * 33]; h[q] = f2bf(w); l[q] = f2bf(w - bf2f(h[q])); }
        v4u oh, ol; oh.x = h[0] | (h[1] << 16); oh.y = h[2] | (h[3] << 16); oh.z = h[4] | (h[5] << 16); oh.w = h[6] | (h[7] << 16);
        ol.x = l[0] | (l[1] << 16); ol.y = l[2] | (l[3] << 16); ol.z = l[4] | (l[5] << 16); ol.w = l[6] | (l[7] << 16);
        *(GAS v4u*)(HI + (size_t)(n0 + n) * 1024 + k0 + 8 * c) = oh; *(GAS v4u*)(LO + (size_t)(n0 + n) * 1024 + k0 + 8 * c) = ol; }
    LDS_WAIT(); asm volatile("" ::: "memory");
}
__device__ __forceinline__ void convert_experts(Frame& F, int layer) {
    LAS float* scr = (LAS float*)(F.lds + RING_OFF + F.wave * 16384);
    const int gw = F.vcu * NWAVES + F.wave, NGW = F.G * NWAVES;
    bf16* UP = wsp<bf16>(F, WS_WEUP); bf16* DN = wsp<bf16>(F, WS_WEDN);
    for (int it = gw; it < 64 * 384; it += NGW) {
        const int e = it / 384, r = it % 384; const size_t eo = (size_t)(layer * 64 + e) * 1024 * 256;
        if (r < 128) p0_transpose_item(inp(F, I_WGATE) + eo, 1024, 256, UP + (size_t)e * 512 * 1024, 3, scr, r, F.lane);
        else if (r < 256) p0_transpose_item(inp(F, I_WUP) + eo, 1024, 256, UP + (size_t)e * 512 * 1024, 4, scr, r - 128, F.lane);
        else p0_transpose_item(inp(F, I_WDOWN) + eo, 256, 1024, DN + (size_t)e * 1024 * 256, 0, scr, r - 256, F.lane);
    }
}
__device__ __forceinline__ float silu(float v) { return v / (1.f + __expf(-v)); }

__device__ __forceinline__ void p0_prologue(Frame& F) {
    __syncthreads();
#ifndef P0_PARTS
#define P0_PARTS 15
#endif
    if (P0_PARTS & 1)
    {
        LAS float* sc = (LAS float*)(F.lds);
        LAS float* part = (LAS float*)(F.lds + 40960);
        for (int i = F.tid; i < 9 * 1024; i += 512) { const int r = i >> 10, k = i & 1023; sc[i] = silu(r < 8 ? inp(F, I_C)[r * 1024 + k] : inp(F, I_CCTX)[k]); }
        __syncthreads();
        for (int item = F.vcu; item < 192; item += F.G) {
            const int layer = item / 96, col = (item % 96) * 64 + F.lane;
            const float* W = inp(F, I_ADAW) + (size_t)layer * 1024 * 6144 + col;
            float a[9];
#pragma unroll
            for (int r = 0; r < 9; ++r) a[r] = 0.f;
#pragma unroll 8
            for (int kk = 0; kk < 128; ++kk) { const int k = F.wave * 128 + kk; const float w = W[(size_t)k * 6144];
#pragma unroll
                for (int r = 0; r < 9; ++r) a[r] += sc[r * 1024 + k] * w; }
#pragma unroll
            for (int r = 0; r < 9; ++r) part[(F.wave * 9 + r) * 64 + F.lane] = a[r];
            __syncthreads();
            for (int i = F.tid; i < 576; i += 512) { const int r = i >> 6, l = i & 63; float s = 0.f;
#pragma unroll
                for (int w = 0; w < 8; ++w) s += part[(w * 9 + r) * 64 + l];
                const int cc = (item % 96) * 64 + l;
                wsp<float>(F, WS_MOD)[(size_t)(layer * 9 + r) * 6144 + cc] = s + inp(F, I_ADAB)[layer * 6144 + cc]; }
            __syncthreads();
        }
        __syncthreads();
    }
    LAS float* scr = (LAS float*)(F.lds + RING_OFF + F.wave * 16384);
    const int gw = F.vcu * NWAVES + F.wave, NGW = F.G * NWAVES;
    constexpr int NI_IN = 16 * 48, NI_OUT = 16 * 32, NI_QKV = 16 * 96, NI_DAO = 16 * 32, NI_SHG = 16 * 8, NI_SHD = 4 * 32, NI_RT = 32;
    constexpr int NI_TAB = 4096, NI_TABC = 256, NI_BD = 512, NI_ROPE = 2048;
    constexpr int NITEMS = NI_IN + NI_OUT + NI_QKV + NI_DAO + 4 * NI_SHG + 2 * NI_SHD + 2 * NI_RT + NI_TAB + NI_TABC + NI_BD + NI_ROPE;
#ifndef P0_IT_LO
#define P0_IT_LO 0
#define P0_IT_HI 1000000
#endif
    if (P0_PARTS & 2)
    for (int it = gw; it < NITEMS; it += NGW) {
        int r = it; if (it < P0_IT_LO || it >= P0_IT_HI) continue;
        if (r < NI_IN) { p0_transpose_item(inp(F, I_WIN), 1024, 1536, wsp<bf16>(F, WS_WIN), 1, scr, r, F.lane); continue; } r -= NI_IN;
        if (r < NI_OUT) { p0_transpose_item(inp(F, I_WOUT), 1024, 1024, wsp<bf16>(F, WS_WOUT), 0, scr, r, F.lane); continue; } r -= NI_OUT;
        if (r < NI_QKV) { p0_transpose_item(inp(F, I_WQKV), 1024, 3072, wsp<bf16>(F, WS_WQKV), 2, scr, r, F.lane); continue; } r -= NI_QKV;
        if (r < NI_DAO) { p0_transpose_item(inp(F, I_DAWOUT), 1024, 1024, wsp<bf16>(F, WS_WDAO), 0, scr, r, F.lane); continue; } r -= NI_DAO;
        if (r < 4 * NI_SHG) { const int l = r / (2 * NI_SHG), q = r % (2 * NI_SHG);
            if (q < NI_SHG) p0_transpose_item(inp(F, I_SHG) + (size_t)l * 1024 * 256, 1024, 256, wsp<bf16>(F, WS_SHUP) + (size_t)l * 512 * 1024, 3, scr, q, F.lane);
            else p0_transpose_item(inp(F, I_SHU) + (size_t)l * 1024 * 256, 1024, 256, wsp<bf16>(F, WS_SHUP) + (size_t)l * 512 * 1024, 4, scr, q - NI_SHG, F.lane);
            continue; } r -= 4 * NI_SHG;
        if (r < 2 * NI_SHD) { const int l = r / NI_SHD; p0_transpose_item(inp(F, I_SHD) + (size_t)l * 256 * 1024, 256, 1024, wsp<bf16>(F, WS_SHDN) + (size_t)l * 1024 * 256, 0, scr, r % NI_SHD, F.lane); continue; } r -= 2 * NI_SHD;
        if (r < 2 * NI_RT) { const int l = r / NI_RT; bf16* base = wsp<bf16>(F, WS_WRT) + (size_t)l * 2 * 64 * 1024; p0_router_item(inp(F, I_RTW) + (size_t)l * 1024 * 64, base, base + 64 * 1024, scr, r % NI_RT, F.lane); continue; } r -= 2 * NI_RT;
        if (r < NI_TAB) {
            const int kk = r <= 2048 ? r : r - 2048; bf16* row = wsp<bf16>(F, WS_TAB) + (size_t)r * 4096;
            for (int q = 0; q < 8; ++q) { const int l0 = q * 512 + F.lane * 8; unsigned h[8];
#pragma unroll
                for (int i = 0; i < 8; ++i) { const int idx = (kk * (l0 + i)) & 4095; float s, c; sincospif((float)idx * (1.f / 2048.f), &s, &c); h[i] = f2bf((r <= 2048 ? c : -s) * (1.f / 64.f)); }
                *(GAS v4u*)(row + l0) = (v4u){h[0] | (h[1] << 16), h[2] | (h[3] << 16), h[4] | (h[5] << 16), h[6] | (h[7] << 16)}; }
            continue; } r -= NI_TAB;
        if (r < NI_TABC) { const int kk = r <= 128 ? r : r - 128; bf16* row = wsp<bf16>(F, WS_TABC) + (size_t)r * 256; const int l0 = F.lane * 4; unsigned h[4];
#pragma unroll
            for (int i = 0; i < 4; ++i) { const int idx = (kk * (l0 + i)) & 255; float s, c; sincospif((float)idx * (1.f / 128.f), &s, &c); h[i] = f2bf((r <= 128 ? c : -s) * (1.f / 16.f)); }
            *(GAS v2u*)(row + l0) = (v2u){h[0] | (h[1] << 16), h[2] | (h[3] << 16)};
            continue; } r -= NI_TABC;
        if (r < NI_BD) { const int g = r >> 7, m = r & 127; bf16* row = wsp<bf16>(F, WS_BD) + (size_t)r * 1024; const int c0 = F.lane * 16; unsigned h[16];
#pragma unroll
            for (int i = 0; i < 16; ++i) { const int col = c0 + i, g2 = col >> 8, part = (col >> 7) & 1, cc = col & 127; const int idx = (m * cc) & 127; float s, c; sincospif((float)idx * (1.f / 64.f), &s, &c);
                h[i] = g2 == g ? f2bf((part ? s : c) * 0.08838834764831845f) : 0u; }
            *(GAS v4u*)(row + c0) = (v4u){h[0] | (h[1] << 16), h[2] | (h[3] << 16), h[4] | (h[5] << 16), h[6] | (h[7] << 16)};
            *(GAS v4u*)(row + c0 + 8) = (v4u){h[8] | (h[9] << 16), h[10] | (h[11] << 16), h[12] | (h[13] << 16), h[14] | (h[15] << 16)};
            continue; } r -= NI_BD;
        { const int s = r * 2 + (F.lane >> 5), dd = F.lane & 31, i = dd & 15; const float inv = powf(10000.f, -(float)i * (1.f / 16.f)); const float pos = (float)(dd < 16 ? s / 64 : s % 64); const float ang = pos * inv;
          wsp<float>(F, WS_ROPE)[s * 32 + dd] = cosf(ang); wsp<float>(F, WS_ROPE + 512 * 1024)[s * 32 + dd] = sinf(ang); }
    }
    if (P0_PARTS & 4) convert_experts(F, 0);
#if DBG_LAST_PHASE < 6
    if (P0_PARTS & 8)
    for (int m = gw; m < TL; m += NGW) { f32x4 v[4]; ldrow_f32(inp(F, I_X) + (size_t)m * DM, F.lane, v); strow_f32(F.out + (size_t)m * DM, F.lane, v); }
#endif
}

__device__ __forceinline__ void phase_modnorm0(Frame& F) {
    const int gw = F.vcu * NWAVES + F.wave, NGW = F.G * NWAVES;
    for (int row = gw; row < T0; row += NGW) {
        const int rb = rowbatch(row); const float* xr = row < TL ? inp(F, I_X) + (size_t)row * DM : inp(F, I_CTX) + (size_t)(row - TL) * DM;
        f32x4 v[4], o[4]; ldrow_f32(xr, F.lane, v);
        modnorm(v, rstd_of(v), inp(F, I_NORMG), modp(F, 0, rb, 0), modp(F, 0, rb, 1), F.lane, o);
        strow_bf16(wsp<bf16>(F, WS_HX) + (size_t)row * DM, F.lane, o);
    }
}
__device__ __forceinline__ void phase_e2(Frame& F, int layer) {
    const int gw = F.vcu * NWAVES + F.wave, NGW = F.G * NWAVES;
    const int nrows = layer == 0 ? T0 : TL;
    const bf16* Y = wsp<const bf16>(F, layer == 0 ? WS_Y : WS_Y1);
    const float* g1 = inp(F, I_NORMG) + (layer * 4 + 1) * 1024; const float* g2 = inp(F, I_NORMG) + (layer * 4 + 2) * 1024;
    for (int row = gw; row < nrows; row += NGW) {
        const int rb = rowbatch(row);
        const float* xr = layer == 0 ? (row < TL ? inp(F, I_X) + (size_t)row * DM : inp(F, I_CTX) + (size_t)(row - TL) * DM) : F.out + (size_t)row * DM;
        float* xo = row < TL ? F.out + (size_t)row * DM : wsp<float>(F, WS_CTXRES) + (size_t)(row - TL) * DM;
        f32x4 x[4], y[4], gg[4], mm[4]; ldrow_f32(xr, F.lane, x); ldrow_bf16(Y + (size_t)row * DM, F.lane, y);
        const float ry = rstd_of(y); ldrow_f32(g1, F.lane, gg); ldrow_f32(modp(F, layer, rb, 2), F.lane, mm);
#pragma unroll
        for (int j = 0; j < 4; ++j) x[j] = x[j] + mm[j] * (y[j] * ry * gg[j]);
        strow_f32(xo, F.lane, x);
        f32x4 t[4]; modnorm(x, rstd_of(x), g2, modp(F, layer, rb, 3), modp(F, layer, rb, 4), F.lane, t);
        GAS v2u* qh = (GAS v2u*)(wsp<bf16>(F, WS_HX) + (size_t)row * DM) + F.lane; GAS v2u* ql = (GAS v2u*)(wsp<bf16>(F, WS_TOKLO) + (size_t)row * DM) + F.lane;
#pragma unroll
        for (int j = 0; j < 4; ++j) { unsigned h[4], l[4];
#pragma unroll
            for (int i = 0; i < 4; ++i) { h[i] = f2bf(t[j][i]); l[i] = f2bf(t[j][i] - bf2f(h[i])); }
            qh[64 * j] = (v2u){h[0] | (h[1] << 16), h[2] | (h[3] << 16)}; ql[64 * j] = (v2u){l[0] | (l[1] << 16), l[2] | (l[3] << 16)}; }
    }
}
__device__ __forceinline__ void phase_e4(Frame& F, int layer, int chunk, int CT, bool dry = false) {
    const int gw = F.vcu * NWAVES + F.wave, NGW = F.G * NWAVES;
    const LAS int* tbs = (const LAS int*)(F.lds + TBL_OFF + 4096);
    const int NBr = tbs[64], cstart = chunk * CT;
    const bf16* YE = wsp<const bf16>(F, WS_YEXP);
    const GAS int* TS = (const GAS int*)wsp<const int>(F, WS_TOKSLOT); const GAS float* TG = (const GAS float*)wsp<const float>(F, WS_TOKGATE);
    const float* g3 = inp(F, I_NORMG) + (layer * 4 + 3) * 1024;
    for (int t = cstart + gw; t < cstart + CT; t += NGW) {
        const int rb = rowbatch(t);
        f32x4 y[4], v[4]; ldrow_bf16(YE + ((size_t)256 * NBr + (t - cstart)) * DM, F.lane, y);
#pragma unroll
        for (int k = 0; k < TOPK; ++k) { const int s = __builtin_amdgcn_readfirstlane(TS[t * 8 + k]); const float gt = __builtin_bit_cast(float, __builtin_amdgcn_readfirstlane(__builtin_bit_cast(int, TG[t * 8 + k])));
            const size_t row = (size_t)256 * tbs[s >> 20] + (s & 0xfffff); ldrow_bf16(YE + row * DM, F.lane, v);
#pragma unroll
            for (int j = 0; j < 4; ++j) y[j] = y[j] + v[j] * gt; }
        float* xo = t < TL ? F.out + (size_t)t * DM : wsp<float>(F, WS_CTXRES) + (size_t)(t - TL) * DM;
        f32x4 x[4], gg[4], mm[4]; ldrow_f32(xo, F.lane, x);
        const float ry = rstd_of(y); ldrow_f32(g3, F.lane, gg); ldrow_f32(modp(F, layer, rb, 5), F.lane, mm);
#pragma unroll
        for (int j = 0; j < 4; ++j) x[j] = x[j] + mm[j] * (y[j] * ry * gg[j]);
        if (dry) { if (x[0].x == 1.2345e30f) strow_f32(xo, F.lane, x); continue; }
        strow_f32(xo, F.lane, x);
        if (layer == 0) { f32x4 h[4]; modnorm(x, rstd_of(x), inp(F, I_NORMG) + 4 * 1024, modp(F, 1, rb, 0), modp(F, 1, rb, 1), F.lane, h); strow_bf16(wsp<bf16>(F, WS_HX) + (size_t)t * DM, F.lane, h); }
    }
}
__device__ __forceinline__ void phase_combine(Frame& F) {
    const int gw = F.vcu * NWAVES + F.wave, NGW = F.G * NWAVES;
    const float lam_init = 0.8f - 0.6f * expf(-0.3f);
    float s01 = 0.f, s23 = 0.f;
    for (int i = 0; i < 64; ++i) { s01 += inp(F, I_LAMBDA)[i] * inp(F, I_LAMBDA)[64 + i]; s23 += inp(F, I_LAMBDA)[128 + i] * inp(F, I_LAMBDA)[192 + i]; }
    const float lam = expf(s01) - expf(s23) + lam_init, post = 1.f - lam_init;
    const bf16* OC = wsp<const bf16>(F, WS_OC); bf16* AO = wsp<bf16>(F, WS_Q);
    const int h = F.lane >> 3, e0 = (F.lane & 7) * 16;
    float sg[16];
#pragma unroll
    for (int i = 0; i < 16; ++i) sg[i] = inp(F, I_SUBLNG)[e0 + i] * post;
    for (int t = gw; t < TL; t += NGW) {
        const bf16* p = OC + (size_t)t * 2048 + h * 256 + e0;
        const v4u a0 = *(const GAS v4u*)p, a1 = *(const GAS v4u*)(p + 8), b0 = *(const GAS v4u*)(p + 128), b1 = *(const GAS v4u*)(p + 136);
        const unsigned aw[8] = {a0.x, a0.y, a0.z, a0.w, a1.x, a1.y, a1.z, a1.w}, bw[8] = {b0.x, b0.y, b0.z, b0.w, b1.x, b1.y, b1.z, b1.w};
        float d[16]; float ss = 0.f;
#pragma unroll
        for (int i = 0; i < 8; ++i) { d[2 * i] = bf2f(aw[i] & 0xffffu) - lam * bf2f(bw[i] & 0xffffu); d[2 * i + 1] = bf2f(aw[i] >> 16) - lam * bf2f(bw[i] >> 16); ss += d[2 * i] * d[2 * i] + d[2 * i + 1] * d[2 * i + 1]; }
        ss += __shfl_xor(ss, 1); ss += __shfl_xor(ss, 2); ss += __shfl_xor(ss, 4);
        const float rstd = rsqrtf(ss * (1.f / 128.f) + EPSN);
        unsigned w[8];
#pragma unroll
        for (int i = 0; i < 8; ++i) w[i] = pk2(d[2 * i] * rstd * sg[2 * i], d[2 * i + 1] * rstd * sg[2 * i + 1]);
        bf16* q = AO + (size_t)t * DM + h * 128 + e0;
        *(GAS v4u*)q = (v4u){w[0], w[1], w[2], w[3]}; *(GAS v4u*)(q + 8) = (v4u){w[4], w[5], w[6], w[7]};
    }
}

__device__ __forceinline__ void phase_conv(Frame& F) {
    const int c = F.tid;
    float w[31];
#pragma unroll
    for (int j = 0; j < 31; ++j) w[j] = inp(F, I_CONVW)[j * 512 + c];
    const float bias = inp(F, I_CONVB)[c], lg = inp(F, I_LNG)[c], lb = inp(F, I_LNB)[c];
    LAS bf16* tile = (LAS bf16*)(F.lds);
    const bf16* AG = wsp<const bf16>(F, WS_AGLU); bf16* MIX = wsp<bf16>(F, WS_MIX);
    for (int ti = F.vcu; ti < 544; ti += F.G) {
        int rowbase, L, p0;
        if (ti < 512) { rowbase = (ti >> 6) * SEQ; p0 = (ti & 63) * 64; L = SEQ; } else { const int q = ti - 512; rowbase = TL + (q >> 2) * CTXL; p0 = (q & 3) * 64; L = CTXL; }
        __syncthreads();
        for (int rr = F.wave; rr < 94; rr += 8) { const int p = p0 - 15 + rr; v4u val = (v4u){0u, 0u, 0u, 0u};
            if (p >= 0 && p < L) val = *(const GAS v4u*)(AG + (size_t)(rowbase + p) * 512 + F.lane * 8);
            *(LAS v4u*)(tile + rr * 512 + F.lane * 8) = val; }
        __syncthreads();
        for (int ch = 0; ch < 8; ++ch) {
            float in[38];
#pragma unroll
            for (int i = 0; i < 38; ++i) in[i] = bf2f(tile[(ch * 8 + i) * 512 + c]);
#pragma unroll
            for (int q = 0; q < 8; ++q) { float a = bias;
#pragma unroll
                for (int j = 0; j < 31; ++j) a += w[j] * in[q + j];
                const float mean = wave_sum(a) * (1.f / 64.f), d = a - mean, var = wave_sum(d * d) * (1.f / 64.f);
                const float z = d * rsqrtf(var + EPSN) * lg + lb;
                ((GAS bf16*)MIX)[(size_t)(rowbase + p0 + ch * 8 + q) * DM + c] = (bf16)f2bf(silu(z)); }
        }
    }
    __syncthreads();
}

__device__ __forceinline__ void phase_router(Frame& F, int layer, int ntok, int CT, int cnt_off = 0) {
    typedef float f4 __attribute__((ext_vector_type(4)));
    const int gw = F.vcu * NWAVES + F.wave, NGW = F.G * NWAVES;
    LAS float* lg = (LAS float*)(F.lds + RING_OFF + F.wave * 20480);
    const bf16* TH = wsp<const bf16>(F, WS_HX); const bf16* TLo = wsp<const bf16>(F, WS_TOKLO);
    const bf16* WH = wsp<const bf16>(F, WS_WRT) + (size_t)layer * 2 * 64 * 1024; const bf16* WL = WH + 64 * 1024;
    const float* rbias = inp(F, I_RTB) + layer * 64;
    unsigned* cnt = (unsigned*)(F.ctl + CW_CNT) + layer * NCH * 64 * CNT_STRIDE + cnt_off;
    int* LIST = wsp<int>(F, WS_LIST); int* TS = wsp<int>(F, WS_TOKSLOT); float* TG = wsp<float>(F, WS_TOKGATE);
    const int lr = F.lane & 15, lq = F.lane >> 4;
    for (int task = F.wave * F.G + F.vcu; task < ntok / 64; task += NGW) {
        const int t0 = task * 64;
        f4 acc[4][4];
#pragma unroll
        for (int m = 0; m < 4; ++m)
#pragma unroll
            for (int n = 0; n < 4; ++n) acc[m][n] = (f4){0.f, 0.f, 0.f, 0.f};
        const bf16* ah = TH + (size_t)(t0 + lr) * DM + 8 * lq; const bf16* al = TLo + (size_t)(t0 + lr) * DM + 8 * lq;
        const bf16* bh = WH + (size_t)lr * DM + 8 * lq; const bf16* bl = WL + (size_t)lr * DM + 8 * lq;
        for (int ks = 0; ks < 32; ++ks) { const int k0 = ks * 32;
            bf16x8 xh[4], xl[4], wh[4], wl[4];
#pragma unroll
            for (int m = 0; m < 4; ++m) { xh[m] = *(const GAS bf16x8*)(ah + (size_t)m * 16 * DM + k0); xl[m] = *(const GAS bf16x8*)(al + (size_t)m * 16 * DM + k0); }
#pragma unroll
            for (int n = 0; n < 4; ++n) { wh[n] = *(const GAS bf16x8*)(bh + (size_t)n * 16 * DM + k0); wl[n] = *(const GAS bf16x8*)(bl + (size_t)n * 16 * DM + k0); }
#pragma unroll
            for (int m = 0; m < 4; ++m)
#pragma unroll
                for (int n = 0; n < 4; ++n) {
                    acc[m][n] = __builtin_amdgcn_mfma_f32_16x16x32_bf16(xh[m], wh[n], acc[m][n], 0, 0, 0);
                    acc[m][n] = __builtin_amdgcn_mfma_f32_16x16x32_bf16(xl[m], wh[n], acc[m][n], 0, 0, 0);
                    acc[m][n] = __builtin_amdgcn_mfma_f32_16x16x32_bf16(xh[m], wl[n], acc[m][n], 0, 0, 0); } }
#pragma unroll
        for (int m = 0; m < 4; ++m)
#pragma unroll
            for (int n = 0; n < 4; ++n)
#pragma unroll
                for (int j = 0; j < 4; ++j) lg[(m * 16 + 4 * lq + j) * 65 + n * 16 + lr] = acc[m][n][j];
        LDS_WAIT(); asm volatile("" ::: "memory");
        {
            const int t = t0 + F.lane;
            float v[64];
#pragma unroll
            for (int e = 0; e < 64; ++e) v[e] = 1.f / (1.f + expf(-lg[F.lane * 65 + e])) + rbias[e];
            float gs[8];
#pragma unroll
            for (int g = 0; g < 8; ++g) { float m1 = -INFINITY, m2 = -INFINITY;
#pragma unroll
                for (int i = 0; i < 8; ++i) { const float xx = v[8 * g + i]; m2 = fmaxf(m2, fminf(m1, xx)); m1 = fmaxf(m1, xx); }
                gs[g] = m1 + m2; }
#pragma unroll
            for (int g = 0; g < 8; ++g) { int rank = 0;
#pragma unroll
                for (int g2 = 0; g2 < 8; ++g2) rank += (gs[g2] > gs[g] || (gs[g2] == gs[g] && g2 < g)) ? 1 : 0;
                if (rank >= 4) {
#pragma unroll
                    for (int i = 0; i < 8; ++i) v[8 * g + i] = -INFINITY; } }
            int se[TOPK]; float ss[TOPK]; float ssum = 0.f;
#pragma unroll
            for (int k = 0; k < TOPK; ++k) { float best = -INFINITY; int bi = 0;
#pragma unroll
                for (int e = 0; e < 64; ++e) { const bool gt = v[e] > best; best = gt ? v[e] : best; bi = gt ? e : bi; }
#pragma unroll
                for (int e = 0; e < 64; ++e) v[e] = (e == bi) ? -INFINITY : v[e];
                const float bs = 1.f / (1.f + expf(-lg[F.lane * 65 + bi]));
                se[k] = bi; ss[k] = bs; ssum += bs; }
            const int chunk = t0 / CT; const float inv = 2.5f / ssum;
            LAS unsigned* hist = (LAS unsigned*)(lg + 64 * 65); LAS unsigned* hbase = hist + 64;
            hist[F.lane] = 0u; LDS_WAIT(); asm volatile("" ::: "memory");
            unsigned lrank[TOPK];
#pragma unroll
            for (int k = 0; k < TOPK; ++k) lrank[k] = __hip_atomic_fetch_add(hist + se[k], 1u, __ATOMIC_RELAXED, __HIP_MEMORY_SCOPE_WORKGROUP);
            LDS_WAIT(); asm volatile("" ::: "memory");
            { const unsigned tot = hist[F.lane]; unsigned base = 0u; if (tot) base = __hip_atomic_fetch_add(cnt + (chunk * 64 + F.lane) * CNT_STRIDE, tot, RLX_AGENT); hbase[F.lane] = base; }
            LDS_WAIT(); asm volatile("" ::: "memory");
#pragma unroll
            for (int k = 0; k < TOPK; ++k) { const int e = se[k]; const unsigned pos = hbase[e] + lrank[k];
                ((GAS int*)LIST)[((size_t)chunk * 64 + e) * CAP + pos] = t; ((GAS int*)TS)[t * 8 + k] = (e << 20) | (int)pos; ((GAS float*)TG)[t * 8 + k] = ss[k] * inv; }
        }
        LDS_WAIT(); asm volatile("" ::: "memory");
    }
}

template <bool GATHER_> struct MoeOrder {
    static constexpr bool GATHER = GATHER_;
    const LAS int* tb; int NBr, NBt, NPN, G, vcu;
    unsigned Asrc; int lda;
    unsigned Bexp, bstride, Bsh; int ldb;
    const int* list; const unsigned* cnt; int cstart;
    __device__ __forceinline__ bool next(int i, pg8::Unit& u) const {
        const int L = i * G + vcu; if (L >= NBt * NPN) return false;
        const int blk = L / NPN, pn = L - blk * NPN; u.pm = blk; u.pn = pn;
        if (blk < NBr) { const int w = tb[blk]; u.aux = w; u.B = Bexp + (unsigned)(w >> 16) * bstride + (unsigned)pn * 256u * ldb * 2u; }
        else { u.aux = -1; u.B = Bsh + (unsigned)pn * 256u * ldb * 2u; }
        u.A = GATHER ? Asrc : Asrc + (unsigned)blk * 256u * lda * 2u; return true;
    }
    __device__ __forceinline__ void aoffs(const pg8::Unit& u, unsigned (&v)[2][2]) const {
        int tid = threadIdx.x; asm volatile("" : "+v"(tid));
#pragma unroll
        for (int i = 0; i < 2; ++i) { int R, C; pg8::stage_rc(tid * 16 + i * 8192, R, C);
#pragma unroll
            for (int h = 0; h < 2; ++h) { const int r = h * 128 + R;
                if constexpr (!GATHER) v[h][i] = (unsigned)(r * lda + C) * 2u;
                else { int tok;
                    if (u.aux >= 0) { const int e = u.aux >> 16, pos = (u.aux & 0xffff) * 256 + r; tok = pos < (int)((const GAS unsigned*)cnt)[e * CNT_STRIDE] ? ((const GAS int*)list)[(size_t)e * CAP + pos] : cstart; }
                    else tok = cstart + (u.pm - NBr) * 256 + r;
                    v[h][i] = (unsigned)(tok * lda + C) * 2u; } } }
    }
};
__device__ __forceinline__ void moe_tables(Frame& F, const unsigned* cnt) {
    LAS int* tb = (LAS int*)(F.lds + TBL_OFF); LAS int* tbs = (LAS int*)(F.lds + TBL_OFF + 4096);
    __syncthreads();
    if (F.wave == 0) { const int c = (int)cnt[F.lane * CNT_STRIDE]; const int nb = (c + 255) >> 8; int inc = nb;
#pragma unroll
        for (int o = 1; o < 64; o <<= 1) { const int t = __shfl_up(inc, o); if (F.lane >= o) inc += t; }
        const int start = inc - nb; tbs[F.lane] = start; if (F.lane == 63) tbs[64] = inc;
        for (int j = 0; j < nb; ++j) tb[start + j] = (F.lane << 16) | j; }
    __syncthreads();
}

struct DftOrder {
    static constexpr bool GATHER = false;
    unsigned TAB, FT; int L, nM, G, vcu;
    __device__ __forceinline__ bool next(int i, pg8::Unit& u) const {
        const int U = i * G + vcu; if (U >= NBATCH * nM * 2) return false;
        const int b = U / (nM * 2), r = U % (nM * 2); u.pm = r >> 1; u.pn = r & 1; u.aux = b;
        u.A = TAB + (unsigned)u.pm * 256u * L * 2u; u.B = FT + ((unsigned)b * 512u + u.pn * 256u) * L * 2u; return true;
    }
    __device__ __forceinline__ void aoffs(const pg8::Unit&, unsigned (&v)[2][2]) const {
        int tid = threadIdx.x; asm volatile("" : "+v"(tid));
#pragma unroll
        for (int i = 0; i < 2; ++i) { int R, C; pg8::stage_rc(tid * 16 + i * 8192, R, C);
#pragma unroll
            for (int h = 0; h < 2; ++h) v[h][i] = (unsigned)((h * 128 + R) * L + C) * 2u; }
    }
};

struct Args { const float* in[25]; float* out; unsigned char* ws; int ph_lo, ph_hi, li, pad; };
#ifndef REPEAT_MASK
#define REPEAT_MASK 0u
#endif
#define IN(k) (lo <= (k) && (k) < hi && (k) <= DBG_LAST_PHASE)
#define REPS(k) for (int rep_ = 0; rep_ <= (int)((REPEAT_MASK >> (k)) & 1u); ++rep_)
#define SEAM(k) do { if (lo <= (k) && (k) + 1 < hi) xcd_barrier(bar); } while (0)

template <int LAYER, int CHUNK> __device__ __forceinline__ void moe_chunk(Frame& F, const XcdBarrier& bar, const int lo, const int hi) {
    constexpr int pb = 6 + 12 * LAYER, p = pb + 2 + 3 * CHUNK, ntok = LAYER == 0 ? T0 : TL, CT = ntok / NCH;
    if (IN(p)) REPS(p) { FENCE(F);
        const unsigned* cnt = (const unsigned*)(F.ctl + CW_CNT) + (LAYER * NCH + CHUNK) * 64 * CNT_STRIDE; const int* list = wsp<const int>(F, WS_LIST) + (size_t)CHUNK * 64 * CAP;
        const LAS int* tb = (const LAS int*)(F.lds + TBL_OFF); const LAS int* tbs = (const LAS int*)(F.lds + TBL_OFF + 4096);
        moe_tables(F, cnt); const int NBr = tbs[64];
        MoeOrder<true> S{tb, NBr, NBr + CT / 256, 2, F.G, F.vcu, (unsigned)WS_HX, 1024, (unsigned)WS_WEUP, 512u * 1024u * 2u, (unsigned)WS_SHUP + (unsigned)LAYER * 512u * 1024u * 2u, 1024, list, cnt, CHUNK * CT};
        pg8::EpiSwiglu E{wsp<bf16>(F, WS_HID), 256}; pg8::gemm_phase(F.lds + RING_OFF, F.ws, 1024, 1024, S, E); } SEAM(p);
    if (IN(p + 1)) REPS(p + 1) { FENCE(F);
        const unsigned* cnt = (const unsigned*)(F.ctl + CW_CNT) + (LAYER * NCH + CHUNK) * 64 * CNT_STRIDE; const int* list = wsp<const int>(F, WS_LIST) + (size_t)CHUNK * 64 * CAP;
        const LAS int* tb = (const LAS int*)(F.lds + TBL_OFF); const LAS int* tbs = (const LAS int*)(F.lds + TBL_OFF + 4096);
        moe_tables(F, cnt); const int NBr = tbs[64];
        MoeOrder<false> S{tb, NBr, NBr + CT / 256, 4, F.G, F.vcu, (unsigned)WS_HID, 256, (unsigned)WS_WEDN, 1024u * 256u * 2u, (unsigned)WS_SHDN + (unsigned)LAYER * 1024u * 256u * 2u, 256, list, cnt, CHUNK * CT};
        pg8::EpiBf16 E{wsp<bf16>(F, WS_YEXP), 1024, 0}; pg8::gemm_phase(F.lds + RING_OFF, F.ws, 256, 256, S, E); } SEAM(p + 1);
    if (IN(p + 2)) REPS(p + 2) { FENCE(F);
        const unsigned* cnt = (const unsigned*)(F.ctl + CW_CNT) + (LAYER * NCH + CHUNK) * 64 * CNT_STRIDE;
        moe_tables(F, cnt);
#ifdef E4_TIMING
        phase_e4(F, LAYER, CHUNK, CT, true); FENCE(F);
#endif
        phase_e4(F, LAYER, CHUNK, CT); } SEAM(p + 2);
}
template <int LAYER> __device__ __forceinline__ void moe_part(Frame& F, const XcdBarrier& bar, const int lo, const int hi) {
    constexpr int pb = 6 + 12 * LAYER, ntok = LAYER == 0 ? T0 : TL, CT = ntok / NCH;
    if (IN(pb)) REPS(pb) { FENCE(F); phase_e2(F, LAYER); } SEAM(pb);
    if (IN(pb + 1)) { FENCE(F);
#ifdef ROUTER_TIMING
        phase_router(F, LAYER, ntok, CT, 4 * 64 * CNT_STRIDE); FENCE(F);
#endif
        phase_router(F, LAYER, ntok, CT); } SEAM(pb + 1);
    moe_chunk<LAYER, 0>(F, bar, lo, hi);
    moe_chunk<LAYER, 1>(F, bar, lo, hi);
}

__global__ void __launch_bounds__(NWAVES * 64, 2) mega_fwd(Args args) {
    extern __shared__ __attribute__((aligned(16))) unsigned char lds[];
    Frame F;
    F.lds = (LAS unsigned char*)lds;
    F.MISC = (volatile LAS unsigned*)(F.lds + MISC_OFF);
    F.tid = threadIdx.x; F.lane = F.tid & 63; F.wave = __builtin_amdgcn_readfirstlane(F.tid >> 6);
    F.G = gridDim.x; { const int bx = blockIdx.x; F.vcu = (F.G % 8 == 0) ? (bx % 8) * (F.G / 8) + bx / 8 : bx; }
    F.ws = args.ws; F.ctl = (gu32*)(args.ws + WS_CTL); F.out = args.out;
    for (int u = F.tid; u < (LDS_BYTES - LDSCTL_OFF) / 4; u += NWAVES * 64) ((LAS unsigned*)(F.lds + LDSCTL_OFF))[u] = 0u;
    __syncthreads();
    if (F.tid < 25) { const unsigned long long pv = (unsigned long long)args.in[F.tid]; LAS unsigned* t = (LAS unsigned*)(F.lds + INPTR_OFF) + 2 * F.tid; t[0] = (unsigned)pv; t[1] = (unsigned)(pv >> 32); }
    __syncthreads();
    XcdBarrier bar; bar.bar = (unsigned*)(F.ctl + CW_BAR); bar.x = 0; bar.st = nullptr;
#if MK_SINGLE
    bar = xcd_barrier_post((unsigned*)(F.ctl + CW_BAR), F.MISC + 8);
#endif
    const int lo = args.ph_lo, hi = args.ph_hi;
    const int bx = (int)blockIdx.x;

    if (IN(0)) REPS(0) { FENCE(F); p0_prologue(F); } SEAM(0);
    if (IN(1)) REPS(1) { FENCE(F); phase_modnorm0(F); } SEAM(1);
    if (IN(2)) REPS(2) { FENCE(F);
        { pg8::DenseOrder S; S.init((unsigned)WS_HX, 1024, (unsigned)WS_WIN, 1024, T0 / 256, 4, 0, F.G, bx); pg8::EpiGlu E{wsp<bf16>(F, WS_AGLU)}; pg8::gemm_phase(F.lds + RING_OFF, F.ws, 1024, 1024, S, E); }
        FENCE(F);
        { pg8::DenseOrder S; S.init((unsigned)WS_HX, 1024, (unsigned)WS_WIN, 1024, T0 / 256, 2, 4, F.G, bx); pg8::EpiFT E{wsp<bf16>(F, WS_FT), wsp<bf16>(F, WS_FTC)}; pg8::gemm_phase(F.lds + RING_OFF, F.ws, 1024, 1024, S, E); } } SEAM(2);
    if (IN(3)) REPS(3) { FENCE(F); phase_conv(F);
        { DftOrder S{(unsigned)WS_TAB, (unsigned)WS_FT, SEQ, SEQ / 256, F.G, F.vcu}; pg8::EpiDft<SEQ> E{wsp<bf16>(F, WS_FF), 0}; pg8::gemm_phase(F.lds + RING_OFF, F.ws, SEQ, SEQ, S, E); }
        FENCE(F);
        { DftOrder S{(unsigned)WS_TABC, (unsigned)WS_FTC, CTXL, 1, F.G, F.vcu}; pg8::EpiDft<CTXL> E{wsp<bf16>(F, WS_FF), TL}; pg8::gemm_phase(F.lds + RING_OFF, F.ws, CTXL, CTXL, S, E); } } SEAM(3);
    if (IN(4)) REPS(4) { FENCE(F); pg8::DenseOrder S; S.init((unsigned)WS_FF, 1024, (unsigned)WS_BD, 1024, T0 / 256, 2, 0, F.G, bx);
        pg8::EpiBf16 E{wsp<bf16>(F, WS_MIX), 1024, 512}; pg8::gemm_phase(F.lds + RING_OFF, F.ws, 1024, 1024, S, E); } SEAM(4);
    if (IN(5)) REPS(5) { FENCE(F); pg8::DenseOrder S; S.init((unsigned)WS_MIX, 1024, (unsigned)WS_WOUT, 1024, T0 / 256, 4, 0, F.G, bx);
        pg8::EpiBf16 E{wsp<bf16>(F, WS_Y), 1024, 0}; pg8::gemm_phase(F.lds + RING_OFF, F.ws, 1024, 1024, S, E); } SEAM(5);
    moe_part<0>(F, bar, lo, hi);
    if (IN(14)) REPS(14) { FENCE(F);
        { pg8::DenseOrder S; S.init((unsigned)WS_HX, 1024, (unsigned)WS_WQKV, 1024, TL / 256, 12, 0, F.G, bx);
          pg8::EpiQkv E{wsp<bf16>(F, WS_Q), wsp<bf16>(F, WS_KALL), wsp<bf16>(F, WS_VALL), wsp<float>(F, WS_ROPE), wsp<float>(F, WS_ROPE + 512 * 1024), 0}; pg8::gemm_phase(F.lds + RING_OFF, F.ws, 1024, 1024, S, E); }
        FENCE(F);
        { pg8::DenseOrder S; S.init((unsigned)(WS_HX + (size_t)TL * 2048), 1024, (unsigned)WS_WQKV, 1024, TC / 256, 8, 4, F.G, bx);
          pg8::EpiQkv E{wsp<bf16>(F, WS_Q), wsp<bf16>(F, WS_KALL), wsp<bf16>(F, WS_VALL), wsp<float>(F, WS_ROPE), wsp<float>(F, WS_ROPE + 512 * 1024), 1}; pg8::gemm_phase(F.lds + RING_OFF, F.ws, 1024, 1024, S, E); }
    } SEAM(14);
    if (IN(15)) REPS(15) { FENCE(F);
        const attn_body::bf16* Q = wsp<const attn_body::bf16>(F, WS_Q); const attn_body::bf16* KA = wsp<const attn_body::bf16>(F, WS_KALL); const attn_body::bf16* VA = wsp<const attn_body::bf16>(F, WS_VALL);
        attn_body::bf16* OC = wsp<attn_body::bf16>(F, WS_OC);
        for (int i = 0;; ++i) { int bh, cc, qb;
            if (F.G == 256) { if (i >= 16) break; const int xg = F.vcu >> 5, ci = F.vcu & 31, un = (i & 1) * 32 + ci; bh = xg * 8 + (i >> 1); cc = un >> 5; qb = un & 31; }
            else { const int u = i * F.G + F.vcu; if (u >= 64 * 2 * (SEQ / 128)) break; bh = u >> 6; cc = (u >> 5) & 1; qb = u & 31; }
            const int b = bh >> 3, h = bh & 7;
            attn_body::attn_unit<8>(Q + ((size_t)b * SEQ + qb * 128) * 1024 + h * 128 + cc * 64, KA + (size_t)b * LKV * 1024 + h * 128 + cc * 64, VA + (size_t)b * LKV * 1024 + h * 128,
                                    OC + ((size_t)b * SEQ + qb * 128) * 2048 + h * 256 + cc * 128, LKV / 64, (char*)lds + RING_OFF); }
    } SEAM(15);
    if (IN(16)) REPS(16) { FENCE(F); phase_combine(F); FENCE(F); convert_experts(F, 1); } SEAM(16);
    if (IN(17)) REPS(17) { FENCE(F); pg8::DenseOrder S; S.init((unsigned)WS_Q, 1024, (unsigned)WS_WDAO, 1024, TL / 256, 4, 0, F.G, bx);
        pg8::EpiBf16 E{wsp<bf16>(F, WS_Y1), 1024, 0}; pg8::gemm_phase(F.lds + RING_OFF, F.ws, 1024, 1024, S, E); } SEAM(17);
    moe_part<1>(F, bar, lo, hi);
}
#undef IN
#undef SEAM

extern "C" void kernel_launch(void* const* d_in, const int* in_sizes, int n_in, void* d_out, int out_size, void* d_ws, size_t ws_size, hipStream_t stream) {
    static int grid = 0;
    if (grid == 0) {
        if (n_in != 25 || in_sizes[0] != TL * DM || out_size != TL * DM || ws_size < WS_END) { fprintf(stderr, "kernel_launch: unexpected problem shape / workspace (n_in %d, in0 %d, out %d, ws %zu, need %zu); nothing launched\n", n_in, n_in > 0 ? in_sizes[0] : -1, out_size, ws_size, (size_t)WS_END); grid = -1; return; }
        int dev = 0, cus = 0, per_cu = 0;
        if (hipGetDevice(&dev) != hipSuccess || hipDeviceGetAttribute(&cus, hipDeviceAttributeMultiprocessorCount, dev) != hipSuccess) { grid = -1; return; }
        if (hipFuncSetAttribute((const void*)mega_fwd, hipFuncAttributeMaxDynamicSharedMemorySize, LDS_BYTES) != hipSuccess) { fprintf(stderr, "kernel_launch: hipFuncSetAttribute failed\n"); grid = -1; return; }
        if (hipOccupancyMaxActiveBlocksPerMultiprocessor(&per_cu, (const void*)mega_fwd, NWAVES * 64, LDS_BYTES) != hipSuccess || per_cu < 1) fprintf(stderr, "kernel_launch: occupancy query reports %d per CU\n", per_cu);
        (void)hipGetLastError();
        grid = cus;
    }
    if (grid < 0) return;
    if (hipMemsetAsync((char*)d_ws + WS_CTL, 0, CTL_ZERO_BYTES, stream) != hipSuccess) return;
    Args a{};
    for (int i = 0; i < 25; ++i) a.in[i] = (const float*)d_in[i];
    a.out = (float*)d_out; a.ws = (unsigned char*)d_ws;
#if MK_SINGLE
    a.ph_lo = 0; a.ph_hi = NPHASES; a.li = 0;
    hipLaunchKernelGGL(mega_fwd, dim3(grid), dim3(NWAVES * 64), LDS_BYTES, stream, a);
#else
    for (int p = 0; p <= DBG_LAST_PHASE && p < NPHASES; ++p) { a.ph_lo = p; a.ph_hi = p + 1; a.li = p;
        hipLaunchKernelGGL(mega_fwd, dim3(grid), dim3(NWAVES * 64), LDS_BYTES, stream, a); }
#endif
}
```

```cpp
#include <hip/hip_runtime.h>
#include <hip/hip_bf16.h>
#include <cstdio>
#include <cstdint>
#include <cmath>

#ifndef MK_SINGLE
#define MK_SINGLE 1
#endif

constexpr int DM = 1024, NBATCH = 8, SEQ = 4096, CTXL = 256;
constexpr int TL = NBATCH * SEQ;
constexpr int TC = NBATCH * CTXL;
constexpr int T0 = TL + TC;
constexpr int LKV = CTXL + SEQ;
constexpr float EPSN = 1e-6f;
constexpr int NEXP = 64, TOPK = 6;
constexpr int NCH = 1;
constexpr int CAP = T0 / NCH;

namespace pg8 {
#define PG8_LAS __attribute__((address_space(3)))
#define PG8_GAS __attribute__((address_space(1)))
typedef unsigned short bf16_t;
typedef short bf16x8 __attribute__((ext_vector_type(8)));
typedef float f32x4 __attribute__((ext_vector_type(4)));
typedef unsigned u32x4 __attribute__((ext_vector_type(4)));
constexpr int BM = 256, BK = 64, HALF = 128, HTB = HALF * BK * 2, STAGE_BYTES = 8 * HTB;

__host__ __device__ __forceinline__ int lds_byte(int r, int c) { const int st = (r >> 4) * 2 + (c >> 5), rr = r & 15, cc = c & 31, ob = rr * 64 + cc * 2; return st * 1024 + (ob ^ (((ob >> 9) & 1) << 5)); }
__host__ __device__ __forceinline__ void stage_rc(int b, int& R, int& C) { const int st = b / 1024, sb = b % 1024, swz = sb ^ (((sb >> 9) & 1) << 5); R = (st >> 1) * 16 + swz / 64; C = (st & 1) * 32 + (swz % 64) / 2; }
__host__ __device__ __forceinline__ int perm32(int rho) { const int n = rho >> 4, i = rho & 15; return 8 * (i >> 2) + 4 * n + (i & 3); }

struct Unit { unsigned A, B; int pm, pn, aux; };

__device__ __forceinline__ unsigned cvt_pk_bf16(float lo, float hi) { unsigned r; asm volatile("v_cvt_pk_bf16_f32 %0, %1, %2" : "=v"(r) : "v"(lo), "v"(hi)); return r; }
__device__ __forceinline__ u32x4 pack8(const f32x4& a, const f32x4& b) { u32x4 w; w.x = cvt_pk_bf16(a[0], a[1]); w.y = cvt_pk_bf16(a[2], a[3]); w.z = cvt_pk_bf16(b[0], b[1]); w.w = cvt_pk_bf16(b[2], b[3]); return w; }

#ifndef EPI_SC1
#define EPI_SC1 16
#endif
#ifndef FP8_ST_NT
#define FP8_ST_NT 1
#endif
#ifndef HID_ST_NT
#define HID_ST_NT 0
#endif
#ifndef EPI_NT
#define EPI_NT 2
#endif
struct WsStore { __amdgpu_buffer_rsrc_t r; const unsigned char* b;
    __device__ __forceinline__ WsStore(const void* wsbase) : r(__builtin_amdgcn_make_buffer_rsrc((void*)wsbase, 0, 0x7fffffff, 0x00020000)), b((const unsigned char*)wsbase) {}
    __device__ __forceinline__ void st(const void* p, const u32x4& v) const { __builtin_amdgcn_raw_buffer_store_b128(v, r, (unsigned)((const unsigned char*)p - b), 0, EPI_SC1); }
    __device__ __forceinline__ void st_nt(const void* p, const u32x4& v) const { __builtin_amdgcn_raw_buffer_store_b128(v, r, (unsigned)((const unsigned char*)p - b), 0, EPI_SC1 | EPI_NT); } };

template <class Epi, class Sched>
__device__ __forceinline__ void gemm_phase(PG8_LAS unsigned char* lds, const void* wsbase, const int K, const int ldb, const Sched& S, const Epi& E) {
    const __amdgpu_buffer_rsrc_t rsrc = __builtin_amdgcn_make_buffer_rsrc((void*)wsbase, 0, 0x7fffffff, 0x00020000);
    int tid_ = threadIdx.x; asm volatile("" : "+v"(tid_));
    const int tid = tid_, wid = __builtin_amdgcn_readfirstlane(tid >> 6), lane = tid & 63, wr = wid >> 2, wc = wid & 3, fr = lane & 15, fq = lane >> 4;
    const int nt = K / BK;
    unsigned voffB[2];
#pragma unroll
    for (int i = 0; i < 2; ++i) { int R, C; stage_rc(tid * 16 + i * 8192, R, C); const int Rb = Epi::WIDE ? 64 * (R >> 5) + perm32(R & 31) : (R & ~31) + perm32(R & 31); voffB[i] = (unsigned)(Rb * ldb + C) * 2u; }
    const unsigned kstep = (unsigned)(BK * 2);
    const unsigned hstepB = (unsigned)(Epi::WIDE ? 32 : HALF) * ldb * 2;
    const unsigned ldsw = (unsigned)wid * 1024u;
    const int aoff = lds_byte(wr * 64 + fr, fq * 8), boff = lds_byte(wc * 32 + fr, fq * 8);
#define PG8_SA(b, h) (((b) * 2 + (h)) * HTB)
#define PG8_SB(b, h) ((4 + (b) * 2 + (h)) * HTB)
#define PG8_STGX(bufoff, gbase, v0, v1, AUX) do { \
        __builtin_amdgcn_raw_ptr_buffer_load_lds(rsrc, (PG8_LAS unsigned*)(lds + (bufoff) + ldsw), 16, (v0), (gbase), 0, (AUX)); \
        __builtin_amdgcn_raw_ptr_buffer_load_lds(rsrc, (PG8_LAS unsigned*)(lds + (bufoff) + ldsw + 8192), 16, (v1), (gbase), 0, (AUX)); } while (0)
#define PG8_STG(bufoff, gbase, v0, v1) PG8_STGX(bufoff, gbase, v0, v1, Sched::AUXA)
#define PG8_STGB(bufoff, gbase) PG8_STGX(bufoff, gbase, voffB[0], voffB[1], 0)
#define PG8_LDA(dst, b, h) do { _Pragma("unroll") for (int m = 0; m < 4; ++m) _Pragma("unroll") for (int k = 0; k < 2; ++k) dst[m][k] = *(const PG8_LAS bf16x8*)(lds + PG8_SA(b, h) + aoff + m * 2048 + k * 1024); } while (0)
#define PG8_LDB(dst, b, h) do { _Pragma("unroll") for (int n = 0; n < 2; ++n) _Pragma("unroll") for (int k = 0; k < 2; ++k) dst[n][k] = *(const PG8_LAS bf16x8*)(lds + PG8_SB(b, h) + boff + n * 2048 + k * 1024); } while (0)
#define PG8_MMA(ai, bj, At, Bt) do { __builtin_amdgcn_s_setprio(1); _Pragma("unroll") for (int m = 0; m < 4; ++m) _Pragma("unroll") for (int n = 0; n < 2; ++n) _Pragma("unroll") for (int k = 0; k < 2; ++k) \
        acc[ai][bj][m][n] = __builtin_amdgcn_mfma_f32_16x16x32_bf16(Bt[n][k], At[m][k], acc[ai][bj][m][n], 0, 0, 0); __builtin_amdgcn_s_setprio(0); } while (0)
#define PG8_WAIT_V(n) asm volatile("s_waitcnt vmcnt(" #n ")" ::: "memory")
#define PG8_WAIT_VN(n) asm volatile("s_waitcnt vmcnt(%0)" ::"n"(n) : "memory")
#define PG8_WAIT_L(n) asm volatile("s_waitcnt lgkmcnt(" #n ")" ::: "memory")
#define PG8_BAR __builtin_amdgcn_s_barrier()
#define PG8_SCHED __builtin_amdgcn_sched_barrier(0)
    Unit cur, nxt; int ui = 0;
    if (!S.next(0, cur)) return;
#ifndef PG8_SLK1
#define PG8_SLK1 0
#define PG8_SLK2 0
#endif
#ifndef PG8_FIRSTW
#define PG8_FIRSTW 8
#endif
#ifndef PG8_STAGGER
#define PG8_STAGGER 0
#endif
    if (PG8_STAGGER && nt == 4) {
        const unsigned long long t0 = __builtin_amdgcn_s_memrealtime(); const unsigned long long want = (unsigned long long)((blockIdx.x >> 3) & 3) * 340ull;
        while (__builtin_amdgcn_s_memrealtime() - t0 < want) __builtin_amdgcn_s_sleep(16);
    }
    f32x4 acc[2][2][4][2];
#pragma unroll
    for (int a = 0; a < 2; ++a)
#pragma unroll
        for (int b = 0; b < 2; ++b)
#pragma unroll
            for (int m = 0; m < 4; ++m)
#pragma unroll
                for (int n = 0; n < 2; ++n) acc[a][b][m][n] = (f32x4){0.f, 0.f, 0.f, 0.f};
    bf16x8 At[4][2], B0[2][2], B1[2][2];
    unsigned vAc[2][2], vAn[2][2];
    S.aoffs(cur, vAc);
    unsigned cA = cur.A, cB = cur.B;
    PG8_STGB(PG8_SB(0, 0), cB); PG8_STGB(PG8_SB(0, 1), cB + hstepB); PG8_STG(PG8_SA(0, 0), cA, vAc[0][0], vAc[0][1]); PG8_STG(PG8_SA(0, 1), cA, vAc[1][0], vAc[1][1]);
    if (wr == 1) PG8_BAR;
    PG8_WAIT_V(2); PG8_BAR;
    PG8_STGB(PG8_SB(1, 0), cB + kstep); PG8_STG(PG8_SA(1, 0), cA + kstep, vAc[0][0], vAc[0][1]); PG8_STGB(PG8_SB(1, 1), cB + hstepB + kstep);
    PG8_WAIT_V(0); PG8_BAR;
    for (;;) {
        const bool has_next = S.next(ui + 1, nxt);
        if constexpr (Sched::GATHER) {
            if (has_next) S.aoffs(nxt, vAn);
            else {
#pragma unroll
                for (int h = 0; h < 2; ++h)
#pragma unroll
                    for (int i = 0; i < 2; ++i) vAn[h][i] = vAc[h][i]; } }
        const unsigned nA = has_next ? nxt.A : cA, nB = has_next ? nxt.B : cB;
#define PG8_ITER(t, W1, W2, W3, W4) do { \
            const bool last = ((t) == nt - 2); \
            const unsigned a1 = cA + (unsigned)((t) + 1) * kstep; \
            const unsigned a2 = last ? nA : cA + (unsigned)((t) + 2) * kstep, b2 = last ? nB : cB + (unsigned)((t) + 2) * kstep; \
            const unsigned a3 = a2 + kstep, b3 = b2 + kstep; \
            unsigned w00 = vAc[0][0], w01 = vAc[0][1], w10 = vAc[1][0], w11 = vAc[1][1]; \
            if constexpr (Sched::GATHER) { w00 = last ? vAn[0][0] : w00; w01 = last ? vAn[0][1] : w01; w10 = last ? vAn[1][0] : w10; w11 = last ? vAn[1][1] : w11; } \
              \
            PG8_LDB(B0, 0, 0); PG8_LDB(B1, 0, 1); PG8_SCHED; PG8_LDA(At, 0, 0); PG8_STG(PG8_SA(1, 1), a1, vAc[1][0], vAc[1][1]); \
            PG8_WAIT_VN(W1); PG8_WAIT_L(0); PG8_BAR; PG8_MMA(0, 0, At, B0); PG8_MMA(0, 1, At, B1); PG8_BAR; PG8_SCHED; \
              \
            PG8_LDA(At, 0, 1); PG8_STGB(PG8_SB(0, 0), b2); PG8_STGB(PG8_SB(0, 1), b2 + hstepB); PG8_STG(PG8_SA(0, 0), a2, w00, w01); \
            PG8_WAIT_VN(W2); PG8_WAIT_L(0); PG8_BAR; PG8_MMA(1, 0, At, B0); PG8_MMA(1, 1, At, B1); PG8_BAR; PG8_SCHED; \
              \
            PG8_LDB(B0, 1, 0); PG8_LDB(B1, 1, 1); PG8_SCHED; PG8_LDA(At, 1, 0); PG8_STG(PG8_SA(0, 1), a2, w10, w11); \
            PG8_WAIT_VN(W3); PG8_WAIT_L(0); PG8_BAR; PG8_MMA(0, 0, At, B0); PG8_MMA(0, 1, At, B1); PG8_BAR; PG8_SCHED; \
              \
            PG8_LDA(At, 1, 1); PG8_STGB(PG8_SB(1, 0), b3); PG8_STGB(PG8_SB(1, 1), b3 + hstepB); PG8_STG(PG8_SA(1, 0), a3, w00, w01); \
            PG8_WAIT_VN(W4); PG8_WAIT_L(0); PG8_BAR; PG8_MMA(1, 0, At, B0); PG8_MMA(1, 1, At, B1); PG8_BAR; PG8_SCHED; } while (0)
        PG8_ITER(0, PG8_FIRSTW + 2 + Epi::NVM, PG8_FIRSTW + 6 + Epi::NVM, PG8_FIRSTW + 2 + Epi::NVM, PG8_FIRSTW + 6);
        for (int t = 2; t < nt; t += 2) PG8_ITER(t, 8 + PG8_SLK1, 8 + PG8_SLK2, 8 + PG8_SLK1, 8 + PG8_SLK2);
        if (wr == 0) PG8_BAR;
        { int t2 = threadIdx.x; asm volatile("" : "+v"(t2)); const int l2 = t2 & 63, w2 = __builtin_amdgcn_readfirstlane(t2 >> 6);
          E(acc, cur, w2 >> 2, w2 & 3, l2 & 15, l2 >> 4); }
        if (!has_next) break;
#pragma unroll
        for (int a = 0; a < 2; ++a)
#pragma unroll
            for (int b = 0; b < 2; ++b)
#pragma unroll
                for (int m = 0; m < 4; ++m)
#pragma unroll
                    for (int n = 0; n < 2; ++n) acc[a][b][m][n] = (f32x4){0.f, 0.f, 0.f, 0.f};
        cur = nxt; cA = nA; cB = nB; ++ui;
        if constexpr (Sched::GATHER) {
#pragma unroll
            for (int h = 0; h < 2; ++h)
#pragma unroll
                for (int i = 0; i < 2; ++i) vAc[h][i] = vAn[h][i]; }
        if (wr == 1) PG8_BAR;
    }
    PG8_WAIT_V(0);
    PG8_BAR;
#undef PG8_SA
#undef PG8_SB
#undef PG8_STG
#undef PG8_STGX
#undef PG8_STGB
#undef PG8_LDA
#undef PG8_LDB
#undef PG8_MMA
#undef PG8_WAIT_V
#undef PG8_WAIT_VN
#undef PG8_ITER
#undef PG8_WAIT_L
#undef PG8_BAR
#undef PG8_SCHED
}

struct DenseOrder {
    static constexpr bool GATHER = false; static constexpr int AUXA = 0;
    unsigned A, B; int lda, ldb, nM, nN, pn0, nwg, G, c, amul;
    __device__ __forceinline__ void init(size_t A_, int lda_, size_t B_, int ldb_, int nM_, int nN_, int pn0_, int G_, int c_) { A = (unsigned)A_; B = (unsigned)B_; lda = lda_; ldb = ldb_; nM = nM_; nN = nN_; pn0 = pn0_; nwg = nM * nN; G = G_; c = c_; amul = 1; }
    __device__ __forceinline__ bool next(int i, Unit& u) const {
        const long L = (long)i * G + c; if (L >= nwg) return false;
        int wgid = (int)L; { const int q = nwg / 8, r = nwg % 8, xcd = wgid % 8, off = wgid / 8; wgid = (xcd < r ? xcd * (q + 1) : r * (q + 1) + (xcd - r) * q) + off; }
        const int nig = 8 * nN, gid = wgid / nig, fm = gid * 8, gsz = (nM - fm) < 8 ? (nM - fm) : 8;
        u.pm = fm + ((wgid % nig) % gsz); u.pn = (wgid % nig) / gsz + pn0; u.aux = 0;
        u.A = A + (unsigned)(u.pm * amul) * 256u * lda * 2u; u.B = B + (unsigned)u.pn * 256u * ldb * 2u; return true;
    }
    __device__ __forceinline__ void aoffs(const Unit&, unsigned (&v)[2][2]) const {
        int tid = threadIdx.x; asm volatile("" : "+v"(tid));
#pragma unroll
        for (int i = 0; i < 2; ++i) { int R, C; stage_rc(tid * 16 + i * 8192, R, C);
#pragma unroll
            for (int h = 0; h < 2; ++h) v[h][i] = (unsigned)((h * 128 + R) * lda + C) * 2u; }
    }
};

struct EpiBf16 {
    static constexpr int NVM = 16;
    static constexpr bool WIDE = true;
    bf16_t* O; int ldc, coff; PG8_LAS unsigned char* stg0; const void* wsb;
    __device__ __forceinline__ void operator()(const f32x4 (&acc)[2][2][4][2], const Unit& u, int wr, int wc, int fr, int fq) const { const WsStore W_(wsb);
#ifndef EPI_DIRECT
#define EPI_DIRECT 0
#endif
        PG8_LAS unsigned char* stg = stg0 + (wr * 4 + wc) * 2048;
        const int lane = fr + 16 * fq, rr = lane >> 3, ch = lane & 7;
        const int row0 = u.pm * BM + wr * 64, col0 = coff + u.pn * BM + wc * 64 + ch * 8;
#pragma unroll
        for (int ai = 0; ai < 2; ++ai)
#pragma unroll
            for (int m = 0; m < 4; ++m) {
                if (EPI_DIRECT) {
#pragma unroll
                    for (int bj = 0; bj < 2; ++bj) W_.st(O + (size_t)(row0 + ai * HALF + m * 16 + fr) * ldc + coff + u.pn * BM + wc * 64 + bj * 32 + 8 * fq, pack8(acc[ai][bj][m][0], acc[ai][bj][m][1]));
                    continue; }
#pragma unroll
                for (int bj = 0; bj < 2; ++bj) *(PG8_LAS u32x4*)(stg + fr * 128 + (((bj * 4 + fq) ^ (fr & 7)) * 16)) = pack8(acc[ai][bj][m][0], acc[ai][bj][m][1]);
                asm volatile("s_waitcnt lgkmcnt(0)" ::: "memory");
                u32x4 w[2];
#pragma unroll
                for (int r = 0; r < 2; ++r) { const int row = 8 * r + rr; w[r] = *(const PG8_LAS u32x4*)(stg + row * 128 + ((ch ^ (row & 7)) * 16)); }
                asm volatile("s_waitcnt lgkmcnt(0)" ::: "memory");
#pragma unroll
                for (int r = 0; r < 2; ++r) W_.st(O + (size_t)(row0 + ai * HALF + m * 16 + 8 * r + rr) * ldc + col0, w[r]); }
    }
};
struct EpiFp8 {
    static constexpr bool WIDE = true; static constexpr int NVM = 8;
    unsigned char* O8; PG8_LAS unsigned char* stg0; const void* wsb;
    __device__ __forceinline__ void operator()(const f32x4 (&acc)[2][2][4][2], const Unit& u, int wr, int wc, int fr, int fq) const { const WsStore W_(wsb);
        typedef unsigned u32x2 __attribute__((ext_vector_type(2)));
        PG8_LAS unsigned char* stg = stg0 + (wr * 4 + wc) * 2048;
        const int lane = fr + 16 * fq, rr = lane >> 2, ch = lane & 3;
        const size_t row0 = (size_t)u.pm * BM + wr * 64; const int col0 = u.pn * BM + wc * 64 + ch * 16;
        float cl_hi = 432.f; asm volatile("" : "+v"(cl_hi));
#pragma unroll
        for (int ai = 0; ai < 2; ++ai)
#pragma unroll
            for (int m = 0; m < 4; ++m) {
#pragma unroll
                for (int bj = 0; bj < 2; ++bj) { u32x2 w; f32x4 v0 = acc[ai][bj][m][0], v1 = acc[ai][bj][m][1];
#pragma unroll
                    for (int j = 0; j < 4; ++j) { asm("v_med3_f32 %0, %1, %2, %3" : "=v"(v0[j]) : "v"(v0[j]), "s"(-432.f), "v"(cl_hi)); asm("v_med3_f32 %0, %1, %2, %3" : "=v"(v1[j]) : "v"(v1[j]), "s"(-432.f), "v"(cl_hi)); }
                    int p = 0; p = __builtin_amdgcn_cvt_pk_fp8_f32(v0[0], v0[1], p, false); p = __builtin_amdgcn_cvt_pk_fp8_f32(v0[2], v0[3], p, true); w.x = (unsigned)p;
                    p = 0; p = __builtin_amdgcn_cvt_pk_fp8_f32(v1[0], v1[1], p, false); p = __builtin_amdgcn_cvt_pk_fp8_f32(v1[2], v1[3], p, true); w.y = (unsigned)p;
                    *(PG8_LAS u32x2*)(stg + fr * 64 + (((bj * 4 + fq) ^ ((fr & 3) << 1)) * 8)) = w; }
                asm volatile("s_waitcnt lgkmcnt(0)" ::: "memory");
                const u32x4 w4 = *(const PG8_LAS u32x4*)(stg + rr * 64 + (((2 * ch) ^ ((rr & 3) << 1)) * 8));
                asm volatile("s_waitcnt lgkmcnt(0)" ::: "memory");
                if (FP8_ST_NT) W_.st_nt(O8 + (row0 + ai * HALF + m * 16 + rr) * 1024 + col0, w4); else W_.st(O8 + (row0 + ai * HALF + m * 16 + rr) * 1024 + col0, w4); }
    }
};
#ifdef UP_DRY
#define PG8_SWIGLU_NVM 0
#else
#define PG8_SWIGLU_NVM 8
#endif
__device__ __forceinline__ float sigm(float x) { return __builtin_amdgcn_rcpf(1.f + __builtin_amdgcn_exp2f(-1.4426950408889634f * x)); }
struct EpiSwiglu {
    static constexpr int NVM = PG8_SWIGLU_NVM;
    static constexpr bool WIDE = false;
    bf16_t* H; int ldh; const void* wsb; int dry = 0;
    __device__ __forceinline__ void operator()(const f32x4 (&acc)[2][2][4][2], const Unit& u, int wr, int wc, int fr, int fq) const { const WsStore W_(wsb);
        const int row0 = u.pm * BM + wr * 64 + fr, col0 = u.pn * HALF + wc * 32 + 8 * fq;
#pragma unroll
        for (int ai = 0; ai < 2; ++ai)
#pragma unroll
            for (int m = 0; m < 4; ++m) { f32x4 o[2];
#pragma unroll
                for (int n = 0; n < 2; ++n)
#pragma unroll
                    for (int j = 0; j < 4; ++j) { const float g = acc[ai][0][m][n][j]; o[n][j] = g * sigm(g) * acc[ai][1][m][n][j]; }
                const u32x4 w_ = pack8(o[0], o[1]); if (!dry || w_.x == 0x12345678u) { if (HID_ST_NT) W_.st_nt(H + (size_t)(row0 + ai * HALF + m * 16) * ldh + col0, w_); else W_.st(H + (size_t)(row0 + ai * HALF + m * 16) * ldh + col0, w_); } }
    }
};
struct EpiGlu {
    static constexpr int NVM = 8;
    static constexpr bool WIDE = false;
    bf16_t* AGLU; const void* wsb;
    __device__ __forceinline__ void operator()(const f32x4 (&acc)[2][2][4][2], const Unit& u, int wr, int wc, int fr, int fq) const { const WsStore W_(wsb);
        const int row0 = u.pm * BM + wr * 64 + fr, col0 = u.pn * HALF + wc * 32 + 8 * fq;
#pragma unroll
        for (int ai = 0; ai < 2; ++ai)
#pragma unroll
            for (int m = 0; m < 4; ++m) { f32x4 o[2];
#pragma unroll
                for (int n = 0; n < 2; ++n)
#pragma unroll
                    for (int j = 0; j < 4; ++j) o[n][j] = acc[ai][0][m][n][j] * sigm(acc[ai][1][m][n][j]);
                W_.st(AGLU + (size_t)(row0 + ai * HALF + m * 16) * 512 + col0, pack8(o[0], o[1])); }
    }
};
struct EpiFT {
    static constexpr int NVM = 8;
    static constexpr bool WIDE = false;
    bf16_t* FT; bf16_t* FTC;
    __device__ __forceinline__ void operator()(const f32x4 (&acc)[2][2][4][2], const Unit& u, int wr, int wc, int fr, int fq) const {
        const int rb = u.pm * BM; bf16_t* base; int L, l0;
        if (rb < TL) { base = FT + (size_t)(rb / SEQ) * 512 * SEQ; L = SEQ; l0 = rb % SEQ; } else { base = FTC + (size_t)((rb - TL) / CTXL) * 512 * CTXL; L = CTXL; l0 = 0; }
        const int ch0 = (u.pn - 4) * BM + wc * 32 + 8 * fq;
        bf16_t* lanep = base + (size_t)ch0 * L + l0 + wr * 64 + fr;
#pragma unroll
        for (int ai = 0; ai < 2; ++ai)
#pragma unroll
            for (int m = 0; m < 4; ++m)
#pragma unroll
                for (int bj = 0; bj < 2; ++bj)
#pragma unroll
                    for (int n = 0; n < 2; ++n) { const unsigned p0 = cvt_pk_bf16(acc[ai][bj][m][n][0], acc[ai][bj][m][n][1]), p1 = cvt_pk_bf16(acc[ai][bj][m][n][2], acc[ai][bj][m][n][3]);
                        PG8_GAS bf16_t* d = (PG8_GAS bf16_t*)(lanep + (size_t)(bj * HALF + 4 * n) * L + (ai * HALF + m * 16));
                        d[0] = (bf16_t)(p0 & 0xffffu); d[(size_t)L] = (bf16_t)(p0 >> 16); d[(size_t)2 * L] = (bf16_t)(p1 & 0xffffu); d[(size_t)3 * L] = (bf16_t)(p1 >> 16); }
    }
};
struct EpiGluFT {    static constexpr int NVM = 8;
    static constexpr bool WIDE = false;
    EpiGlu g; EpiFT f;
    __device__ __forceinline__ void operator()(const f32x4 (&acc)[2][2][4][2], const Unit& u, int wr, int wc, int fr, int fq) const { if (u.pn < 4) g(acc, u, wr, wc, fr, fq); else f(acc, u, wr, wc, fr, fq); }
};
template <int L> struct EpiDft {
    static constexpr int NVM = 16;
    static constexpr bool WIDE = false;
    bf16_t* FF; int tok0; const void* wsb; int pitch, cbase;
    __device__ __forceinline__ void operator()(const f32x4 (&acc)[2][2][4][2], const Unit& u, int wr, int wc, int fr, int fq) const { const WsStore W_(wsb);
        constexpr int H = L / 2;
        const size_t tokbase = (size_t)tok0 + (size_t)u.aux * L;
        const int c0 = wc * 32 + 8 * fq;
#pragma unroll
        for (int ai = 0; ai < 2; ++ai)
#pragma unroll
            for (int m = 0; m < 4; ++m) { const int r = u.pm * BM + ai * HALF + wr * 64 + m * 16 + fr; const int part = r > H ? 1 : 0, k = part ? r - H : r;
#pragma unroll
                for (int bj = 0; bj < 2; ++bj) { const int g = 2 * u.pn + bj; const f32x4 a0 = acc[ai][bj][m][0], a1 = acc[ai][bj][m][1];
                    const u32x4 pos = pack8(a0, a1);
                    bf16_t* d1 = FF + (tokbase + k) * pitch + cbase + g * 256 + part * 128 + c0; W_.st(d1, pos);
                    if (k != 0 && k != H) { bf16_t* d2 = FF + (tokbase + (L - k)) * pitch + cbase + g * 256 + part * 128 + c0; u32x4 w = pos; if (part) { w.x ^= 0x80008000u; w.y ^= 0x80008000u; w.z ^= 0x80008000u; w.w ^= 0x80008000u; } W_.st(d2, w); }
                    else if (!part) { bf16_t* d3 = FF + (tokbase + k) * pitch + cbase + g * 256 + 128 + c0; W_.st(d3, (u32x4){0u, 0u, 0u, 0u}); } } }
    }
};
template <bool W> struct EpiNull {
    static constexpr bool WIDE = W; static constexpr int NVM = 0;
    __device__ __forceinline__ void operator()(const f32x4 (&acc)[2][2][4][2], const Unit&, int, int, int, int) const {
#pragma unroll
        for (int a = 0; a < 2; ++a)
#pragma unroll
            for (int b = 0; b < 2; ++b)
#pragma unroll
                for (int m = 0; m < 4; ++m)
#pragma unroll
                    for (int n = 0; n < 2; ++n) asm volatile("" ::"v"(acc[a][b][m][n]));
    }
};
constexpr float QSCALE = 0.125f * 1.4426950408889634f;
struct EpiQkv {
    static constexpr int NVM = 16;
    static constexpr bool WIDE = true;
    bf16_t* Q; bf16_t* KA; bf16_t* VA; const unsigned* rt; int is_ctx; const void* wsb; PG8_LAS unsigned char* stg0; unsigned* kmaxp;
    __device__ __forceinline__ void operator()(const f32x4 (&acc)[2][2][4][2], const Unit& u, int wr, int wc, int fr, int fq) const { const WsStore W_(wsb);
        const int kind = u.pn >> 2, pt = u.pn & 3;
        const int rb = u.pm * BM;
        const int b = is_ctx ? rb / CTXL : rb / SEQ, s0 = is_ctx ? 0 : rb % SEQ;
        const size_t kvrow0 = (size_t)b * LKV + (is_ctx ? 0 : CTXL) + s0;
        const int lr0 = wr * 64 + fr;
        PG8_LAS unsigned char* stg = stg0 + (wr * 4 + wc) * 2048;
        const int lane = fr + 16 * fq, rr = lane >> 3, ch = lane & 7;
        bf16_t* dbase = (kind == 0 ? Q + (size_t)rb * 1024 : (kind == 1 ? KA : VA) + kvrow0 * 1024) + (size_t)(wr * 64 + rr) * 1024 + pt * BM + wc * 64 + ch * 8;
        const bool rot = kind != 2 && !is_ctx;
        const float sc = kind == 0 ? QSCALE : 1.f;
        float k2max = 0.f;
        u32x4 tb[2][4][2];
        if (rot) {
#pragma unroll
            for (int ai = 0; ai < 2; ++ai)
#pragma unroll
                for (int m = 0; m < 4; ++m) { const PG8_GAS u32x4* p = (const PG8_GAS u32x4*)(rt + (size_t)(s0 + lr0 + ai * HALF + m * 16) * 32 + 8 * fq); tb[ai][m][0] = p[0]; tb[ai][m][1] = p[1]; }
        }
#pragma unroll
        for (int ai = 0; ai < 2; ++ai)
#pragma unroll
            for (int m = 0; m < 4; ++m) {
                f32x4 o1[2], o2[2];
                if (rot) {
#pragma unroll
                    for (int n = 0; n < 2; ++n) { const f32x4 x1 = acc[ai][0][m][n], x2 = acc[ai][1][m][n]; f32x4 cv, sv;
#pragma unroll
                        for (int j = 0; j < 4; ++j) { const unsigned w = tb[ai][m][n][j]; cv[j] = __builtin_bit_cast(float, w << 16); sv[j] = __builtin_bit_cast(float, w & 0xffff0000u); }
                        o1[n] = (x1 * cv - x2 * sv) * sc; o2[n] = (x2 * cv + x1 * sv) * sc; }
                } else { o1[0] = acc[ai][0][m][0]; o1[1] = acc[ai][0][m][1]; o2[0] = acc[ai][1][m][0]; o2[1] = acc[ai][1][m][1]; }
                if (kind == 1) { float ss = 0.f;
#pragma unroll
                    for (int n = 0; n < 2; ++n)
#pragma unroll
                        for (int j = 0; j < 4; ++j) ss = __builtin_fmaf(o1[n][j], o1[n][j], __builtin_fmaf(o2[n][j], o2[n][j], ss));
                    ss += __shfl_xor(ss, 16); ss += __shfl_xor(ss, 32); k2max = __builtin_fmaxf(k2max, ss); }
                *(PG8_LAS u32x4*)(stg + fr * 128 + ((fq ^ (fr & 7)) * 16)) = pack8(o1[0], o1[1]);
                *(PG8_LAS u32x4*)(stg + fr * 128 + (((4 + fq) ^ (fr & 7)) * 16)) = pack8(o2[0], o2[1]);
                asm volatile("s_waitcnt lgkmcnt(0)" ::: "memory");
                u32x4 w[2];
#pragma unroll
                for (int r = 0; r < 2; ++r) { const int row = 8 * r + rr; w[r] = *(const PG8_LAS u32x4*)(stg + row * 128 + ((ch ^ (row & 7)) * 16)); }
                asm volatile("s_waitcnt lgkmcnt(0)" ::: "memory");
#pragma unroll
                for (int r = 0; r < 2; ++r) W_.st(dbase + (size_t)(ai * HALF + m * 16 + 8 * r) * 1024, w[r]); }
        if (kind == 1) {
#pragma unroll
            for (int off = 1; off < 16; off <<= 1) k2max = __builtin_fmaxf(k2max, __shfl_xor(k2max, off));
            if (lane == 0) __hip_atomic_fetch_max(kmaxp + (b * 8 + pt * 2 + (wc >> 1)) * 2 + (wc & 1), __builtin_bit_cast(unsigned, __builtin_sqrtf(k2max)), __ATOMIC_RELAXED, __HIP_MEMORY_SCOPE_AGENT); }
    }
};
}

namespace attn_body {
using bf16=__hip_bfloat16;
using bf16x8=__attribute__((ext_vector_type(8)))short;
using s16x4=__attribute__((ext_vector_type(4)))short;
using f32x16=__attribute__((ext_vector_type(16)))float;
using u32x4=__attribute__((ext_vector_type(4)))unsigned;
constexpr int D=64,DM=1024,DMO=2048;
constexpr int NW=8,QBLK=32,QB=QBLK*NW,KVBLK=64;
constexpr int ATTN_PITCH=DM, ATTN_UNIT_ROWS=QB;
__device__ __forceinline__ int crow(int r,int hi){return (r&3)+8*(r>>2)+4*hi;}
#define SBAR() __builtin_amdgcn_sched_barrier(0)

constexpr int NSLOT=3, SLOTB=8192;
constexpr int LDS_K=0, LDS_V=NSLOT*SLOTB, LDS_WS=LDS_V+NSLOT*2*SLOTB, LDS_OST=LDS_WS+NW*64*4, LDS_BYTES=LDS_OST+NW*4096;
constexpr float C2=0.125f*1.4426950408889634f;
__device__ __forceinline__ void glds16(const void*gsrc,unsigned lds_dst){unsigned keep;
  asm volatile("s_mov_b32 %0, m0\n\ts_mov_b32 m0, %2\n\ts_nop 0\n\tglobal_load_lds_dwordx4 %1, off\n\ts_mov_b32 m0, %0":"=&s"(keep):"v"(gsrc),"s"(lds_dst):"memory");}
__device__ __forceinline__ void glds16s(const void*sbase,unsigned voff,unsigned lds_dst){unsigned keep;
  asm volatile("s_mov_b32 %0, m0\n\ts_mov_b32 m0, %3\n\ts_nop 0\n\tglobal_load_lds_dwordx4 %1, %2\n\ts_mov_b32 m0, %0":"=&s"(keep):"v"(voff),"s"(sbase),"s"(lds_dst):"memory");}
__device__ __forceinline__ float max3f(float a,float b,float c){float r;asm("v_max3_f32 %0, %1, %2, %3":"=v"(r):"v"(a),"v"(b),"v"(c));return r;}
__device__ __forceinline__ float max2f(float a,float b){float r;asm("v_max_f32_e32 %0, %1, %2":"=v"(r):"v"(a),"v"(b));return r;}
__device__ __forceinline__ float fadd_s(float a,float b){float r;asm("v_add_f32_e32 %0, %1, %2":"=v"(r):"v"(a),"v"(b));return r;}
__device__ __forceinline__ float fsub_s(float a,float b){float r;asm("v_sub_f32_e32 %0, %1, %2":"=v"(r):"v"(a),"v"(b));return r;}
typedef float f32x2_t __attribute__((ext_vector_type(2))); typedef __bf16 bf16x2_t __attribute__((ext_vector_type(2)));
__device__ __forceinline__ unsigned cvtpk_s(float lo,float hi){f32x2_t v={lo,hi};bf16x2_t b=__builtin_convertvector(v,bf16x2_t);return __builtin_bit_cast(unsigned,b);}
#define WAIT_BAR(N) asm volatile("s_waitcnt vmcnt(" #N ") lgkmcnt(0)\n\ts_barrier":::"memory")

__device__ __forceinline__ void qkt(f32x16&p0,f32x16&p1,const char*Kslot,const bf16x8*qr,const f32x16&negm,int r32,int hi){
  const char*kb=Kslot+hi*1024+r32*16;
  #pragma unroll
  for(int d0=0;d0<4;++d0){
    const bf16x8 b0=*reinterpret_cast<const bf16x8*>(kb+d0*2048);
    const bf16x8 b1=*reinterpret_cast<const bf16x8*>(kb+d0*2048+512);
    if(d0==0){p0=__builtin_amdgcn_mfma_f32_32x32x16_bf16(b0,qr[0],negm,0,0,0);p1=__builtin_amdgcn_mfma_f32_32x32x16_bf16(b1,qr[0],negm,0,0,0);}
    else{p0=__builtin_amdgcn_mfma_f32_32x32x16_bf16(b0,qr[d0],p0,0,0,0);p1=__builtin_amdgcn_mfma_f32_32x32x16_bf16(b1,qr[d0],p1,0,0,0);}}
}
typedef __attribute__((address_space(3))) const char* lds_cptr;
typedef short v4i16_t __attribute__((ext_vector_type(4)));
__device__ __forceinline__ void kload8(bf16x8*kf,lds_cptr kp){
  kf[0]=*(const __attribute__((address_space(3))) bf16x8*)(kp);      kf[1]=*(const __attribute__((address_space(3))) bf16x8*)(kp+512);
  kf[2]=*(const __attribute__((address_space(3))) bf16x8*)(kp+2048); kf[3]=*(const __attribute__((address_space(3))) bf16x8*)(kp+2560);
  kf[4]=*(const __attribute__((address_space(3))) bf16x8*)(kp+4096); kf[5]=*(const __attribute__((address_space(3))) bf16x8*)(kp+4608);
  kf[6]=*(const __attribute__((address_space(3))) bf16x8*)(kp+6144); kf[7]=*(const __attribute__((address_space(3))) bf16x8*)(kp+6656);
}
__device__ __forceinline__ void kload2(bf16x8*kf,lds_cptr kp,int j){ kf[2*j]=*(const __attribute__((address_space(3))) bf16x8*)(kp+j*2048); kf[2*j+1]=*(const __attribute__((address_space(3))) bf16x8*)(kp+j*2048+512); }
__device__ __forceinline__ s16x4 vtr(lds_cptr p){ return __builtin_bit_cast(s16x4,__builtin_amdgcn_ds_read_tr16_b64_v4i16((__attribute__((address_space(3))) v4i16_t*)p)); }
__device__ __forceinline__ float rowmax(const f32x16&p0,const f32x16&p1){
  float a=max3f(p0[0],p0[1],p1[0]),b=max3f(p0[2],p0[3],p1[1]);a=max3f(a,p1[2],p1[3]);
  #pragma unroll
  for(int r=4;r<16;r+=4){a=max3f(a,p0[r],p0[r+1]);b=max3f(b,p0[r+2],p0[r+3]);a=max3f(a,p1[r],p1[r+1]);b=max3f(b,p1[r+2],p1[r+3]);}
  const float m=max2f(a,b);
  auto rr=__builtin_amdgcn_permlane32_swap(__float_as_uint(m),__float_as_uint(m),false,false);
  return max2f(__uint_as_float(rr[0]),__uint_as_float(rr[1]));
}
__device__ __forceinline__ void pv(f32x16*o,int vb,bf16x8 pa0,bf16x8 pa1,bf16x8 pa2,bf16x8 pa3){
  #pragma unroll
  for(int d0=0;d0<4;++d0){s16x4 lo[4],hi[4];
    #pragma unroll
    for(int ks=0;ks<4;++ks){
      asm volatile("ds_read_b64_tr_b16 %0,%1 offset:%c2":"=&v"(lo[ks]):"v"(vb),"i"(d0*4096+ks*1024):"memory");
      asm volatile("ds_read_b64_tr_b16 %0,%1 offset:%c2":"=&v"(hi[ks]):"v"(vb),"i"(d0*4096+ks*1024+512):"memory");}
    asm volatile("s_waitcnt lgkmcnt(0)":::"memory");SBAR();
    #define PK(k) (bf16x8){lo[k][0],lo[k][1],lo[k][2],lo[k][3],hi[k][0],hi[k][1],hi[k][2],hi[k][3]}
    o[d0]=__builtin_amdgcn_mfma_f32_32x32x16_bf16(pa0,PK(0),o[d0],0,0,0);
    o[d0]=__builtin_amdgcn_mfma_f32_32x32x16_bf16(pa1,PK(1),o[d0],0,0,0);
    o[d0]=__builtin_amdgcn_mfma_f32_32x32x16_bf16(pa2,PK(2),o[d0],0,0,0);
    o[d0]=__builtin_amdgcn_mfma_f32_32x32x16_bf16(pa3,PK(3),o[d0],0,0,0);
    #undef PK
  }
}

#ifndef ATTN_STORE16
#define ATTN_STORE16(p,v) (*(__attribute__((address_space(1))) u32x4*)(p)=(v))
#endif
template<int THRL> __device__ __forceinline__ void attn_unit(const bf16*Qu,const bf16*__restrict__ Kh,const bf16*__restrict__ Vh,bf16*Ou,const int NT,char*shm,const float kmax){
  const int tid=threadIdx.x,lane=tid&63,r32=lane&31,hi=lane>>5; const int wid=__builtin_amdgcn_readfirstlane(tid>>6);
  const bf16*Qw=Qu+(long)(wid*QBLK)*DM;
  const unsigned lds0=(unsigned)(uintptr_t)shm;
  float*wsf=(float*)(shm+LDS_WS)+wid*64;
  const unsigned kvo=(unsigned)((lane*DM+wid*8)*2);
  const unsigned vvo=(unsigned)(((16*(wid&3)+(lane>>2))*DM+(wid>>2)*32+(lane&3)*8)*2);
  const unsigned kdst=lds0+LDS_K+wid*1024, vdst=lds0+LDS_V+wid*1024;
  #define DMA_K(t,slot) glds16s(Kh+(long)(t)*KVBLK*DM,kvo,(unsigned)__builtin_amdgcn_readfirstlane(kdst+(slot)))
  #define DMA_V(t,slot) do{ glds16s(Vh+(long)(t)*KVBLK*DM,vvo,(unsigned)__builtin_amdgcn_readfirstlane(vdst+2*(slot))); glds16s(Vh+64+(long)(t)*KVBLK*DM,vvo,(unsigned)__builtin_amdgcn_readfirstlane(vdst+8192+2*(slot))); }while(0)
  const int vb0=(int)(lds0+LDS_V)+((lane>>4)&1)*32+(lane&3)*8+(4*hi+((lane&15)>>2))*64;
  const char*Kbase=shm+LDS_K; bf16x8 kf[8];
  const lds_cptr shm3=(lds_cptr)shm; const lds_cptr kp0=shm3+LDS_K+hi*1024+r32*16; const lds_cptr vp0=shm3+LDS_V+((lane>>4)&1)*32+(lane&3)*8+(4*hi+((lane&15)>>2))*64;
  DMA_K(0,0);DMA_V(0,0);DMA_K(1,SLOTB);
  bf16x8 qr[4];
  #pragma unroll
  for(int d0=0;d0<4;++d0)qr[d0]=*(const __attribute__((address_space(1))) bf16x8*)(&Qw[(long)r32*DM+d0*16+hi*8]);
  float l_reg=0.f;f32x16 o[4];o[0]=f32x16{};o[1]=f32x16{};o[2]=f32x16{};o[3]=f32x16{};f32x16 negm;
  #define CMASK(P0,P1,t) do{}while(0)
  #define START(P0,P1) do{ _Pragma("unroll") for(int r=0;r<16;++r)P0[r]=__builtin_amdgcn_exp2f(P0[r]); }while(0)
  #define RESC() do{}while(0)
  f32x16 pA0,pA1,pB0,pB1;
  int sl_prev=0,sl_cur=0,sl_next=SLOTB;
  #define ROT() do{sl_prev=sl_cur;sl_cur=sl_next;sl_next=(sl_next==(NSLOT-1)*SLOTB)?0:sl_next+SLOTB;}while(0)
  DMA_K(2,2*SLOTB);
  WAIT_BAR(4);
  { float q2=0.f;
    #pragma unroll
    for(int d0=0;d0<4;++d0){
      #pragma unroll
      for(int e=0;e<8;++e){ const float qv=__builtin_bit_cast(float,((unsigned)(unsigned short)qr[d0][e])<<16); q2=__builtin_fmaf(qv,qv,q2);} }
    auto rq=__builtin_amdgcn_permlane32_swap(__float_as_uint(q2),__float_as_uint(q2),false,false); q2=__uint_as_float(rq[0])+__uint_as_float(rq[1]);
    const float bound=__builtin_sqrtf(q2)*kmax*1.02f+1e-6f;
    #pragma unroll
    for(int r=0;r<16;++r)negm[r]=-bound; asm volatile("":"+v"(negm)); }
  qkt(pA0,pA1,Kbase,qr,negm,r32,hi);asm volatile("s_nop 15\n\ts_nop 7":"+v"(pA0),"+v"(pA1));CMASK(pA0,pA1,0);
  START(pA0,pA1);
  _Pragma("unroll") for(int r=0;r<16;++r)pA1[r]=__builtin_amdgcn_exp2f(pA1[r]);
  WAIT_BAR(0);
  DMA_K(3,0);DMA_V(1,SLOTB);
  ROT();
  kload8(kf,kp0+sl_cur);
  WAIT_BAR(3);
  s16x4 vlo[8],vhi[8]; u32x4 pw0,pw1,pw2,pw3;
  #define PKW(P,B) cvtpk_s(P[B],P[B+1])
  #define PAF(k) __builtin_bit_cast(bf16x8,pw##k)
  #define VFR(i) (bf16x8){vlo[i][0],vlo[i][1],vlo[i][2],vlo[i][3],vhi[i][0],vhi[i][1],vhi[i][2],vhi[i][3]}
  #define PIN(x) asm volatile("":"+v"(x))
  #define MX3(a,b,c) __builtin_fmaxf(__builtin_fmaxf((a),(b)),(c))
  #define GAPA(MF,A0,A1,A2,A3,W0,W1,PW) do{ MF; sa0=fadd_s(sa0,A0); sa1=fadd_s(sa1,A1); sa0=fadd_s(sa0,A2); sa1=fadd_s(sa1,A3); PIN(sa0); PIN(sa1); W0; W1; PIN(PW); SBAR(); }while(0)
  #define EX(v) __builtin_amdgcn_exp2f(v)
  #define GAPB(MF,RL,X,B) do{ MF; RL; X[B]=EX(X[B]); X[B+1]=EX(X[B+1]); PIN(X); SBAR(); }while(0)
  #define VRD(d,k) do{ vlo[(d)*2+((k)&1)]=vtr(vp_+((d)*4096+(k)*1024)); vhi[(d)*2+((k)&1)]=vtr(vp_+((d)*4096+(k)*1024+512)); }while(0)
  #define VS(d,k) VFR((d)*2+((k)&1))
  #define KRD(G,j) do{ if(G){ kload2(kf,kp0+sl_next,j); SBAR(); } }while(0)
  #define STEP(C0,C1,P0,P1,t,GK,GV,GL) do{ SBAR(); \
    const lds_cptr vp_=vp0+2*sl_prev; \
    VRD(0,0); SBAR(); float sa0=P0[0],sa1=P0[1]; \
    GAPA(C0=__builtin_amdgcn_mfma_f32_32x32x16_bf16(kf[0],qr[0],negm,0,0,0), P0[2],P0[3],P0[4],P0[5],     pw0[0]=PKW(P0,0), pw0[1]=PKW(P0,2), pw0); \
    VRD(1,0); SBAR(); GAPA(C1=__builtin_amdgcn_mfma_f32_32x32x16_bf16(kf[1],qr[0],negm,0,0,0), P0[6],P0[7],P0[8],P0[9],     pw0[2]=PKW(P0,4), pw0[3]=PKW(P0,6), pw0); \
    VRD(2,0); SBAR(); GAPA(C0=__builtin_amdgcn_mfma_f32_32x32x16_bf16(kf[2],qr[1],C0,0,0,0),   P0[10],P0[11],P0[12],P0[13], pw1[0]=PKW(P0,8), pw1[1]=PKW(P0,10), pw1); \
    VRD(3,0); SBAR(); GAPA(C1=__builtin_amdgcn_mfma_f32_32x32x16_bf16(kf[3],qr[1],C1,0,0,0),   P0[14],P0[15],P1[0],P1[1],   pw1[2]=PKW(P0,12),pw1[3]=PKW(P0,14), pw1); \
    VRD(0,1); SBAR(); GAPA(C0=__builtin_amdgcn_mfma_f32_32x32x16_bf16(kf[4],qr[2],C0,0,0,0),   P1[2],P1[3],P1[4],P1[5],     pw2[0]=PKW(P1,0), pw2[1]=PKW(P1,2), pw2); \
    VRD(1,1); SBAR(); GAPA(C1=__builtin_amdgcn_mfma_f32_32x32x16_bf16(kf[5],qr[2],C1,0,0,0),   P1[6],P1[7],P1[8],P1[9],     pw2[2]=PKW(P1,4), pw2[3]=PKW(P1,6), pw2); \
    VRD(2,1); SBAR(); GAPA(C0=__builtin_amdgcn_mfma_f32_32x32x16_bf16(kf[6],qr[3],C0,0,0,0),   P1[10],P1[11],P1[12],P1[13], pw3[0]=PKW(P1,8), pw3[1]=PKW(P1,10), pw3); \
    VRD(3,1); SBAR(); GAPA(C1=__builtin_amdgcn_mfma_f32_32x32x16_bf16(kf[7],qr[3],C1,0,0,0),   P1[14],P1[15],0.f,0.f,       pw3[2]=PKW(P1,12),pw3[3]=PKW(P1,14), pw3); \
    l_reg+=(sa0+sa1); \
    if(GK){DMA_K((t)+3,sl_cur);} if(GV){DMA_V((t)+1,sl_next);} \
    CMASK(C0,C1,t); \
    SBAR(); \
    GAPB(o[0]=__builtin_amdgcn_mfma_f32_32x32x16_bf16(PAF(0),VS(0,0),o[0],0,0,0), VRD(0,2), C0,0); \
    GAPB(o[1]=__builtin_amdgcn_mfma_f32_32x32x16_bf16(PAF(0),VS(1,0),o[1],0,0,0), VRD(1,2), C0,2); \
    GAPB(o[2]=__builtin_amdgcn_mfma_f32_32x32x16_bf16(PAF(0),VS(2,0),o[2],0,0,0), VRD(2,2), C0,4); \
    GAPB(o[3]=__builtin_amdgcn_mfma_f32_32x32x16_bf16(PAF(0),VS(3,0),o[3],0,0,0), VRD(3,2), C0,6); \
    KRD(GL,0); GAPB(o[0]=__builtin_amdgcn_mfma_f32_32x32x16_bf16(PAF(1),VS(0,1),o[0],0,0,0), VRD(0,3), C0,8); \
    GAPB(o[1]=__builtin_amdgcn_mfma_f32_32x32x16_bf16(PAF(1),VS(1,1),o[1],0,0,0), VRD(1,3), C0,10); \
    KRD(GL,1); GAPB(o[2]=__builtin_amdgcn_mfma_f32_32x32x16_bf16(PAF(1),VS(2,1),o[2],0,0,0), VRD(2,3), C0,12); \
    GAPB(o[3]=__builtin_amdgcn_mfma_f32_32x32x16_bf16(PAF(1),VS(3,1),o[3],0,0,0), VRD(3,3), C0,14); \
    KRD(GL,2); GAPB(o[0]=__builtin_amdgcn_mfma_f32_32x32x16_bf16(PAF(2),VS(0,2),o[0],0,0,0), , C1,0); \
    GAPB(o[1]=__builtin_amdgcn_mfma_f32_32x32x16_bf16(PAF(2),VS(1,2),o[1],0,0,0), , C1,2); \
    KRD(GL,3); GAPB(o[2]=__builtin_amdgcn_mfma_f32_32x32x16_bf16(PAF(2),VS(2,2),o[2],0,0,0), , C1,4); \
    GAPB(o[3]=__builtin_amdgcn_mfma_f32_32x32x16_bf16(PAF(2),VS(3,2),o[3],0,0,0), , C1,6); \
    GAPB(o[0]=__builtin_amdgcn_mfma_f32_32x32x16_bf16(PAF(3),VS(0,3),o[0],0,0,0), , C1,8); \
    GAPB(o[1]=__builtin_amdgcn_mfma_f32_32x32x16_bf16(PAF(3),VS(1,3),o[1],0,0,0), , C1,10); \
    GAPB(o[2]=__builtin_amdgcn_mfma_f32_32x32x16_bf16(PAF(3),VS(2,3),o[2],0,0,0), , C1,12); \
    GAPB(o[3]=__builtin_amdgcn_mfma_f32_32x32x16_bf16(PAF(3),VS(3,3),o[3],0,0,0), , C1,14); \
    }while(0)
  int t=1;
  for(;t+5<NT;t+=2){
    STEP(pB0,pB1,pA0,pA1,t,true,true,true);     WAIT_BAR(3); RESC(); ROT();
    STEP(pA0,pA1,pB0,pB1,t+1,true,true,true);   WAIT_BAR(3); RESC(); ROT();
  }
  #define ENDW(tt) do{ if((tt)+3<NT){WAIT_BAR(3);} else if((tt)+2<NT){WAIT_BAR(2);} else {WAIT_BAR(0);} }while(0)
  for(;t+1<NT;t+=2){
    STEP(pB0,pB1,pA0,pA1,t,(t+3<NT),(t+1<NT),(t+1<NT));       ENDW(t);   RESC(); ROT();
    STEP(pA0,pA1,pB0,pB1,t+1,(t+4<NT),(t+2<NT),(t+2<NT));     ENDW(t+1); RESC(); ROT();
  }
  STEP(pB0,pB1,pA0,pA1,NT-1,false,false,false); RESC();
  { float sacc=pB0[0]+pB0[1]; _Pragma("unroll") for(int r=2;r<16;++r)sacc+=pB0[r]; _Pragma("unroll") for(int r=0;r<16;++r)sacc+=pB1[r]; l_reg+=sacc;
    pw0=(u32x4){PKW(pB0,0),PKW(pB0,2),PKW(pB0,4),PKW(pB0,6)};pw1=(u32x4){PKW(pB0,8),PKW(pB0,10),PKW(pB0,12),PKW(pB0,14)};pw2=(u32x4){PKW(pB1,0),PKW(pB1,2),PKW(pB1,4),PKW(pB1,6)};pw3=(u32x4){PKW(pB1,8),PKW(pB1,10),PKW(pB1,12),PKW(pB1,14)};
    SBAR(); pv(o,vb0+2*sl_cur,PAF(0),PAF(1),PAF(2),PAF(3)); }
  #undef PKW
  #undef PAF
  #undef VFR
  #undef PIN
  #undef MX3
  #undef GAPA
  #undef GAPB
  #undef EX
  #undef VRD
  #undef VS
  #undef KRD
  #undef STEP
  #undef ENDW
  {auto rr=__builtin_amdgcn_permlane32_swap(__float_as_uint(l_reg),__float_as_uint(l_reg),false,false);l_reg=__uint_as_float(rr[0])+__uint_as_float(rr[1]);}
  if(hi==0)wsf[32+r32]=l_reg;asm volatile("s_waitcnt lgkmcnt(0)":::"memory");
  float rli[16];
  #pragma unroll
  for(int r=0;r<16;++r)rli[r]=__builtin_amdgcn_rcpf(__builtin_fmaxf(wsf[32+crow(r,hi)],1e-30f));
  bf16*Ow=Ou+(long)(wid*QBLK)*DMO;
  #pragma unroll
  for(int hf=0;hf<2;++hf){ bf16*stg=(bf16*)(shm+LDS_OST)+wid*2048;
    #pragma unroll
    for(int r=0;r<16;++r){const int orow=crow(r,hi);
      #pragma unroll
      for(int d0=0;d0<2;++d0)stg[orow*64+d0*32+r32]=__float2bfloat16(o[2*hf+d0][r]*rli[r]);}
    asm volatile("s_waitcnt lgkmcnt(0)":::"memory");
    #pragma unroll
    for(int i=0;i<4;++i){const int row=i*8+(lane>>3),ch=lane&7; const u32x4 v=*(const u32x4*)(stg+row*64+ch*8); ATTN_STORE16(Ow+(long)row*DMO+hf*64+ch*8,v);}
    asm volatile("s_waitcnt lgkmcnt(0)":::"memory"); }
  asm volatile("s_waitcnt lgkmcnt(0)\n\ts_barrier":::"memory");
  #undef DMA_K
  #undef DMA_V
  #undef CMASK
  #undef START
  #undef RESC
  #undef ROT
}
constexpr int ATTN_LDS_BYTES=LDS_BYTES;
#undef SBAR
#undef WAIT_BAR
}

constexpr int NWAVES = 8;
#ifndef DBG_LAST_PHASE
#define DBG_LAST_PHASE 99
#endif
constexpr int NMOE = 2 + 3 * NCH;
constexpr int PB0 = 5, PH_QKV = PB0 + NMOE, PH_ATT = PH_QKV + 1, PH_CMB = PH_QKV + 2, PH_OPR = PH_QKV + 3, PB1 = PH_QKV + 4, NPHASES = PB1 + NMOE;

#ifndef CVT0_LATE
#define CVT0_LATE 0
#endif
constexpr size_t MiB = 1u << 20;
constexpr size_t WS_CTL = 0, CTL_ZERO_BYTES = 1 * MiB;
constexpr size_t WS_MOD = 1 * MiB;
constexpr size_t WS_ROPE = 2 * MiB;
constexpr size_t WS_WIN = 3 * MiB;
constexpr size_t WS_W2 = 6 * MiB;
constexpr size_t WS_WQKV = 9 * MiB;
constexpr size_t WS_WDAO = 15 * MiB;
constexpr size_t WS_SHUP = 17 * MiB;
constexpr size_t WS_SHDN = 19 * MiB;
constexpr size_t WS_WRT = 20 * MiB;
constexpr size_t WS_TABC = 20 * MiB + 512 * 1024;
constexpr size_t WS_LIST = 21 * MiB;
constexpr size_t WS_TOKSLOT = 29 * MiB + 512 * 1024;
constexpr size_t WS_TOKGATE = 30 * MiB + 768 * 1024;
constexpr size_t WS_CTXRES = 32 * MiB;
constexpr size_t WS_WEDN = 40 * MiB;
constexpr size_t WS_WEUP = 72 * MiB;
constexpr size_t WS_HX = 136 * MiB;
constexpr size_t WS_HID = 204 * MiB;
constexpr size_t WS_YEXP = 332 * MiB;
constexpr size_t WS_END = 586 * MiB;
constexpr size_t WS_TAB = 204 * MiB;
constexpr size_t WS_AGLU = 236 * MiB;
constexpr size_t WS_FT = 272 * MiB;
constexpr size_t WS_FTC = 304 * MiB;
constexpr size_t WS_XA = 306 * MiB;
constexpr size_t WS_YPART = 410 * MiB;
constexpr size_t WS_Y = 442 * MiB;
constexpr size_t WS_TOKLO = 332 * MiB;
constexpr size_t WS_Q = 204 * MiB;
constexpr size_t WS_OC = 272 * MiB;
constexpr size_t WS_KALL = 400 * MiB;
constexpr size_t WS_VALL = 468 * MiB;
constexpr size_t WS_Y1 = 400 * MiB;
static_assert(WS_HID + (size_t)(7 * T0 + 64 * 255 * NCH) / NCH * 512 <= WS_YEXP && WS_YEXP + (size_t)(7 * T0 + 64 * 255 * NCH) / NCH * 1024 <= WS_END, "MoE buffers");
static_assert(WS_LIST + (size_t)NCH * 64 * CAP * 4 <= WS_TOKSLOT && WS_TOKSLOT + (size_t)T0 * 32 <= WS_TOKGATE && WS_TOKGATE + (size_t)T0 * 32 <= WS_CTXRES, "lists");
constexpr int CW_TMO = 0, CW_CODE = 1, CW_BAR = 4096, CW_CNT = 16384, CNT_STRIDE = 64, CW_KMAX = 65536;

constexpr int RING_OFF = 0, RING_BYTES = 131072;
constexpr int LDSCTL_OFF = RING_BYTES, MISC_OFF = LDSCTL_OFF + 320, INPTR_OFF = LDSCTL_OFF + 512, TBL_OFF = LDSCTL_OFF + 1024;
constexpr int STAGE_OFF = 139264;
constexpr int LDS_BYTES = 155648;

#define GAS __attribute__((address_space(1)))
#define LAS __attribute__((address_space(3)))
typedef unsigned short bf16;
typedef unsigned v4u __attribute__((ext_vector_type(4)));
typedef unsigned v2u __attribute__((ext_vector_type(2)));
typedef float f32x4 __attribute__((ext_vector_type(4)));
typedef short bf16x8 __attribute__((ext_vector_type(8)));
typedef GAS unsigned gu32;
#define RLX_AGENT __ATOMIC_RELAXED, __HIP_MEMORY_SCOPE_AGENT
#define LDS_WAIT() asm volatile("s_waitcnt lgkmcnt(0)" ::: "memory")
#define VM_WAIT() asm volatile("s_waitcnt vmcnt(0)" ::: "memory")
__device__ __forceinline__ unsigned f2bf(float f) { unsigned u = __builtin_bit_cast(unsigned, f); return (u + 0x7fffu + ((u >> 16) & 1u)) >> 16; }
__device__ __forceinline__ float bf2f(unsigned b) { return __builtin_bit_cast(float, b << 16); }
__device__ __forceinline__ unsigned pk2(float lo, float hi) { return f2bf(lo) | (f2bf(hi) << 16); }

#define XB_TMO      128
#define XB_XCNT(j)  (256  + 64 * (j))
#define XB_XSUB(j)  (1280 + 64 * (j))
#define XB_XGEN(j)  (2304 + 64 * (j))
#define XB_TOP      3328
#define XB_TOPGEN   3392
#define XCD_BAR_WORDS 3456
#define XB_SPIN_CAP (1u << 18)

__device__ __forceinline__ unsigned xb_ld(unsigned* p)              { return __hip_atomic_load(p, __ATOMIC_RELAXED, __HIP_MEMORY_SCOPE_AGENT); }
__device__ __forceinline__ unsigned xb_add(unsigned* p, unsigned v) { return __hip_atomic_fetch_add(p, v, __ATOMIC_RELAXED, __HIP_MEMORY_SCOPE_AGENT); }
__device__ __forceinline__ unsigned xb_xcc_id() { return (unsigned)__builtin_amdgcn_s_getreg((3 << 11) | 20) & 0xFu; }
#define XB_SPIN(cond, bar) do { unsigned _sp = 0; while (cond) { __builtin_amdgcn_s_sleep(1); \
    if ((++_sp & 255u) == 0u) { if (xb_ld(&(bar)[XB_TMO])) break; if (_sp > XB_SPIN_CAP) { atomicAdd(&(bar)[XB_TMO], 1u); break; } } } } while (0)

struct XcdBarrier {
    unsigned* bar; unsigned x;
    volatile LAS unsigned* st;
};

__device__ __forceinline__ XcdBarrier xcd_barrier_post(unsigned* bar, volatile LAS unsigned* st) {
    XcdBarrier b; b.bar = bar; b.x = xb_xcc_id(); b.st = st;
    if (threadIdx.x == 0) (void)xb_add(&bar[XB_XCNT(b.x)], 1u);
    return b;
}
__device__ __forceinline__ void xcd_barrier_complete(unsigned* bar, unsigned x, unsigned& nloc, unsigned& nx) {
    const unsigned G = gridDim.x * gridDim.y * gridDim.z;
    unsigned sum, cnt, mine, sp = 0u;
    for (;;) {
        sum = 0u; cnt = 0u; mine = 0u;
#pragma unroll
        for (unsigned j = 0; j < 16; ++j) { const unsigned c = xb_ld(&bar[XB_XCNT(j)]); sum += c; cnt += (c > 0u) ? 1u : 0u; mine = (j == x) ? c : mine; }
        if (sum == G) break;
        __builtin_amdgcn_s_sleep(1);
        if ((++sp & 255u) == 0u) { if (xb_ld(&bar[XB_TMO])) break; if (sp > XB_SPIN_CAP) { atomicAdd(&bar[XB_TMO], 1u); break; } }
    }
    nloc = mine > 0u ? mine : 1u; nx = cnt > 0u ? cnt : 1u;
}

__device__ __forceinline__ void xcd_barrier(const XcdBarrier& b) {
    asm volatile("s_waitcnt vmcnt(0)" ::: "memory");
    __syncthreads();
    if (threadIdx.x == 0) {
        unsigned* bar = b.bar;
        __builtin_amdgcn_s_waitcnt(0);
        unsigned nloc = b.st[0], nx = b.st[1];
        if (nloc == 0u) { xcd_barrier_complete(bar, b.x, nloc, nx); b.st[0] = nloc; b.st[1] = nx; }
        const unsigned old = xb_add(&bar[XB_XSUB(b.x)], 1u);
        const unsigned gen = old / nloc;
        if (old + 1u == (gen + 1u) * nloc) {
            __builtin_amdgcn_fence(__ATOMIC_RELEASE, "agent");
            asm volatile("s_waitcnt vmcnt(0)" ::: "memory");
            const unsigned og = xb_add(&bar[XB_TOP], 1u);
            const unsigned tg = og / nx;
            if (og + 1u == (tg + 1u) * nx) xb_add(&bar[XB_TOPGEN], 1u);
            else XB_SPIN(xb_ld(&bar[XB_TOPGEN]) == tg, bar);
            __builtin_amdgcn_fence(__ATOMIC_ACQUIRE, "agent");
            xb_add(&bar[XB_XGEN(b.x)], 1u);
            asm volatile("s_waitcnt vmcnt(0)" ::: "memory");
        } else {
            XB_SPIN(xb_ld(&bar[XB_XGEN(b.x)]) == gen, bar);
            __builtin_amdgcn_fence(__ATOMIC_ACQUIRE, "agent");
            asm volatile("s_waitcnt vmcnt(0)" ::: "memory");
        }
    }
    __syncthreads();
}

struct Frame {
    LAS unsigned char* lds;
    volatile LAS unsigned* MISC;
    gu32* ctl;
    unsigned char* ws;
    int tid, lane, wave, vcu, G;
    float* out;
};
template <class T> __device__ __forceinline__ T* wsp(const Frame& F, size_t off) { return (T*)(F.ws + off); }
enum { I_X = 0, I_C, I_CTX, I_CCTX, I_ADAW, I_ADAB, I_NORMG, I_WIN, I_CONVW, I_CONVB, I_LNG, I_LNB, I_WOUT, I_WQKV, I_LAMBDA, I_SUBLNG, I_DAWOUT, I_RTW, I_RTB, I_WGATE, I_WUP, I_WDOWN, I_SHG, I_SHU, I_SHD };
__device__ __forceinline__ const float* inp(const Frame& F, int i) { const LAS unsigned* t = (const LAS unsigned*)(F.lds + INPTR_OFF) + 2 * i;
    const unsigned lo = __builtin_amdgcn_readfirstlane(t[0]), hi = __builtin_amdgcn_readfirstlane(t[1]); return (const float*)(const GAS float*)(((unsigned long long)hi << 32) | lo); }
#ifndef DBG_JITTER
#define DBG_JITTER 0
#endif
#define FENCE(F) do { if (DBG_JITTER && ((blockIdx.x * 5 + 3) % 7 < 2)) { const unsigned long long t0_ = __builtin_amdgcn_s_memrealtime(); while (__builtin_amdgcn_s_memrealtime() - t0_ < (unsigned long long)(DBG_JITTER * 100 * (1 + blockIdx.x % 3))) __builtin_amdgcn_s_sleep(8); } int t_ = threadIdx.x; asm volatile("" : "+v"(t_)); F.tid = t_; F.lane = t_ & 63; F.wave = __builtin_amdgcn_readfirstlane(t_ >> 6); asm volatile("" : "+s"(F.ws), "+s"(F.out), "+s"(F.ctl) :: "memory"); F.ws = (unsigned char*)(GAS unsigned char*)F.ws; F.out = (float*)(GAS float*)F.out; } while (0)

__device__ __forceinline__ float wave_sum(float v) {
#pragma unroll
    for (int o = 1; o < 64; o <<= 1) v += __shfl_xor(v, o);
    return v;
}
#ifndef NT_STREAMS
#define NT_STREAMS 1
#endif
#define NTLD(P) (NT_STREAMS ? __builtin_nontemporal_load(P) : *(P))
__device__ __forceinline__ void ldrow_f32(const float* p, int lane, f32x4 (&v)[4]) { const GAS f32x4* q = (const GAS f32x4*)p + lane;
#pragma unroll
    for (int j = 0; j < 4; ++j) v[j] = q[64 * j]; }
__device__ __forceinline__ void ldrow_bf16(const bf16* p, int lane, f32x4 (&v)[4]) { const GAS v2u* q = (const GAS v2u*)p + lane;
#pragma unroll
    for (int j = 0; j < 4; ++j) { const v2u w = q[64 * j]; v[j] = (f32x4){bf2f(w.x & 0xffffu), bf2f(w.x >> 16), bf2f(w.y & 0xffffu), bf2f(w.y >> 16)}; } }
__device__ __forceinline__ void ldrow_fp8(const unsigned char* p, int lane, f32x4 (&v)[4]) { typedef float f32x2 __attribute__((ext_vector_type(2))); const GAS unsigned* q = (const GAS unsigned*)p + lane;
#pragma unroll
    for (int j = 0; j < 4; ++j) { const int w = (int)NTLD(q + 64 * j); const f32x2 a = __builtin_amdgcn_cvt_pk_f32_fp8(w, false), b = __builtin_amdgcn_cvt_pk_f32_fp8(w, true); v[j] = (f32x4){a.x, a.y, b.x, b.y} * 0.0625f; } }
__device__ __forceinline__ void ldrow_f32_nt(const float* p, int lane, f32x4 (&v)[4]) { const GAS f32x4* q = (const GAS f32x4*)p + lane;
#pragma unroll
    for (int j = 0; j < 4; ++j) v[j] = NTLD(q + 64 * j); }
__device__ __forceinline__ void ldrow_bf16_nt(const bf16* p, int lane, f32x4 (&v)[4]) { const GAS v2u* q = (const GAS v2u*)p + lane;
#pragma unroll
    for (int j = 0; j < 4; ++j) { const v2u w = NTLD(q + 64 * j); v[j] = (f32x4){bf2f(w.x & 0xffffu), bf2f(w.x >> 16), bf2f(w.y & 0xffffu), bf2f(w.y >> 16)}; } }
__device__ __forceinline__ void strow_f32_nt(float* p, int lane, const f32x4 (&v)[4]) { GAS f32x4* q = (GAS f32x4*)p + lane;
#pragma unroll
    for (int j = 0; j < 4; ++j) { if (NT_STREAMS) __builtin_nontemporal_store(v[j], q + 64 * j); else q[64 * j] = v[j]; } }
__device__ __forceinline__ void strow_f32(float* p, int lane, const f32x4 (&v)[4]) { GAS f32x4* q = (GAS f32x4*)p + lane;
#pragma unroll
    for (int j = 0; j < 4; ++j) q[64 * j] = v[j]; }
#ifndef ROW_WT
#define ROW_WT 1
#endif
__device__ __forceinline__ void strow_pk_wt(const Frame& F, const bf16* row, int lane, const v2u (&w)[4]) {
    const bool odd = lane & 1;
    const v2u s0 = odd ? w[0] : w[1], s1 = odd ? w[2] : w[3];
    v2u r0, r1; r0.x = __shfl_xor(s0.x, 1); r0.y = __shfl_xor(s0.y, 1); r1.x = __shfl_xor(s1.x, 1); r1.y = __shfl_xor(s1.y, 1);
    const v4u a = odd ? (v4u){r0.x, r0.y, w[1].x, w[1].y} : (v4u){w[0].x, w[0].y, r0.x, r0.y};
    const v4u b = odd ? (v4u){r1.x, r1.y, w[3].x, w[3].y} : (v4u){w[2].x, w[2].y, r1.x, r1.y};
    const __amdgpu_buffer_rsrc_t rs = __builtin_amdgcn_make_buffer_rsrc((void*)F.ws, 0, 0x7fffffff, 0x00020000);
    const unsigned off = (unsigned)((const unsigned char*)row - (const unsigned char*)F.ws) + 8u * (unsigned)(lane & ~1) + (odd ? 512u : 0u);
    __builtin_amdgcn_raw_buffer_store_b128(a, rs, off, 0, 16); __builtin_amdgcn_raw_buffer_store_b128(b, rs, off + 1024u, 0, 16);
}
__device__ __forceinline__ void strow_bf16_wt(const Frame& F, bf16* p, int lane, const f32x4 (&v)[4]) {
    if (!ROW_WT) { GAS v2u* q = (GAS v2u*)p + lane;
#pragma unroll
        for (int j = 0; j < 4; ++j) q[64 * j] = (v2u){pk2(v[j][0], v[j][1]), pk2(v[j][2], v[j][3])};
        return; }
    v2u w[4];
#pragma unroll
    for (int j = 0; j < 4; ++j) w[j] = (v2u){pk2(v[j][0], v[j][1]), pk2(v[j][2], v[j][3])};
    strow_pk_wt(F, p, lane, w);
}
__device__ __forceinline__ void strow_bf16(bf16* p, int lane, const f32x4 (&v)[4]) { GAS v2u* q = (GAS v2u*)p + lane;
#pragma unroll
    for (int j = 0; j < 4; ++j) q[64 * j] = (v2u){pk2(v[j].x, v[j].y), pk2(v[j].z, v[j].w)}; }
__device__ __forceinline__ float rstd_of(const f32x4 (&v)[4]) { float s = 0.f;
#pragma unroll
    for (int j = 0; j < 4; ++j) s += (v[j].x * v[j].x + v[j].y * v[j].y) + (v[j].z * v[j].z + v[j].w * v[j].w);
    return rsqrtf(wave_sum(s) * (1.f / DM) + EPSN); }
__device__ __forceinline__ void modnorm(const f32x4 (&v)[4], float rstd, const float* g, const float* shift, const float* scale, int lane, f32x4 (&o)[4]) {
    f32x4 gg[4], sh[4], sc[4]; ldrow_f32(g, lane, gg); ldrow_f32(shift, lane, sh); ldrow_f32(scale, lane, sc);
#pragma unroll
    for (int j = 0; j < 4; ++j) o[j] = v[j] * rstd * gg[j] * (sc[j] + 1.f) + sh[j]; }
__device__ __forceinline__ const float* modp(const Frame& F, int layer, int rb, int j) { return wsp<const float>(F, WS_MOD) + ((size_t)(layer * 9 + rb) * 6 + j) * 1024; }
__device__ __forceinline__ int rowbatch(int row) { return row < TL ? row / SEQ : 8; }

__device__ __forceinline__ int maprow(int mode, int n) {
    if (mode == 1) { if (n < 512) return 256 * (n >> 7) + (n & 127); if (n < 1024) { const int q = n - 512; return 256 * (q >> 7) + 128 + (q & 127); } return n; }
    if (mode == 2) { if (n < 2048) { const int blk = n >> 10, q = n & 1023, h = q >> 7, comp = (q >> 6) & 1, d = q & 63, bj = d >> 5, dd = d & 31, g = (h & 1) * 2 + comp; return blk * 1024 + 256 * (h >> 1) + 128 * bj + 32 * g + dd; } return n; }
    if (mode == 3) return 256 * (n >> 7) + (n & 127);
    if (mode == 4) return 256 * (n >> 7) + 128 + (n & 127);
    return n;
}
__device__ __forceinline__ void p0_transpose_item(const float* W, int K, int N, bf16* WT, int mode, LAS float* scr, int item, int lane, const float scale = 1.f) {
    (void)scr;
    const int nblk = N / 32, kb = item / nblk, nb = item % nblk, a = lane & 7, q = lane >> 3, k0 = 64 * kb + 8 * q, n0 = 32 * nb + 4 * a;
    const GAS f32x4* src = (const GAS f32x4*)(W + (size_t)k0 * N + n0);
    f32x4 r[8];
#pragma unroll
    for (int i = 0; i < 8; ++i) r[i] = NTLD(src + (size_t)i * (N / 4));
#pragma unroll
    for (int j = 0; j < 4; ++j) { v4u o; o.x = pk2(r[0][j] * scale, r[1][j] * scale); o.y = pk2(r[2][j] * scale, r[3][j] * scale); o.z = pk2(r[4][j] * scale, r[5][j] * scale); o.w = pk2(r[6][j] * scale, r[7][j] * scale);
        if (NT_STREAMS) __builtin_nontemporal_store(o, (GAS v4u*)(WT + (size_t)maprow(mode, n0 + j) * K + k0)); else *(GAS v4u*)(WT + (size_t)maprow(mode, n0 + j) * K + k0) = o; }
}
__device__ __forceinline__ void p0_router_item(const float* W, bf16* HI, bf16* LO, LAS float* scr, int item, int lane) {
    const int kb = item >> 1, nb = item & 1, k0 = 64 * kb, n0 = 32 * nb;
#pragma unroll 8
    for (int i = 0; i < 32; ++i) { const int kk = 2 * i + (lane >> 5); scr[kk * 33 + (lane & 31)] = ((const GAS float*)W)[(size_t)(k0 + kk) * 64 + n0 + (lane & 31)]; }
    LDS_WAIT(); asm volatile("" ::: "memory");
    const int c = lane & 7;
#pragma unroll
    for (int j = 0; j < 4; ++j) { const int n = (lane >> 3) + 8 * j; const LAS float* s = scr + (8 * c) * 33 + n;
        unsigned h[8], l[8];
#pragma unroll
        for (int q = 0; q < 8; ++q) { const float w = s[q * 33]; h[q] = f2bf(w); l[q] = f2bf(w - bf2f(h[q])); }
        v4u oh, ol; oh.x = h[0] | (h[1] << 16); oh.y = h[2] | (h[3] << 16); oh.z = h[4] | (h[5] << 16); oh.w = h[6] | (h[7] << 16);
        ol.x = l[0] | (l[1] << 16); ol.y = l[2] | (l[3] << 16); ol.z = l[4] | (l[5] << 16); ol.w = l[6] | (l[7] << 16);
        *(GAS v4u*)(HI + (size_t)(n0 + n) * 1024 + k0 + 8 * c) = oh; *(GAS v4u*)(LO + (size_t)(n0 + n) * 1024 + k0 + 8 * c) = ol; }
    LDS_WAIT(); asm volatile("" ::: "memory");
}
__device__ __forceinline__ void convert_experts(Frame& F, int layer, int it0 = 0, int it1 = 64 * 384, int cu0 = 0, int ncu = 0) {
    LAS float* scr = (LAS float*)(F.lds + RING_OFF + F.wave * 16384);
    const int gw = (ncu ? (int)blockIdx.x - cu0 : F.vcu) * NWAVES + F.wave, NGW = (ncu ? ncu : F.G) * NWAVES;
    bf16* UP = wsp<bf16>(F, WS_WEUP); bf16* DN = wsp<bf16>(F, WS_WEDN);
    for (int it = it0 + gw; it < it1; it += NGW) {
        const int e = it / 384, r = it % 384; const size_t eo = (size_t)(layer * 64 + e) * 1024 * 256;
        if (r < 128) p0_transpose_item(inp(F, I_WGATE) + eo, 1024, 256, UP + (size_t)e * 512 * 1024, 3, scr, r, F.lane);
        else if (r < 256) p0_transpose_item(inp(F, I_WUP) + eo, 1024, 256, UP + (size_t)e * 512 * 1024, 4, scr, r - 128, F.lane);
        else p0_transpose_item(inp(F, I_WDOWN) + eo, 256, 1024, DN + (size_t)e * 1024 * 256, 0, scr, r - 256, F.lane, 16.f);
    }
}
__device__ __forceinline__ float silu(float v) { return v / (1.f + __expf(-v)); }

__device__ __forceinline__ void p0_prologue(Frame& F) {
    __syncthreads();
#ifndef P0_PARTS
#define P0_PARTS 15
#endif
    if (P0_PARTS & 1)
    {
        LAS float* sc = (LAS float*)(F.lds);
        LAS float* part = (LAS float*)(F.lds + 40960);
        for (int i = F.tid; i < 9 * 1024; i += 512) { const int r = i >> 10, k = i & 1023; sc[i] = silu(r < 8 ? inp(F, I_C)[r * 1024 + k] : inp(F, I_CCTX)[k]); }
        __syncthreads();
        for (int item = F.vcu; item < 192; item += F.G) {
            const int layer = item / 96, col = (item % 96) * 64 + F.lane;
            const float* W = inp(F, I_ADAW) + (size_t)layer * 1024 * 6144 + col;
            float a[9];
#pragma unroll
            for (int r = 0; r < 9; ++r) a[r] = 0.f;
#pragma unroll 8
            for (int kk = 0; kk < 128; ++kk) { const int k = F.wave * 128 + kk; const float w = NTLD((const GAS float*)(W + (size_t)k * 6144));
#pragma unroll
                for (int r = 0; r < 9; ++r) a[r] += sc[r * 1024 + k] * w; }
#pragma unroll
            for (int r = 0; r < 9; ++r) part[(F.wave * 9 + r) * 64 + F.lane] = a[r];
            __syncthreads();
            for (int i = F.tid; i < 576; i += 512) { const int r = i >> 6, l = i & 63; float s = 0.f;
#pragma unroll
                for (int w = 0; w < 8; ++w) s += part[(w * 9 + r) * 64 + l];
                const int cc = (item % 96) * 64 + l;
                wsp<float>(F, WS_MOD)[(size_t)(layer * 9 + r) * 6144 + cc] = s + inp(F, I_ADAB)[layer * 6144 + cc]; }
            __syncthreads();
        }
        __syncthreads();
    }
    LAS float* scr = (LAS float*)(F.lds + RING_OFF + F.wave * 16384);
    const int gw = F.vcu * NWAVES + F.wave, NGW = F.G * NWAVES;
    constexpr int NI_IN = 16 * 48, NI_OUT = 8 * 32, NI_QKV = 16 * 96, NI_DAO = 16 * 32, NI_SHG = 16 * 8, NI_SHD = 4 * 32, NI_RT = 32;
    constexpr int NI_TAB = 4096, NI_TABC = 256, NI_BD = 2048, NI_ROPE = 2048;
    constexpr int NITEMS = NI_IN + NI_OUT + NI_QKV + NI_DAO + 4 * NI_SHG + 2 * NI_SHD + 2 * NI_RT + NI_TAB + NI_TABC + NI_BD + NI_ROPE;
#ifndef P0_IT_LO
#define P0_IT_LO 0
#define P0_IT_HI 1000000
#endif
    if (P0_PARTS & 2)
    for (int it = gw; it < NITEMS; it += NGW) {
        int r = it; if (it < P0_IT_LO || it >= P0_IT_HI) continue;
        if (r < NI_IN) { p0_transpose_item(inp(F, I_WIN), 1024, 1536, wsp<bf16>(F, WS_WIN), 1, scr, r, F.lane); continue; } r -= NI_IN;
        if (r < NI_OUT) { p0_transpose_item(inp(F, I_WOUT), 1536, 1024, wsp<bf16>(F, WS_W2), 0, scr, r, F.lane); continue; } r -= NI_OUT;
        if (r < NI_QKV) { p0_transpose_item(inp(F, I_WQKV), 1024, 3072, wsp<bf16>(F, WS_WQKV), 0, scr, r, F.lane); continue; } r -= NI_QKV;
        if (r < NI_DAO) { p0_transpose_item(inp(F, I_DAWOUT), 1024, 1024, wsp<bf16>(F, WS_WDAO), 0, scr, r, F.lane); continue; } r -= NI_DAO;
        if (r < 4 * NI_SHG) { const int l = r / (2 * NI_SHG), q = r % (2 * NI_SHG);
            if (q < NI_SHG) p0_transpose_item(inp(F, I_SHG) + (size_t)l * 1024 * 256, 1024, 256, wsp<bf16>(F, WS_SHUP) + (size_t)l * 512 * 1024, 3, scr, q, F.lane);
            else p0_transpose_item(inp(F, I_SHU) + (size_t)l * 1024 * 256, 1024, 256, wsp<bf16>(F, WS_SHUP) + (size_t)l * 512 * 1024, 4, scr, q - NI_SHG, F.lane);
            continue; } r -= 4 * NI_SHG;
        if (r < 2 * NI_SHD) { const int l = r / NI_SHD; p0_transpose_item(inp(F, I_SHD) + (size_t)l * 256 * 1024, 256, 1024, wsp<bf16>(F, WS_SHDN) + (size_t)l * 1024 * 256, 0, scr, r % NI_SHD, F.lane, 16.f); continue; } r -= 2 * NI_SHD;
        if (r < 2 * NI_RT) { const int l = r / NI_RT; bf16* base = wsp<bf16>(F, WS_WRT) + (size_t)l * 2 * 64 * 1024; p0_router_item(inp(F, I_RTW) + (size_t)l * 1024 * 64, base, base + 64 * 1024, scr, r % NI_RT, F.lane); continue; } r -= 2 * NI_RT;
        if (r < NI_TAB) {
            const int kk = r <= 2048 ? r : r - 2048; bf16* row = wsp<bf16>(F, WS_TAB) + (size_t)r * 4096;
            for (int q = 0; q < 8; ++q) { const int l0 = q * 512 + F.lane * 8; unsigned h[8];
#pragma unroll
                for (int i = 0; i < 8; ++i) { const int idx = (kk * (l0 + i)) & 4095; float s, c; sincospif((float)idx * (1.f / 2048.f), &s, &c); h[i] = f2bf((r <= 2048 ? c : -s) * (1.f / 64.f)); }
                *(GAS v4u*)(row + l0) = (v4u){h[0] | (h[1] << 16), h[2] | (h[3] << 16), h[4] | (h[5] << 16), h[6] | (h[7] << 16)}; }
            continue; } r -= NI_TAB;
        if (r < NI_TABC) { const int kk = r <= 128 ? r : r - 128; bf16* row = wsp<bf16>(F, WS_TABC) + (size_t)r * 256; const int l0 = F.lane * 4; unsigned h[4];
#pragma unroll
            for (int i = 0; i < 4; ++i) { const int idx = (kk * (l0 + i)) & 255; float s, c; sincospif((float)idx * (1.f / 128.f), &s, &c); h[i] = f2bf((r <= 128 ? c : -s) * (1.f / 16.f)); }
            *(GAS v2u*)(row + l0) = (v2u){h[0] | (h[1] << 16), h[2] | (h[3] << 16)};
            continue; } r -= NI_TABC;
        if (r < NI_BD) {
            const int nb = r & 15, cb = (r >> 4) & 15, part = (r >> 8) & 1, g = r >> 9; const int n = nb * 64 + F.lane, c0 = cb * 8;
            const GAS float* wsrc = (const GAS float*)inp(F, I_WOUT) + (size_t)(512 + 128 * g) * 1024 + n;
            { float s0, c0_, s1, c1_; sincospif((float)F.lane * (1.f / 64.f), &s0, &c0_); sincospif((float)(F.lane + 64) * (1.f / 64.f), &s1, &c1_);
              scr[F.lane] = part ? s0 : c0_; scr[F.lane + 64] = part ? s1 : c1_; LDS_WAIT(); asm volatile("" ::: "memory"); }
            float acc8[8];
#pragma unroll
            for (int j = 0; j < 8; ++j) acc8[j] = 0.f;
#pragma unroll 2
            for (int m = 0; m < 128; ++m) { const float wv = wsrc[(size_t)m * 1024];
#pragma unroll
                for (int j = 0; j < 8; ++j) acc8[j] += scr[(m * (c0 + j)) & 127] * wv; }
            LDS_WAIT(); asm volatile("" ::: "memory");
            unsigned h[8];
#pragma unroll
            for (int j = 0; j < 8; ++j) h[j] = f2bf(acc8[j] * 0.08838834764831845f);
            *(GAS v4u*)(wsp<bf16>(F, WS_W2) + (size_t)n * 1536 + 512 + 256 * g + 128 * part + c0) = (v4u){h[0] | (h[1] << 16), h[2] | (h[3] << 16), h[4] | (h[5] << 16), h[6] | (h[7] << 16)};
            continue; } r -= NI_BD;
        { const int s = r * 2 + (F.lane >> 5), dd = F.lane & 31, i = dd & 15; const float inv = powf(10000.f, -(float)i * (1.f / 16.f)); const float pos = (float)(dd < 16 ? s / 64 : s % 64); const float ang = pos * inv;
          wsp<unsigned>(F, WS_ROPE)[s * 32 + dd] = f2bf(cosf(ang)) | (f2bf(sinf(ang)) << 16); }
    }
    if (P0_PARTS & 4) convert_experts(F, 0, (CVT0_LATE > 0 && F.G == 256) ? CVT0_LATE : 0);
#if DBG_LAST_PHASE < 6
    if (P0_PARTS & 8)
    for (int m = gw; m < TL; m += NGW) { f32x4 v[4]; ldrow_f32(inp(F, I_X) + (size_t)m * DM, F.lane, v); strow_f32(F.out + (size_t)m * DM, F.lane, v); }
#endif
}

#ifndef KSPLIT_CTX
#define KSPLIT_CTX 1
#endif
#ifndef X3_BF16
#define X3_BF16 1
#endif
__device__ __forceinline__ void ldvec(const float* p, int lane, f32x4 (&v)[4]) { ldrow_f32(p, lane, v); }
__device__ __forceinline__ void phase_modnorm0(Frame& F) {
    const int gw = F.vcu * NWAVES + F.wave, NGW = F.G * NWAVES, R = (T0 + NGW - 1) / NGW;
    const int r0 = gw * R, r1 = (r0 + R < T0) ? r0 + R : T0;
    int crb = -1; f32x4 A[4], B[4];
    for (int row = r0; row < r1; ++row) {
        const int rb = rowbatch(row);
        if (rb != crb) { crb = rb; f32x4 g[4], sc[4]; ldvec(inp(F, I_NORMG), F.lane, g); ldvec(modp(F, 0, rb, 1), F.lane, sc); ldvec(modp(F, 0, rb, 0), F.lane, B);
#pragma unroll
            for (int j = 0; j < 4; ++j) A[j] = g[j] * (sc[j] + 1.f); }
        const float* xr = row < TL ? inp(F, I_X) + (size_t)row * DM : inp(F, I_CTX) + (size_t)(row - TL) * DM;
        f32x4 v[4], o[4]; ldrow_f32_nt(xr, F.lane, v); const float rs = rstd_of(v);
#pragma unroll
        for (int j = 0; j < 4; ++j) o[j] = v[j] * rs * A[j] + B[j];
        strow_bf16_wt(F, wsp<bf16>(F, WS_HX) + (size_t)row * DM, F.lane, o);
    }
}
__device__ __forceinline__ void phase_e2(Frame& F, int layer) {
    const int gw = F.vcu * NWAVES + F.wave, NGW = F.G * NWAVES;
    const bool ksp = KSPLIT_CTX && layer == 0;
    const int nrows = (layer == 0 && !ksp) ? T0 : TL, R = (nrows + NGW - 1) / NGW;
    const int r0 = gw * R, r1 = (r0 + R < nrows) ? r0 + R : nrows;
    const int nx = ksp ? (TC - gw + NGW - 1) / NGW : 0;
    const bf16* Y = wsp<const bf16>(F, layer == 0 ? WS_Y : WS_Y1);
    int crb = -1; f32x4 C[4], A[4], B[4];
    for (int it = 0; it < (r1 > r0 ? r1 - r0 : 0) + nx; ++it) {
        const int row = (it < r1 - r0) ? r0 + it : TL + gw + (it - (r1 > r0 ? r1 - r0 : 0)) * NGW;
        const int rb = rowbatch(row);
        if (rb != crb) { crb = rb; f32x4 g1[4], m2[4], g2[4], m4[4]; ldvec(inp(F, I_NORMG) + (layer * 4 + 1) * 1024, F.lane, g1); ldvec(modp(F, layer, rb, 2), F.lane, m2);
            ldvec(inp(F, I_NORMG) + (layer * 4 + 2) * 1024, F.lane, g2); ldvec(modp(F, layer, rb, 4), F.lane, m4); ldvec(modp(F, layer, rb, 3), F.lane, B);
#pragma unroll
            for (int j = 0; j < 4; ++j) { C[j] = m2[j] * g1[j]; A[j] = g2[j] * (m4[j] + 1.f); } }
        const float* xr = layer == 0 ? (row < TL ? inp(F, I_X) + (size_t)row * DM : inp(F, I_CTX) + (size_t)(row - TL) * DM) : F.out + (size_t)row * DM;
        float* xo = row < TL ? F.out + (size_t)row * DM : wsp<float>(F, WS_CTXRES) + (size_t)(row - TL) * DM;
        f32x4 x[4], y[4]; ldrow_f32_nt(xr, F.lane, x);
        if (ksp && row >= TL) { const bf16* P = wsp<const bf16>(F, WS_YPART) + (size_t)(row - TL) * DM; f32x4 p1[4], p2[4], p3[4];
            ldrow_bf16(P, F.lane, y); ldrow_bf16(P + (size_t)TC * DM, F.lane, p1); ldrow_bf16(P + (size_t)2 * TC * DM, F.lane, p2); ldrow_bf16(P + (size_t)3 * TC * DM, F.lane, p3);
#pragma unroll
            for (int j = 0; j < 4; ++j) y[j] = (y[j] + p1[j]) + (p2[j] + p3[j]); }
        else ldrow_bf16_nt(Y + (size_t)row * DM, F.lane, y);
        const float ry = rstd_of(y);
#pragma unroll
        for (int j = 0; j < 4; ++j) x[j] = x[j] + (y[j] * ry) * C[j];
        if (layer == 0 || !X3_BF16) strow_f32_nt(xo, F.lane, x); else strow_bf16((bf16*)xo, F.lane, x);
        const float rx = rstd_of(x);
        GAS v2u* qh = (GAS v2u*)(wsp<bf16>(F, WS_HX) + (size_t)row * DM) + F.lane; GAS v2u* ql = (GAS v2u*)(wsp<bf16>(F, WS_TOKLO) + (size_t)row * DM) + F.lane;
        v2u hw[4], lw[4];
#pragma unroll
        for (int j = 0; j < 4; ++j) { const f32x4 t = x[j] * rx * A[j] + B[j]; unsigned h[4], l[4];
#pragma unroll
            for (int i = 0; i < 4; ++i) { h[i] = f2bf(t[i]); l[i] = f2bf(t[i] - bf2f(h[i])); }
            hw[j] = (v2u){h[0] | (h[1] << 16), h[2] | (h[3] << 16)}; lw[j] = (v2u){l[0] | (l[1] << 16), l[2] | (l[3] << 16)}; }
        if (ROW_WT) { strow_pk_wt(F, wsp<bf16>(F, WS_HX) + (size_t)row * DM, F.lane, hw); strow_pk_wt(F, wsp<bf16>(F, WS_TOKLO) + (size_t)row * DM, F.lane, lw); }
        else {
#pragma unroll
            for (int j = 0; j < 4; ++j) { qh[64 * j] = hw[j]; ql[64 * j] = lw[j]; } }
    }
}
__device__ __forceinline__ void phase_e4(Frame& F, int layer, int chunk, int CT, bool dry = false) {
    (void)dry;
    const int gw = F.vcu * NWAVES + F.wave, NGW = F.G * NWAVES, R = (CT + NGW - 1) / NGW;
    const LAS int* tbs = (const LAS int*)(F.lds + TBL_OFF + 4096);
    const int NBr = tbs[64], cstart = chunk * CT;
    const int r0 = cstart + gw * R, r1 = (gw * R + R < CT) ? r0 + R : cstart + CT;
    const unsigned char* YE = wsp<const unsigned char>(F, WS_YEXP);
    const GAS int* TS = (const GAS int*)wsp<const int>(F, WS_TOKSLOT); const GAS float* TG = (const GAS float*)wsp<const float>(F, WS_TOKGATE);
    int crb = -1; f32x4 C[4], A[4], B[4];
    for (int t = r0; t < r1; ++t) {
        const int rb = rowbatch(t);
        if (rb != crb) { crb = rb; f32x4 g3[4], m5[4]; ldvec(inp(F, I_NORMG) + (layer * 4 + 3) * 1024, F.lane, g3); ldvec(modp(F, layer, rb, 5), F.lane, m5);
#pragma unroll
            for (int j = 0; j < 4; ++j) C[j] = m5[j] * g3[j];
            if (layer == 0) { f32x4 g0[4], m1[4]; ldvec(inp(F, I_NORMG) + 4 * 1024, F.lane, g0); ldvec(modp(F, 1, rb, 1), F.lane, m1); ldvec(modp(F, 1, rb, 0), F.lane, B);
#pragma unroll
                for (int j = 0; j < 4; ++j) A[j] = g0[j] * (m1[j] + 1.f); } }
        f32x4 y[4], v[4]; ldrow_fp8(YE + ((size_t)256 * NBr + (t - cstart)) * DM, F.lane, y);
#pragma unroll
        for (int k = 0; k < TOPK; ++k) { const int s = __builtin_amdgcn_readfirstlane(TS[t * 8 + k]); const float gt = __builtin_bit_cast(float, __builtin_amdgcn_readfirstlane(__builtin_bit_cast(int, TG[t * 8 + k])));
            const size_t row = (size_t)256 * tbs[s >> 20] + (s & 0xfffff); ldrow_fp8(YE + row * DM, F.lane, v);
#pragma unroll
            for (int j = 0; j < 4; ++j) y[j] = y[j] + v[j] * gt; }
        float* xo = t < TL ? F.out + (size_t)t * DM : wsp<float>(F, WS_CTXRES) + (size_t)(t - TL) * DM;
        f32x4 x[4]; if (layer == 0 || !X3_BF16) ldrow_f32_nt(xo, F.lane, x); else ldrow_bf16_nt((const bf16*)xo, F.lane, x);
        const float ry = rstd_of(y);
#pragma unroll
        for (int j = 0; j < 4; ++j) x[j] = x[j] + (y[j] * ry) * C[j];
        if (layer == 1 && NT_STREAMS) { GAS f32x4* q_ = (GAS f32x4*)xo + F.lane;
#pragma unroll
            for (int j = 0; j < 4; ++j) __builtin_nontemporal_store(x[j], q_ + 64 * j); }
        else strow_f32_nt(xo, F.lane, x);
        if (layer == 0) { const float rx = rstd_of(x); f32x4 h[4];
#pragma unroll
            for (int j = 0; j < 4; ++j) h[j] = x[j] * rx * A[j] + B[j];
            strow_bf16_wt(F, wsp<bf16>(F, WS_HX) + (size_t)t * DM, F.lane, h); }
    }
}
__device__ __forceinline__ void phase_combine(Frame& F) {
    const int gw = F.vcu * NWAVES + F.wave, NGW = F.G * NWAVES;
    const float lam_init = 0.8f - 0.6f * expf(-0.3f);
    float s01 = 0.f, s23 = 0.f;
    for (int i = 0; i < 64; ++i) { s01 += inp(F, I_LAMBDA)[i] * inp(F, I_LAMBDA)[64 + i]; s23 += inp(F, I_LAMBDA)[128 + i] * inp(F, I_LAMBDA)[192 + i]; }
    const float lam = expf(s01) - expf(s23) + lam_init, post = 1.f - lam_init;
    const bf16* OC = wsp<const bf16>(F, WS_OC); bf16* AO = wsp<bf16>(F, WS_Q);
    const int h = F.lane >> 3, e0 = (F.lane & 7) * 16;
    float sg[16];
#pragma unroll
    for (int i = 0; i < 16; ++i) sg[i] = inp(F, I_SUBLNG)[e0 + i] * post;
    for (int t = gw; t < TL; t += NGW) {
        const bf16* p = OC + (size_t)t * 2048 + h * 256 + e0;
        const v4u a0 = NTLD((const GAS v4u*)p), a1 = NTLD((const GAS v4u*)(p + 8)), b0 = NTLD((const GAS v4u*)(p + 128)), b1 = NTLD((const GAS v4u*)(p + 136));
        const unsigned aw[8] = {a0.x, a0.y, a0.z, a0.w, a1.x, a1.y, a1.z, a1.w}, bw[8] = {b0.x, b0.y, b0.z, b0.w, b1.x, b1.y, b1.z, b1.w};
        float d[16]; float ss = 0.f;
#pragma unroll
        for (int i = 0; i < 8; ++i) { d[2 * i] = bf2f(aw[i] & 0xffffu) - lam * bf2f(bw[i] & 0xffffu); d[2 * i + 1] = bf2f(aw[i] >> 16) - lam * bf2f(bw[i] >> 16); ss += d[2 * i] * d[2 * i] + d[2 * i + 1] * d[2 * i + 1]; }
        ss += __shfl_xor(ss, 1); ss += __shfl_xor(ss, 2); ss += __shfl_xor(ss, 4);
        const float rstd = rsqrtf(ss * (1.f / 128.f) + EPSN);
        unsigned w[8];
#pragma unroll
        for (int i = 0; i < 8; ++i) w[i] = pk2(d[2 * i] * rstd * sg[2 * i], d[2 * i + 1] * rstd * sg[2 * i + 1]);
        bf16* q = AO + (size_t)t * DM + h * 128 + e0;
        if (ROW_WT) { const __amdgpu_buffer_rsrc_t rs_ = __builtin_amdgcn_make_buffer_rsrc((void*)F.ws, 0, 0x7fffffff, 0x00020000); const unsigned o_ = (unsigned)((const unsigned char*)q - (const unsigned char*)F.ws);
            __builtin_amdgcn_raw_buffer_store_b128((v4u){w[0], w[1], w[2], w[3]}, rs_, o_, 0, 16); __builtin_amdgcn_raw_buffer_store_b128((v4u){w[4], w[5], w[6], w[7]}, rs_, o_ + 16u, 0, 16); }
        else { *(GAS v4u*)q = (v4u){w[0], w[1], w[2], w[3]}; *(GAS v4u*)(q + 8) = (v4u){w[4], w[5], w[6], w[7]}; }
    }
}

__device__ __forceinline__ void phase_conv(Frame& F) {
    const int c = F.tid;
    float w[31];
#pragma unroll
    for (int j = 0; j < 31; ++j) w[j] = inp(F, I_CONVW)[j * 512 + c];
    const float bias = inp(F, I_CONVB)[c], lg = inp(F, I_LNG)[c], lb = inp(F, I_LNB)[c];
    LAS bf16* tile = (LAS bf16*)(F.lds);
    const bf16* AG = wsp<const bf16>(F, WS_AGLU); bf16* MIX = wsp<bf16>(F, WS_XA);
    for (int ti = F.vcu; ti < 544; ti += F.G) {
        int rowbase, L, p0;
        if (ti < 512) { rowbase = (ti >> 6) * SEQ; p0 = (ti & 63) * 64; L = SEQ; } else { const int q = ti - 512; rowbase = TL + (q >> 2) * CTXL; p0 = (q & 3) * 64; L = CTXL; }
        __syncthreads();
        for (int rr = F.wave; rr < 94; rr += 8) { const int p = p0 - 15 + rr; v4u val = (v4u){0u, 0u, 0u, 0u};
            if (p >= 0 && p < L) val = NTLD((const GAS v4u*)(AG + (size_t)(rowbase + p) * 512 + F.lane * 8));
            *(LAS v4u*)(tile + rr * 512 + F.lane * 8) = val; }
        __syncthreads();
        for (int ch = 0; ch < 8; ++ch) {
            float in[38];
#pragma unroll
            for (int i = 0; i < 38; ++i) in[i] = bf2f(tile[(ch * 8 + i) * 512 + c]);
            float a[8], s[8], ss[8];
#pragma unroll
            for (int q = 0; q < 8; ++q) { float t = bias;
#pragma unroll
                for (int j = 0; j < 31; ++j) t += w[j] * in[q + j];
                a[q] = t; s[q] = t; ss[q] = t * t; }
#pragma unroll
            for (int o = 1; o < 64; o <<= 1) {
                float ts[8], tq[8];
#pragma unroll
                for (int q = 0; q < 8; ++q) { ts[q] = __shfl_xor(s[q], o); tq[q] = __shfl_xor(ss[q], o); }
#pragma unroll
                for (int q = 0; q < 8; ++q) { s[q] += ts[q]; ss[q] += tq[q]; } }
#pragma unroll
            for (int q = 0; q < 8; ++q) { const float mean = s[q] * (1.f / 64.f), var = fmaxf(ss[q] * (1.f / 64.f) - mean * mean, 0.f);
                const float z = (a[q] - mean) * rsqrtf(var + EPSN) * lg + lb;
                ((GAS bf16*)MIX)[(size_t)(rowbase + p0 + ch * 8 + q) * 1536 + c] = (bf16)f2bf(z * __builtin_amdgcn_rcpf(1.f + __builtin_amdgcn_exp2f(-1.4426950408889634f * z))); }
        }
    }
    __syncthreads();
}

__device__ __forceinline__ void phase_router(Frame& F, int layer, int ntok, int CT, int cnt_off = 0) {
    typedef float f4 __attribute__((ext_vector_type(4)));
    const int gw = F.vcu * NWAVES + F.wave, NGW = F.G * NWAVES;
    LAS float* lg = (LAS float*)(F.lds + RING_OFF + F.wave * 20480);
    const bf16* TH = wsp<const bf16>(F, WS_HX); const bf16* TLo = wsp<const bf16>(F, WS_TOKLO);
    const bf16* WH = wsp<const bf16>(F, WS_WRT) + (size_t)layer * 2 * 64 * 1024; const bf16* WL = WH + 64 * 1024;
    const float* rbias = inp(F, I_RTB) + layer * 64;
    unsigned* cnt = (unsigned*)(F.ctl + CW_CNT) + layer * NCH * 64 * CNT_STRIDE + cnt_off;
    int* LIST = wsp<int>(F, WS_LIST); int* TS = wsp<int>(F, WS_TOKSLOT); float* TG = wsp<float>(F, WS_TOKGATE);
    const int lr = F.lane & 15, lq = F.lane >> 4;
    for (int task = F.wave * F.G + F.vcu; task < ntok / 64; task += NGW) {
        const int t0 = task * 64;
        f4 acc[4][4];
#pragma unroll
        for (int m = 0; m < 4; ++m)
#pragma unroll
            for (int n = 0; n < 4; ++n) acc[m][n] = (f4){0.f, 0.f, 0.f, 0.f};
        const bf16* ah = TH + (size_t)(t0 + lr) * DM + 8 * lq; const bf16* al = TLo + (size_t)(t0 + lr) * DM + 8 * lq;
        const bf16* bh = WH + (size_t)lr * DM + 8 * lq; const bf16* bl = WL + (size_t)lr * DM + 8 * lq;
#define RT_LOAD(XH, XL, WH, WL, K0) do { _Pragma("unroll") for (int m = 0; m < 4; ++m) { XH[m] = *(const GAS bf16x8*)(ah + (size_t)m * 16 * DM + (K0)); XL[m] = NTLD((const GAS bf16x8*)(al + (size_t)m * 16 * DM + (K0))); } \
            _Pragma("unroll") for (int n = 0; n < 4; ++n) { WH[n] = *(const GAS bf16x8*)(bh + (size_t)n * 16 * DM + (K0)); WL[n] = *(const GAS bf16x8*)(bl + (size_t)n * 16 * DM + (K0)); } } while (0)
#define RT_MMA(XH, XL, WH, WL) do { _Pragma("unroll") for (int m = 0; m < 4; ++m) _Pragma("unroll") for (int n = 0; n < 4; ++n) { \
            acc[m][n] = __builtin_amdgcn_mfma_f32_16x16x32_bf16(XH[m], WH[n], acc[m][n], 0, 0, 0); \
            acc[m][n] = __builtin_amdgcn_mfma_f32_16x16x32_bf16(XL[m], WH[n], acc[m][n], 0, 0, 0); \
            acc[m][n] = __builtin_amdgcn_mfma_f32_16x16x32_bf16(XH[m], WL[n], acc[m][n], 0, 0, 0); } } while (0)
        bf16x8 xhA[4], xlA[4], whA[4], wlA[4], xhB[4], xlB[4], whB[4], wlB[4];
        RT_LOAD(xhA, xlA, whA, wlA, 0);
        for (int ks = 0; ks < 32; ks += 2) {
            RT_LOAD(xhB, xlB, whB, wlB, (ks + 1) * 32);
            RT_MMA(xhA, xlA, whA, wlA);
            if (ks + 2 < 32) RT_LOAD(xhA, xlA, whA, wlA, (ks + 2) * 32);
            RT_MMA(xhB, xlB, whB, wlB);
        }
#undef RT_LOAD
#undef RT_MMA
#pragma unroll
        for (int m = 0; m < 4; ++m)
#pragma unroll
            for (int n = 0; n < 4; ++n)
#pragma unroll
                for (int j = 0; j < 4; ++j) lg[(m * 16 + 4 * lq + j) * 65 + n * 16 + lr] = acc[m][n][j];
        LDS_WAIT(); asm volatile("" ::: "memory");
        {
            const int t = t0 + F.lane;
            float v[64];
#pragma unroll
            for (int e = 0; e < 64; ++e) v[e] = pg8::sigm(lg[F.lane * 65 + e]) + rbias[e];
            float gs[8];
#pragma unroll
            for (int g = 0; g < 8; ++g) { float m1 = -INFINITY, m2 = -INFINITY;
#pragma unroll
                for (int i = 0; i < 8; ++i) { const float xx = v[8 * g + i]; m2 = fmaxf(m2, fminf(m1, xx)); m1 = fmaxf(m1, xx); }
                gs[g] = m1 + m2; }
#pragma unroll
            for (int g = 0; g < 8; ++g) { int rank = 0;
#pragma unroll
                for (int g2 = 0; g2 < 8; ++g2) rank += (gs[g2] > gs[g] || (gs[g2] == gs[g] && g2 < g)) ? 1 : 0;
                if (rank >= 4) {
#pragma unroll
                    for (int i = 0; i < 8; ++i) v[8 * g + i] = -INFINITY; } }
            int se[TOPK]; float ss[TOPK]; float ssum = 0.f;
#pragma unroll
            for (int k = 0; k < TOPK; ++k) { float best = -INFINITY; int bi = 0;
#pragma unroll
                for (int e = 0; e < 64; ++e) { const bool gt = v[e] > best; best = gt ? v[e] : best; bi = gt ? e : bi; }
#pragma unroll
                for (int e = 0; e < 64; ++e) v[e] = (e == bi) ? -INFINITY : v[e];
                const float bs = pg8::sigm(lg[F.lane * 65 + bi]);
                se[k] = bi; ss[k] = bs; ssum += bs; }
            const int chunk = t0 / CT; const float inv = 2.5f / ssum;
            LAS unsigned* hist = (LAS unsigned*)(lg + 64 * 65); LAS unsigned* hbase = hist + 64;
            hist[F.lane] = 0u; LDS_WAIT(); asm volatile("" ::: "memory");
            unsigned lrank[TOPK];
#pragma unroll
            for (int k = 0; k < TOPK; ++k) lrank[k] = __hip_atomic_fetch_add(hist + se[k], 1u, __ATOMIC_RELAXED, __HIP_MEMORY_SCOPE_WORKGROUP);
            LDS_WAIT(); asm volatile("" ::: "memory");
            { const unsigned tot = hist[F.lane]; unsigned base = 0u; if (tot) base = __hip_atomic_fetch_add(cnt + (chunk * 64 + F.lane) * CNT_STRIDE, tot, RLX_AGENT); hbase[F.lane] = base; }
            LDS_WAIT(); asm volatile("" ::: "memory");
#pragma unroll
            for (int k = 0; k < TOPK; ++k) { const int e = se[k]; const unsigned pos = hbase[e] + lrank[k];
                ((GAS int*)LIST)[((size_t)chunk * 64 + e) * CAP + pos] = t; ((GAS int*)TS)[t * 8 + k] = (e << 20) | (int)pos; ((GAS float*)TG)[t * 8 + k] = ss[k] * inv; }
        }
        LDS_WAIT(); asm volatile("" ::: "memory");
    }
}

template <bool GATHER_> struct MoeOrder {
    static constexpr bool GATHER = GATHER_; static constexpr int AUXA = 0;
    const LAS int* tb; int NBr, NBt, NPN, G, vcu;
    unsigned Asrc; int lda;
    unsigned Bexp, bstride, Bsh; int ldb;
    const int* list; const unsigned* cnt; int cstart; const LAS int* rows;
    __device__ __forceinline__ bool next(int i, pg8::Unit& u) const {
        const int L = i * G + vcu; if (L >= NBt * NPN) return false;
        const int blk = L / NPN, pn = L - blk * NPN; u.pm = blk; u.pn = pn;
        if (blk < NBr) { const int w = tb[blk]; u.aux = GATHER ? i : w; u.B = Bexp + (unsigned)(w >> 16) * bstride + (unsigned)pn * 256u * ldb * 2u; }
        else { u.aux = GATHER ? i : -1; u.B = Bsh + (unsigned)pn * 256u * ldb * 2u; }
        u.A = GATHER ? Asrc : Asrc + (unsigned)blk * 256u * lda * 2u; return true;
    }
    __device__ __forceinline__ void aoffs(const pg8::Unit& u, unsigned (&v)[2][2]) const {
        int tid = threadIdx.x; asm volatile("" : "+v"(tid));
#pragma unroll
        for (int i = 0; i < 2; ++i) { int R, C; pg8::stage_rc(tid * 16 + i * 8192, R, C);
#pragma unroll
            for (int h = 0; h < 2; ++h) { const int r = h * 128 + R;
                if constexpr (!GATHER) v[h][i] = (unsigned)(r * lda + C) * 2u;
                else v[h][i] = (unsigned)(rows[u.aux * 256 + r] * lda + C) * 2u; } }
    }
};
__device__ __forceinline__ void moe_rows(Frame& F, LAS int* rows, int NBr, int NBt, int NPN, const int* list, int cstart, bool UP_IDENT_ON = false) {
    const LAS int* tb = (const LAS int*)(F.lds + TBL_OFF);
    for (int idx = F.tid; idx < 16 * 256; idx += NWAVES * 64) { const int i = idx >> 8, r = idx & 255; const int L = i * F.G + F.vcu; if (L >= NBt * NPN) break;
        const int blk = L / NPN; int tok;
        if (blk < NBr) { const int w = tb[blk], e = w >> 16, pos = (w & 0xffff) * 256 + r; tok = pos < tb[1024 + 128 + e] ? ((const GAS int*)list)[(size_t)e * CAP + pos] : cstart; }
        else tok = cstart + (blk - NBr) * 256 + r;
#ifdef UP_IDENT
        if (UP_IDENT_ON) tok = cstart + ((i * 7 + (F.vcu & 63)) & 63) * 256 + r;
#endif
        rows[idx] = tok; }
    __syncthreads();
}
__device__ __forceinline__ void moe_tables(Frame& F, const unsigned* cnt) {
    LAS int* tb = (LAS int*)(F.lds + TBL_OFF); LAS int* tbs = (LAS int*)(F.lds + TBL_OFF + 4096);
    __syncthreads();
    if (F.wave == 0) { const int c = (int)cnt[F.lane * CNT_STRIDE]; const int nb = (c + 255) >> 8; int inc = nb;
#pragma unroll
        for (int o = 1; o < 64; o <<= 1) { const int t = __shfl_up(inc, o); if (F.lane >= o) inc += t; }
        const int start = inc - nb; tbs[F.lane] = start; tbs[128 + F.lane] = c; if (F.lane == 63) tbs[64] = inc;
        for (int j = 0; j < nb; ++j) tb[start + j] = (F.lane << 16) | j; }
    __syncthreads();
}

struct DftOrder {
    static constexpr bool GATHER = false; static constexpr int AUXA = 0;
    unsigned TAB, FT; int L, nM, G, vcu;
    __device__ __forceinline__ bool next(int i, pg8::Unit& u) const {
        const int U = i * G + vcu; if (U >= NBATCH * nM * 2) return false;
        const int b = U / (nM * 2), r = U % (nM * 2); u.pm = r >> 1; u.pn = r & 1; u.aux = b;
        u.A = TAB + (unsigned)u.pm * 256u * L * 2u; u.B = FT + ((unsigned)b * 512u + u.pn * 256u) * L * 2u; return true;
    }
    __device__ __forceinline__ void aoffs(const pg8::Unit&, unsigned (&v)[2][2]) const {
        int tid = threadIdx.x; asm volatile("" : "+v"(tid));
#pragma unroll
        for (int i = 0; i < 2; ++i) { int R, C; pg8::stage_rc(tid * 16 + i * 8192, R, C);
#pragma unroll
            for (int h = 0; h < 2; ++h) v[h][i] = (unsigned)((h * 128 + R) * L + C) * 2u; }
    }
};

struct KSplitOrder {
    static constexpr bool GATHER = false; static constexpr int AUXA = 0;
    unsigned A, B; int ld, nM, nN, nS, Kq, G, c;
    __device__ __forceinline__ bool next(int i, pg8::Unit& u) const {
        const int U = i * G + c; if (U >= nM * nN * nS) return false;
        const int ks = U % nS, t = U / nS, pm = t % nM, pn = t / nM; u.pm = pm + nM * ks; u.pn = pn; u.aux = 0;
        u.A = A + ((unsigned)pm * 256u * ld + (unsigned)ks * Kq) * 2u; u.B = B + ((unsigned)pn * 256u * ld + (unsigned)ks * Kq) * 2u; return true;
    }
    __device__ __forceinline__ void aoffs(const pg8::Unit&, unsigned (&v)[2][2]) const {
        int tid = threadIdx.x; asm volatile("" : "+v"(tid));
#pragma unroll
        for (int i = 0; i < 2; ++i) { int R, C; pg8::stage_rc(tid * 16 + i * 8192, R, C);
#pragma unroll
            for (int h = 0; h < 2; ++h) v[h][i] = (unsigned)((h * 128 + R) * ld + C) * 2u; }
    }
};
#ifndef KSPLIT_CTX
#define KSPLIT_CTX 1
#endif

struct Args { const float* in[25]; float* out; unsigned char* ws; int ph_lo, ph_hi, li, pad; };
#ifndef CVT_EARLY
#define CVT_EARLY 8192
#endif
#ifndef REPEAT_MASK
#define REPEAT_MASK 0u
#endif
#define IN(k) (lo <= (k) && (k) < hi && (k) <= DBG_LAST_PHASE)
#define REPS(k) for (int rep_ = 0; rep_ <= (int)((REPEAT_MASK >> (k)) & 1u); ++rep_)
#define SEAM(k) do { if (lo <= (k) && (k) + 1 < hi) xcd_barrier(bar); } while (0)

template <int LAYER, int CHUNK> __device__ __forceinline__ void moe_chunk(Frame& F, const XcdBarrier& bar, const int lo, const int hi) {
    constexpr int pb = LAYER == 0 ? PB0 : PB1, p = pb + 2 + 3 * CHUNK, ntok = LAYER == 0 ? T0 : TL, CT = ntok / NCH;
    if (IN(p)) REPS(p) { FENCE(F);
        const unsigned* cnt = (const unsigned*)(F.ctl + CW_CNT) + (LAYER * NCH + CHUNK) * 64 * CNT_STRIDE; const int* list = wsp<const int>(F, WS_LIST) + (size_t)CHUNK * 64 * CAP;
        const LAS int* tb = (const LAS int*)(F.lds + TBL_OFF); const LAS int* tbs = (const LAS int*)(F.lds + TBL_OFF + 4096);
        moe_tables(F, cnt); const int NBr = tbs[64];
        LAS int* rows = (LAS int*)(F.lds + STAGE_OFF);
        moe_rows(F, rows, NBr, NBr + CT / 256, 2, list, CHUNK * CT);
        MoeOrder<true> S{tb, NBr, NBr + CT / 256, 2, F.G, F.vcu, (unsigned)WS_HX, 1024, (unsigned)WS_WEUP, 512u * 1024u * 2u, (unsigned)WS_SHUP + (unsigned)LAYER * 512u * 1024u * 2u, 1024, list, cnt, CHUNK * CT, rows};
#ifdef UP_DRY
        { if (UP_DRY == 2) moe_rows(F, rows, NBr, NBr + CT / 256, 2, list, CHUNK * CT, true);
          pg8::EpiSwiglu E{wsp<bf16>(F, WS_HID), 256, F.ws, UP_DRY == 1 ? 1 : 0}; pg8::gemm_phase(F.lds + RING_OFF, F.ws, 1024, 1024, S, E); FENCE(F);
          if (UP_DRY == 2) { __syncthreads(); moe_rows(F, rows, NBr, NBr + CT / 256, 2, list, CHUNK * CT); } }
#endif
        pg8::EpiSwiglu E{wsp<bf16>(F, WS_HID), 256, F.ws}; pg8::gemm_phase(F.lds + RING_OFF, F.ws, 1024, 1024, S, E); } SEAM(p);
    if (IN(p + 1)) REPS(p + 1) { FENCE(F);
        const unsigned* cnt = (const unsigned*)(F.ctl + CW_CNT) + (LAYER * NCH + CHUNK) * 64 * CNT_STRIDE; const int* list = wsp<const int>(F, WS_LIST) + (size_t)CHUNK * 64 * CAP;
        const LAS int* tb = (const LAS int*)(F.lds + TBL_OFF); const LAS int* tbs = (const LAS int*)(F.lds + TBL_OFF + 4096);
        moe_tables(F, cnt); const int NBr = tbs[64];
        MoeOrder<false> S{tb, NBr, NBr + CT / 256, 4, F.G, F.vcu, (unsigned)WS_HID, 256, (unsigned)WS_WEDN, 1024u * 256u * 2u, (unsigned)WS_SHDN + (unsigned)LAYER * 1024u * 256u * 2u, 256, list, cnt, CHUNK * CT, nullptr};
        pg8::EpiFp8 E{wsp<unsigned char>(F, WS_YEXP), F.lds + STAGE_OFF, F.ws}; pg8::gemm_phase(F.lds + RING_OFF, F.ws, 256, 256, S, E); } SEAM(p + 1);
    if (IN(p + 2)) REPS(p + 2) { FENCE(F);
        const unsigned* cnt = (const unsigned*)(F.ctl + CW_CNT) + (LAYER * NCH + CHUNK) * 64 * CNT_STRIDE;
        moe_tables(F, cnt);
        phase_e4(F, LAYER, CHUNK, CT); }
    if (CHUNK == NCH - 1) SEAM(p + 2);
#if !MK_SINGLE
    static_assert(true, "");
#endif
}
template <int LAYER> __device__ __forceinline__ void moe_part(Frame& F, const XcdBarrier& bar, const int lo, const int hi) {
    constexpr int pb = LAYER == 0 ? PB0 : PB1, ntok = LAYER == 0 ? T0 : TL, CT = ntok / NCH;
    if (IN(pb)) REPS(pb) { FENCE(F); phase_e2(F, LAYER); } SEAM(pb);
    if (IN(pb + 1)) { FENCE(F);
#ifdef ROUTER_TIMING
        phase_router(F, LAYER, ntok, CT, 4 * 64 * CNT_STRIDE); FENCE(F);
#endif
        phase_router(F, LAYER, ntok, CT); } SEAM(pb + 1);
    moe_chunk<LAYER, 0>(F, bar, lo, hi);
    if constexpr (NCH > 1) moe_chunk<LAYER, NCH - 1>(F, bar, lo, hi);
    static_assert(NCH <= 2, "moe_part instantiates chunks 0 and NCH-1");
}

__global__ void __launch_bounds__(NWAVES * 64, 2) mega_fwd(Args args) {
    extern __shared__ __attribute__((aligned(16))) unsigned char lds[];
    Frame F;
    F.lds = (LAS unsigned char*)lds;
    F.MISC = (volatile LAS unsigned*)(F.lds + MISC_OFF);
    F.tid = threadIdx.x; F.lane = F.tid & 63; F.wave = __builtin_amdgcn_readfirstlane(F.tid >> 6);
    F.G = gridDim.x; { const int bx = blockIdx.x; F.vcu = (F.G % 8 == 0) ? (bx % 8) * (F.G / 8) + bx / 8 : bx; }
    F.ws = args.ws; F.ctl = (gu32*)(args.ws + WS_CTL); F.out = args.out;
    for (int u = F.tid; u < (LDS_BYTES - LDSCTL_OFF) / 4; u += NWAVES * 64) ((LAS unsigned*)(F.lds + LDSCTL_OFF))[u] = 0u;
    __syncthreads();
    if (F.tid < 25) { const unsigned long long pv = (unsigned long long)args.in[F.tid]; LAS unsigned* t = (LAS unsigned*)(F.lds + INPTR_OFF) + 2 * F.tid; t[0] = (unsigned)pv; t[1] = (unsigned)(pv >> 32); }
    __syncthreads();
    XcdBarrier bar; bar.bar = (unsigned*)(F.ctl + CW_BAR); bar.x = 0; bar.st = nullptr;
#if MK_SINGLE
    bar = xcd_barrier_post((unsigned*)(F.ctl + CW_BAR), F.MISC + 8);
#endif
    const int lo = args.ph_lo, hi = args.ph_hi;
    const int bx = (int)blockIdx.x;

    if (IN(0)) REPS(0) { FENCE(F); p0_prologue(F); } SEAM(0);
#ifdef EXTRA_BARS
    for (int eb = 0; eb < EXTRA_BARS; ++eb) xcd_barrier(bar);
#endif
    if (IN(1)) REPS(1) { FENCE(F); phase_modnorm0(F); } SEAM(1);
    if (IN(2)) REPS(2) { FENCE(F);
        pg8::DenseOrder S; S.init((unsigned)WS_HX, 1024, (unsigned)WS_WIN, 1024, T0 / 256, 6, 0, F.G, bx); pg8::EpiGluFT E{{wsp<bf16>(F, WS_AGLU), F.ws}, {wsp<bf16>(F, WS_FT), wsp<bf16>(F, WS_FTC)}}; pg8::gemm_phase(F.lds + RING_OFF, F.ws, 1024, 1024, S, E);
        if (CVT0_LATE > 0 && F.G == 256 && bx >= 48) { FENCE(F); convert_experts(F, 0, 0, CVT0_LATE, 48, 208); } } SEAM(2);
    if (IN(3)) REPS(3) { FENCE(F); phase_conv(F);
        { DftOrder S{(unsigned)WS_TAB, (unsigned)WS_FT, SEQ, SEQ / 256, F.G, F.vcu}; pg8::EpiDft<SEQ> E{wsp<bf16>(F, WS_XA), 0, F.ws, 1536, 512}; pg8::gemm_phase(F.lds + RING_OFF, F.ws, SEQ, SEQ, S, E); }
        FENCE(F);
        { DftOrder S{(unsigned)WS_TABC, (unsigned)WS_FTC, CTXL, 1, F.G, F.G - 1 - F.vcu};     pg8::EpiDft<CTXL> E{wsp<bf16>(F, WS_XA), TL, F.ws, 1536, 512}; pg8::gemm_phase(F.lds + RING_OFF, F.ws, CTXL, CTXL, S, E); } } SEAM(3);
    if (IN(4)) REPS(4) { FENCE(F);
#if KSPLIT_CTX
        { pg8::DenseOrder S; S.init((unsigned)WS_XA, 1536, (unsigned)WS_W2, 1536, TL / 256, 4, 0, F.G, bx);
          pg8::EpiBf16 E{wsp<bf16>(F, WS_Y), 1024, 0, F.lds + STAGE_OFF, F.ws}; pg8::gemm_phase(F.lds + RING_OFF, F.ws, 1536, 1536, S, E); }
        FENCE(F);
        { KSplitOrder S{(unsigned)(WS_XA + (size_t)TL * 1536 * 2), (unsigned)WS_W2, 1536, TC / 256, 4, 4, 384, F.G, bx};
          pg8::EpiBf16 E{wsp<bf16>(F, WS_YPART), 1024, 0, F.lds + STAGE_OFF, F.ws}; pg8::gemm_phase(F.lds + RING_OFF, F.ws, 384, 1536, S, E); }
#else
        pg8::DenseOrder S; S.init((unsigned)WS_XA, 1536, (unsigned)WS_W2, 1536, T0 / 256, 4, 0, F.G, bx);
        pg8::EpiBf16 E{wsp<bf16>(F, WS_Y), 1024, 0, F.lds + STAGE_OFF, F.ws}; pg8::gemm_phase(F.lds + RING_OFF, F.ws, 1536, 1536, S, E);
#endif
    } SEAM(4);
    moe_part<0>(F, bar, lo, hi);
    if (IN(PH_QKV)) REPS(PH_QKV) { FENCE(F);
        { pg8::DenseOrder S; S.init((unsigned)WS_HX, 1024, (unsigned)WS_WQKV, 1024, TL / 256, 12, 0, F.G, bx);
          pg8::EpiQkv E{wsp<bf16>(F, WS_Q), wsp<bf16>(F, WS_KALL), wsp<bf16>(F, WS_VALL), wsp<unsigned>(F, WS_ROPE), 0, F.ws, F.lds + STAGE_OFF, (unsigned*)(F.ctl + CW_KMAX)}; pg8::gemm_phase(F.lds + RING_OFF, F.ws, 1024, 1024, S, E); }
        FENCE(F);
        { pg8::DenseOrder S; S.init((unsigned)(WS_HX + (size_t)TL * 2048), 1024, (unsigned)WS_WQKV, 1024, TC / 256, 8, 4, F.G, bx);
          pg8::EpiQkv E{wsp<bf16>(F, WS_Q), wsp<bf16>(F, WS_KALL), wsp<bf16>(F, WS_VALL), wsp<unsigned>(F, WS_ROPE), 1, F.ws, F.lds + STAGE_OFF, (unsigned*)(F.ctl + CW_KMAX)}; pg8::gemm_phase(F.lds + RING_OFF, F.ws, 1024, 1024, S, E); }
        if (CVT_EARLY > 0 && F.G == 256 && bx >= 64) { FENCE(F); convert_experts(F, 1, 0, CVT_EARLY, 64, 192); }
    } SEAM(PH_QKV);
    if (IN(PH_ATT)) REPS(PH_ATT) { FENCE(F);
        const attn_body::bf16* Q = wsp<const attn_body::bf16>(F, WS_Q); const attn_body::bf16* KA = wsp<const attn_body::bf16>(F, WS_KALL); const attn_body::bf16* VA = wsp<const attn_body::bf16>(F, WS_VALL);
        attn_body::bf16* OC = wsp<attn_body::bf16>(F, WS_OC);
        for (int i = 0;; ++i) { int bh, cc, qb;
            if (F.G == 256) { if (i >= 8) break; const int xg = F.vcu >> 5, ci = F.vcu & 31; bh = xg * 8 + i; cc = ci >> 4; qb = ci & 15; }
            else { const int u = i * F.G + F.vcu; if (u >= 64 * 2 * (SEQ / 256)) break; bh = u >> 5; cc = (u >> 4) & 1; qb = u & 15; }
            const int b = bh >> 3, h = bh & 7;
            attn_body::attn_unit<8>(Q + ((size_t)b * SEQ + qb * 256) * 1024 + h * 128 + cc * 64, KA + (size_t)b * LKV * 1024 + h * 128 + cc * 64, VA + (size_t)b * LKV * 1024 + h * 128,
                                    OC + ((size_t)b * SEQ + qb * 256) * 2048 + h * 256 + cc * 128, LKV / 64, (char*)lds + RING_OFF, __builtin_bit_cast(float, F.ctl[CW_KMAX + (b * 8 + h) * 2 + cc])); }
    } SEAM(PH_ATT);
    if (IN(PH_CMB)) REPS(PH_CMB) { FENCE(F); phase_combine(F); FENCE(F); convert_experts(F, 1, (CVT_EARLY > 0 && F.G == 256) ? CVT_EARLY : 0); } SEAM(PH_CMB);
    if (IN(PH_OPR)) REPS(PH_OPR) { FENCE(F); pg8::DenseOrder S; S.init((unsigned)WS_Q, 1024, (unsigned)WS_WDAO, 1024, TL / 256, 4, 0, F.G, bx);
#ifdef OPR_EXTRA
        for (int xk = 0; xk < OPR_EXTRA; ++xk) {
#ifdef OPR_AMUL
            S.amul = OPR_AMUL;
#endif
#if OPR_NULL
            pg8::EpiNull<true> E0; pg8::gemm_phase(F.lds + RING_OFF, F.ws, 1024, 1024, S, E0);
#else
            pg8::EpiBf16 E0{wsp<bf16>(F, WS_Y1), 1024, 0, F.lds + STAGE_OFF, F.ws}; pg8::gemm_phase(F.lds + RING_OFF, F.ws, 1024, 1024, S, E0);
#endif
            FENCE(F); S.init((unsigned)WS_Q, 1024, (unsigned)WS_WDAO, 1024, TL / 256, 4, 0, F.G, bx); }
#endif
        pg8::EpiBf16 E{wsp<bf16>(F, WS_Y1), 1024, 0, F.lds + STAGE_OFF, F.ws}; pg8::gemm_phase(F.lds + RING_OFF, F.ws, 1024, 1024, S, E); } SEAM(PH_OPR);
    moe_part<1>(F, bar, lo, hi);
}
#undef IN
#undef SEAM

extern "C" void kernel_launch(void* const* d_in, const int* in_sizes, int n_in, void* d_out, int out_size, void* d_ws, size_t ws_size, hipStream_t stream) {
    static int grid = 0;
    if (grid == 0) {
        if (n_in != 25 || in_sizes[0] != TL * DM || out_size != TL * DM || ws_size < WS_END) { fprintf(stderr, "kernel_launch: unexpected problem shape / workspace (n_in %d, in0 %d, out %d, ws %zu, need %zu); nothing launched\n", n_in, n_in > 0 ? in_sizes[0] : -1, out_size, ws_size, (size_t)WS_END); grid = -1; return; }
        int dev = 0, cus = 0, per_cu = 0;
        if (hipGetDevice(&dev) != hipSuccess || hipDeviceGetAttribute(&cus, hipDeviceAttributeMultiprocessorCount, dev) != hipSuccess) { grid = -1; return; }
        if (hipFuncSetAttribute((const void*)mega_fwd, hipFuncAttributeMaxDynamicSharedMemorySize, LDS_BYTES) != hipSuccess) { fprintf(stderr, "kernel_launch: hipFuncSetAttribute failed\n"); grid = -1; return; }
        if (hipOccupancyMaxActiveBlocksPerMultiprocessor(&per_cu, (const void*)mega_fwd, NWAVES * 64, LDS_BYTES) != hipSuccess || per_cu < 1) fprintf(stderr, "kernel_launch: occupancy query reports %d per CU\n", per_cu);
        (void)hipGetLastError();
        grid = cus;
    }
    if (grid < 0) return;
    if (hipMemsetAsync((char*)d_ws + WS_CTL, 0, CTL_ZERO_BYTES, stream) != hipSuccess) return;
    Args a{};
    for (int i = 0; i < 25; ++i) a.in[i] = (const float*)d_in[i];
    a.out = (float*)d_out; a.ws = (unsigned char*)d_ws;
#if MK_SINGLE
    a.ph_lo = 0; a.ph_hi = NPHASES; a.li = 0;
    hipLaunchKernelGGL(mega_fwd, dim3(grid), dim3(NWAVES * 64), LDS_BYTES, stream, a);
#else
    for (int p = 0; p <= DBG_LAST_PHASE && p < NPHASES; ++p) { a.ph_lo = p; a.ph_hi = p + 1; a.li = p;
        hipLaunchKernelGGL(mega_fwd, dim3(grid), dim3(NWAVES * 64), LDS_BYTES, stream, a); }
#endif
}
```

```cpp
#define CVT0_LATE 8192
#include <hip/hip_runtime.h>
#include <hip/hip_bf16.h>
#include <cstdio>
#include <cstdint>
#include <cmath>

#ifndef MK_SINGLE
#define MK_SINGLE 1
#endif

constexpr int DM = 1024, NBATCH = 8, SEQ = 4096, CTXL = 256;
constexpr int TL = NBATCH * SEQ;
constexpr int TC = NBATCH * CTXL;
constexpr int T0 = TL + TC;
constexpr int LKV = CTXL + SEQ;
constexpr float EPSN = 1e-6f;
constexpr int NEXP = 64, TOPK = 6;
constexpr int NCH = 1;
constexpr int CAP = T0 / NCH;

namespace pg8 {
#define PG8_LAS __attribute__((address_space(3)))
#define PG8_GAS __attribute__((address_space(1)))
typedef unsigned short bf16_t;
typedef short bf16x8 __attribute__((ext_vector_type(8)));
typedef float f32x4 __attribute__((ext_vector_type(4)));
typedef unsigned u32x4 __attribute__((ext_vector_type(4)));
constexpr int BM = 256, BK = 64, HALF = 128, HTB = HALF * BK * 2, STAGE_BYTES = 8 * HTB;

__host__ __device__ __forceinline__ int lds_byte(int r, int c) { const int st = (r >> 4) * 2 + (c >> 5), rr = r & 15, cc = c & 31, ob = rr * 64 + cc * 2; return st * 1024 + (ob ^ (((ob >> 9) & 1) << 5)); }
__host__ __device__ __forceinline__ void stage_rc(int b, int& R, int& C) { const int st = b / 1024, sb = b % 1024, swz = sb ^ (((sb >> 9) & 1) << 5); R = (st >> 1) * 16 + swz / 64; C = (st & 1) * 32 + (swz % 64) / 2; }
__host__ __device__ __forceinline__ int perm32(int rho) { const int n = rho >> 4, i = rho & 15; return 8 * (i >> 2) + 4 * n + (i & 3); }

struct Unit { unsigned A, B; int pm, pn, aux; };

__device__ __forceinline__ unsigned cvt_pk_bf16(float lo, float hi) { unsigned r; asm volatile("v_cvt_pk_bf16_f32 %0, %1, %2" : "=v"(r) : "v"(lo), "v"(hi)); return r; }
__device__ __forceinline__ u32x4 pack8(const f32x4& a, const f32x4& b) { u32x4 w; w.x = cvt_pk_bf16(a[0], a[1]); w.y = cvt_pk_bf16(a[2], a[3]); w.z = cvt_pk_bf16(b[0], b[1]); w.w = cvt_pk_bf16(b[2], b[3]); return w; }

#ifndef EPI_SC1
#define EPI_SC1 16
#endif
#ifndef FP8_ST_NT
#define FP8_ST_NT 1
#endif
#ifndef HID_ST_NT
#define HID_ST_NT 0
#endif
#ifndef EPI_NT
#define EPI_NT 2
#endif
struct WsStore { __amdgpu_buffer_rsrc_t r; const unsigned char* b;
    __device__ __forceinline__ WsStore(const void* wsbase) : r(__builtin_amdgcn_make_buffer_rsrc((void*)wsbase, 0, 0x7fffffff, 0x00020000)), b((const unsigned char*)wsbase) {}
    __device__ __forceinline__ void st(const void* p, const u32x4& v) const { __builtin_amdgcn_raw_buffer_store_b128(v, r, (unsigned)((const unsigned char*)p - b), 0, EPI_SC1); }
    __device__ __forceinline__ void st_nt(const void* p, const u32x4& v) const { __builtin_amdgcn_raw_buffer_store_b128(v, r, (unsigned)((const unsigned char*)p - b), 0, EPI_SC1 | EPI_NT); } };

template <class Epi, class Sched>
__device__ __forceinline__ void gemm_phase(PG8_LAS unsigned char* lds, const void* wsbase, const int K, const int ldb, const Sched& S, const Epi& E) {
    const __amdgpu_buffer_rsrc_t rsrc = __builtin_amdgcn_make_buffer_rsrc((void*)wsbase, 0, 0x7fffffff, 0x00020000);
    int tid_ = threadIdx.x; asm volatile("" : "+v"(tid_));
    const int tid = tid_, wid = __builtin_amdgcn_readfirstlane(tid >> 6), lane = tid & 63, wr = wid >> 2, wc = wid & 3, fr = lane & 15, fq = lane >> 4;
    const int nt = K / BK;
    unsigned voffB[2];
#pragma unroll
    for (int i = 0; i < 2; ++i) { int R, C; stage_rc(tid * 16 + i * 8192, R, C); const int Rb = Epi::WIDE ? 64 * (R >> 5) + perm32(R & 31) : (R & ~31) + perm32(R & 31); voffB[i] = (unsigned)(Rb * ldb + C) * 2u; }
    const unsigned kstep = (unsigned)(BK * 2);
    const unsigned hstepB = (unsigned)(Epi::WIDE ? 32 : HALF) * ldb * 2;
    const unsigned ldsw = (unsigned)wid * 1024u;
    const int aoff = lds_byte(wr * 64 + fr, fq * 8), boff = lds_byte(wc * 32 + fr, fq * 8);
#define PG8_SA(b, h) (((b) * 2 + (h)) * HTB)
#define PG8_SB(b, h) ((4 + (b) * 2 + (h)) * HTB)
#define PG8_STGX(bufoff, gbase, v0, v1, AUX) do { \
        __builtin_amdgcn_raw_ptr_buffer_load_lds(rsrc, (PG8_LAS unsigned*)(lds + (bufoff) + ldsw), 16, (v0), (gbase), 0, (AUX)); \
        __builtin_amdgcn_raw_ptr_buffer_load_lds(rsrc, (PG8_LAS unsigned*)(lds + (bufoff) + ldsw + 8192), 16, (v1), (gbase), 0, (AUX)); } while (0)
#define PG8_STG(bufoff, gbase, v0, v1) PG8_STGX(bufoff, gbase, v0, v1, Sched::AUXA)
#define PG8_STGB(bufoff, gbase) PG8_STGX(bufoff, gbase, voffB[0], voffB[1], 0)
#define PG8_LDA(dst, b, h) do { _Pragma("unroll") for (int m = 0; m < 4; ++m) _Pragma("unroll") for (int k = 0; k < 2; ++k) dst[m][k] = *(const PG8_LAS bf16x8*)(lds + PG8_SA(b, h) + aoff + m * 2048 + k * 1024); } while (0)
#define PG8_LDB(dst, b, h) do { _Pragma("unroll") for (int n = 0; n < 2; ++n) _Pragma("unroll") for (int k = 0; k < 2; ++k) dst[n][k] = *(const PG8_LAS bf16x8*)(lds + PG8_SB(b, h) + boff + n * 2048 + k * 1024); } while (0)
#define PG8_MMA(ai, bj, At, Bt) do { __builtin_amdgcn_s_setprio(1); _Pragma("unroll") for (int m = 0; m < 4; ++m) _Pragma("unroll") for (int n = 0; n < 2; ++n) _Pragma("unroll") for (int k = 0; k < 2; ++k) \
        acc[ai][bj][m][n] = __builtin_amdgcn_mfma_f32_16x16x32_bf16(Bt[n][k], At[m][k], acc[ai][bj][m][n], 0, 0, 0); __builtin_amdgcn_s_setprio(0); } while (0)
#define PG8_WAIT_V(n) asm volatile("s_waitcnt vmcnt(" #n ")" ::: "memory")
#define PG8_WAIT_VN(n) asm volatile("s_waitcnt vmcnt(%0)" ::"n"(n) : "memory")
#define PG8_WAIT_L(n) asm volatile("s_waitcnt lgkmcnt(" #n ")" ::: "memory")
#define PG8_BAR __builtin_amdgcn_s_barrier()
#define PG8_SCHED __builtin_amdgcn_sched_barrier(0)
    Unit cur, nxt; int ui = 0;
    if (!S.next(0, cur)) return;
#ifndef PG8_SLK1
#define PG8_SLK1 0
#define PG8_SLK2 0
#endif
#ifndef PG8_FIRSTW
#define PG8_FIRSTW 8
#endif
#ifndef PG8_STAGGER
#define PG8_STAGGER 0
#endif
    if (PG8_STAGGER && nt == 4) {
        const unsigned long long t0 = __builtin_amdgcn_s_memrealtime(); const unsigned long long want = (unsigned long long)((blockIdx.x >> 3) & 3) * 340ull;
        while (__builtin_amdgcn_s_memrealtime() - t0 < want) __builtin_amdgcn_s_sleep(16);
    }
    f32x4 acc[2][2][4][2];
#pragma unroll
    for (int a = 0; a < 2; ++a)
#pragma unroll
        for (int b = 0; b < 2; ++b)
#pragma unroll
            for (int m = 0; m < 4; ++m)
#pragma unroll
                for (int n = 0; n < 2; ++n) acc[a][b][m][n] = (f32x4){0.f, 0.f, 0.f, 0.f};
    bf16x8 At[4][2], B0[2][2], B1[2][2];
    unsigned vAc[2][2], vAn[2][2];
    S.aoffs(cur, vAc);
    unsigned cA = cur.A, cB = cur.B;
    PG8_STGB(PG8_SB(0, 0), cB); PG8_STGB(PG8_SB(0, 1), cB + hstepB); PG8_STG(PG8_SA(0, 0), cA, vAc[0][0], vAc[0][1]); PG8_STG(PG8_SA(0, 1), cA, vAc[1][0], vAc[1][1]);
    if (wr == 1) PG8_BAR;
    PG8_WAIT_V(2); PG8_BAR;
    PG8_STGB(PG8_SB(1, 0), cB + kstep); PG8_STG(PG8_SA(1, 0), cA + kstep, vAc[0][0], vAc[0][1]); PG8_STGB(PG8_SB(1, 1), cB + hstepB + kstep);
    PG8_WAIT_V(0); PG8_BAR;
    for (;;) {
        const bool has_next = S.next(ui + 1, nxt);
        if constexpr (Sched::GATHER) {
            if (has_next) S.aoffs(nxt, vAn);
            else {
#pragma unroll
                for (int h = 0; h < 2; ++h)
#pragma unroll
                    for (int i = 0; i < 2; ++i) vAn[h][i] = vAc[h][i]; } }
        const unsigned nA = has_next ? nxt.A : cA, nB = has_next ? nxt.B : cB;
#define PG8_ITER(t, W1, W2, W3, W4) do { \
            const bool last = ((t) == nt - 2); \
            const unsigned a1 = cA + (unsigned)((t) + 1) * kstep; \
            const unsigned a2 = last ? nA : cA + (unsigned)((t) + 2) * kstep, b2 = last ? nB : cB + (unsigned)((t) + 2) * kstep; \
            const unsigned a3 = a2 + kstep, b3 = b2 + kstep; \
            unsigned w00 = vAc[0][0], w01 = vAc[0][1], w10 = vAc[1][0], w11 = vAc[1][1]; \
            if constexpr (Sched::GATHER) { w00 = last ? vAn[0][0] : w00; w01 = last ? vAn[0][1] : w01; w10 = last ? vAn[1][0] : w10; w11 = last ? vAn[1][1] : w11; } \
              \
            PG8_LDB(B0, 0, 0); PG8_LDB(B1, 0, 1); PG8_SCHED; PG8_LDA(At, 0, 0); PG8_STG(PG8_SA(1, 1), a1, vAc[1][0], vAc[1][1]); \
            PG8_WAIT_VN(W1); PG8_WAIT_L(0); PG8_BAR; PG8_MMA(0, 0, At, B0); PG8_MMA(0, 1, At, B1); PG8_BAR; PG8_SCHED; \
              \
            PG8_LDA(At, 0, 1); PG8_STGB(PG8_SB(0, 0), b2); PG8_STGB(PG8_SB(0, 1), b2 + hstepB); PG8_STG(PG8_SA(0, 0), a2, w00, w01); \
            PG8_WAIT_VN(W2); PG8_WAIT_L(0); PG8_BAR; PG8_MMA(1, 0, At, B0); PG8_MMA(1, 1, At, B1); PG8_BAR; PG8_SCHED; \
              \
            PG8_LDB(B0, 1, 0); PG8_LDB(B1, 1, 1); PG8_SCHED; PG8_LDA(At, 1, 0); PG8_STG(PG8_SA(0, 1), a2, w10, w11); \
            PG8_WAIT_VN(W3); PG8_WAIT_L(0); PG8_BAR; PG8_MMA(0, 0, At, B0); PG8_MMA(0, 1, At, B1); PG8_BAR; PG8_SCHED; \
              \
            PG8_LDA(At, 1, 1); PG8_STGB(PG8_SB(1, 0), b3); PG8_STGB(PG8_SB(1, 1), b3 + hstepB); PG8_STG(PG8_SA(1, 0), a3, w00, w01); \
            PG8_WAIT_VN(W4); PG8_WAIT_L(0); PG8_BAR; PG8_MMA(1, 0, At, B0); PG8_MMA(1, 1, At, B1); PG8_BAR; PG8_SCHED; } while (0)
        PG8_ITER(0, PG8_FIRSTW + 2 + Epi::NVM, PG8_FIRSTW + 6 + Epi::NVM, PG8_FIRSTW + 2 + Epi::NVM, PG8_FIRSTW + 6);
        for (int t = 2; t < nt; t += 2) PG8_ITER(t, 8 + PG8_SLK1, 8 + PG8_SLK2, 8 + PG8_SLK1, 8 + PG8_SLK2);
        if (wr == 0) PG8_BAR;
        { int t2 = threadIdx.x; asm volatile("" : "+v"(t2)); const int l2 = t2 & 63, w2 = __builtin_amdgcn_readfirstlane(t2 >> 6);
          E(acc, cur, w2 >> 2, w2 & 3, l2 & 15, l2 >> 4); }
        if (!has_next) break;
#pragma unroll
        for (int a = 0; a < 2; ++a)
#pragma unroll
            for (int b = 0; b < 2; ++b)
#pragma unroll
                for (int m = 0; m < 4; ++m)
#pragma unroll
                    for (int n = 0; n < 2; ++n) acc[a][b][m][n] = (f32x4){0.f, 0.f, 0.f, 0.f};
        cur = nxt; cA = nA; cB = nB; ++ui;
        if constexpr (Sched::GATHER) {
#pragma unroll
            for (int h = 0; h < 2; ++h)
#pragma unroll
                for (int i = 0; i < 2; ++i) vAc[h][i] = vAn[h][i]; }
        if (wr == 1) PG8_BAR;
    }
    PG8_WAIT_V(0);
    PG8_BAR;
#undef PG8_SA
#undef PG8_SB
#undef PG8_STG
#undef PG8_STGX
#undef PG8_STGB
#undef PG8_LDA
#undef PG8_LDB
#undef PG8_MMA
#undef PG8_WAIT_V
#undef PG8_WAIT_VN
#undef PG8_ITER
#undef PG8_WAIT_L
#undef PG8_BAR
#undef PG8_SCHED
}

struct DenseOrder {
    static constexpr bool GATHER = false; static constexpr int AUXA = 0;
    unsigned A, B; int lda, ldb, nM, nN, pn0, nwg, G, c, amul;
    __device__ __forceinline__ void init(size_t A_, int lda_, size_t B_, int ldb_, int nM_, int nN_, int pn0_, int G_, int c_) { A = (unsigned)A_; B = (unsigned)B_; lda = lda_; ldb = ldb_; nM = nM_; nN = nN_; pn0 = pn0_; nwg = nM * nN; G = G_; c = c_; amul = 1; }
    __device__ __forceinline__ bool next(int i, Unit& u) const {
        const long L = (long)i * G + c; if (L >= nwg) return false;
        int wgid = (int)L; { const int q = nwg / 8, r = nwg % 8, xcd = wgid % 8, off = wgid / 8; wgid = (xcd < r ? xcd * (q + 1) : r * (q + 1) + (xcd - r) * q) + off; }
        const int nig = 8 * nN, gid = wgid / nig, fm = gid * 8, gsz = (nM - fm) < 8 ? (nM - fm) : 8;
        u.pm = fm + ((wgid % nig) % gsz); u.pn = (wgid % nig) / gsz + pn0; u.aux = 0;
        u.A = A + (unsigned)(u.pm * amul) * 256u * lda * 2u; u.B = B + (unsigned)u.pn * 256u * ldb * 2u; return true;
    }
    __device__ __forceinline__ void aoffs(const Unit&, unsigned (&v)[2][2]) const {
        int tid = threadIdx.x; asm volatile("" : "+v"(tid));
#pragma unroll
        for (int i = 0; i < 2; ++i) { int R, C; stage_rc(tid * 16 + i * 8192, R, C);
#pragma unroll
            for (int h = 0; h < 2; ++h) v[h][i] = (unsigned)((h * 128 + R) * lda + C) * 2u; }
    }
};

struct EpiBf16 {
    static constexpr int NVM = 16;
    static constexpr bool WIDE = true;
    bf16_t* O; int ldc, coff; PG8_LAS unsigned char* stg0; const void* wsb;
    __device__ __forceinline__ void operator()(const f32x4 (&acc)[2][2][4][2], const Unit& u, int wr, int wc, int fr, int fq) const { const WsStore W_(wsb);
#ifndef EPI_DIRECT
#define EPI_DIRECT 0
#endif
        PG8_LAS unsigned char* stg = stg0 + (wr * 4 + wc) * 2048;
        const int lane = fr + 16 * fq, rr = lane >> 3, ch = lane & 7;
        const int row0 = u.pm * BM + wr * 64, col0 = coff + u.pn * BM + wc * 64 + ch * 8;
#pragma unroll
        for (int ai = 0; ai < 2; ++ai)
#pragma unroll
            for (int m = 0; m < 4; ++m) {
                if (EPI_DIRECT) {
#pragma unroll
                    for (int bj = 0; bj < 2; ++bj) W_.st(O + (size_t)(row0 + ai * HALF + m * 16 + fr) * ldc + coff + u.pn * BM + wc * 64 + bj * 32 + 8 * fq, pack8(acc[ai][bj][m][0], acc[ai][bj][m][1]));
                    continue; }
#pragma unroll
                for (int bj = 0; bj < 2; ++bj) *(PG8_LAS u32x4*)(stg + fr * 128 + (((bj * 4 + fq) ^ (fr & 7)) * 16)) = pack8(acc[ai][bj][m][0], acc[ai][bj][m][1]);
                asm volatile("s_waitcnt lgkmcnt(0)" ::: "memory");
                u32x4 w[2];
#pragma unroll
                for (int r = 0; r < 2; ++r) { const int row = 8 * r + rr; w[r] = *(const PG8_LAS u32x4*)(stg + row * 128 + ((ch ^ (row & 7)) * 16)); }
                asm volatile("s_waitcnt lgkmcnt(0)" ::: "memory");
#pragma unroll
                for (int r = 0; r < 2; ++r) W_.st(O + (size_t)(row0 + ai * HALF + m * 16 + 8 * r + rr) * ldc + col0, w[r]); }
    }
};
struct EpiFp8 {
    static constexpr bool WIDE = true; static constexpr int NVM = 8;
    unsigned char* O8; PG8_LAS unsigned char* stg0; const void* wsb;
    __device__ __forceinline__ void operator()(const f32x4 (&acc)[2][2][4][2], const Unit& u, int wr, int wc, int fr, int fq) const { const WsStore W_(wsb);
        typedef unsigned u32x2 __attribute__((ext_vector_type(2)));
        PG8_LAS unsigned char* stg = stg0 + (wr * 4 + wc) * 2048;
        const int lane = fr + 16 * fq, rr = lane >> 2, ch = lane & 3;
        const size_t row0 = (size_t)u.pm * BM + wr * 64; const int col0 = u.pn * BM + wc * 64 + ch * 16;
        float cl_hi = 432.f; asm volatile("" : "+v"(cl_hi));
#pragma unroll
        for (int ai = 0; ai < 2; ++ai)
#pragma unroll
            for (int m = 0; m < 4; ++m) {
#pragma unroll
                for (int bj = 0; bj < 2; ++bj) { u32x2 w; f32x4 v0 = acc[ai][bj][m][0], v1 = acc[ai][bj][m][1];
#pragma unroll
                    for (int j = 0; j < 4; ++j) { asm("v_med3_f32 %0, %1, %2, %3" : "=v"(v0[j]) : "v"(v0[j]), "s"(-432.f), "v"(cl_hi)); asm("v_med3_f32 %0, %1, %2, %3" : "=v"(v1[j]) : "v"(v1[j]), "s"(-432.f), "v"(cl_hi)); }
                    int p = 0; p = __builtin_amdgcn_cvt_pk_fp8_f32(v0[0], v0[1], p, false); p = __builtin_amdgcn_cvt_pk_fp8_f32(v0[2], v0[3], p, true); w.x = (unsigned)p;
                    p = 0; p = __builtin_amdgcn_cvt_pk_fp8_f32(v1[0], v1[1], p, false); p = __builtin_amdgcn_cvt_pk_fp8_f32(v1[2], v1[3], p, true); w.y = (unsigned)p;
                    *(PG8_LAS u32x2*)(stg + fr * 64 + (((bj * 4 + fq) ^ ((fr & 3) << 1)) * 8)) = w; }
                asm volatile("s_waitcnt lgkmcnt(0)" ::: "memory");
                const u32x4 w4 = *(const PG8_LAS u32x4*)(stg + rr * 64 + (((2 * ch) ^ ((rr & 3) << 1)) * 8));
                asm volatile("s_waitcnt lgkmcnt(0)" ::: "memory");
                if (FP8_ST_NT) W_.st_nt(O8 + (row0 + ai * HALF + m * 16 + rr) * 1024 + col0, w4); else W_.st(O8 + (row0 + ai * HALF + m * 16 + rr) * 1024 + col0, w4); }
    }
};
#ifdef UP_DRY
#define PG8_SWIGLU_NVM 0
#else
#define PG8_SWIGLU_NVM 8
#endif
__device__ __forceinline__ float sigm(float x) { return __builtin_amdgcn_rcpf(1.f + __builtin_amdgcn_exp2f(-1.4426950408889634f * x)); }
struct EpiSwiglu {
    static constexpr int NVM = PG8_SWIGLU_NVM;
    static constexpr bool WIDE = false;
    bf16_t* H; int ldh; const void* wsb; int dry = 0;
    __device__ __forceinline__ void operator()(const f32x4 (&acc)[2][2][4][2], const Unit& u, int wr, int wc, int fr, int fq) const { const WsStore W_(wsb);
        const int row0 = u.pm * BM + wr * 64 + fr, col0 = u.pn * HALF + wc * 32 + 8 * fq;
#pragma unroll
        for (int ai = 0; ai < 2; ++ai)
#pragma unroll
            for (int m = 0; m < 4; ++m) { f32x4 o[2];
#pragma unroll
                for (int n = 0; n < 2; ++n)
#pragma unroll
                    for (int j = 0; j < 4; ++j) { const float g = acc[ai][0][m][n][j]; o[n][j] = g * sigm(g) * acc[ai][1][m][n][j]; }
                const u32x4 w_ = pack8(o[0], o[1]); if (!dry || w_.x == 0x12345678u) { if (HID_ST_NT) W_.st_nt(H + (size_t)(row0 + ai * HALF + m * 16) * ldh + col0, w_); else W_.st(H + (size_t)(row0 + ai * HALF + m * 16) * ldh + col0, w_); } }
    }
};
struct EpiGlu {
    static constexpr int NVM = 8;
    static constexpr bool WIDE = false;
    bf16_t* AGLU; const void* wsb;
    __device__ __forceinline__ void operator()(const f32x4 (&acc)[2][2][4][2], const Unit& u, int wr, int wc, int fr, int fq) const { const WsStore W_(wsb);
        const int row0 = u.pm * BM + wr * 64 + fr, col0 = u.pn * HALF + wc * 32 + 8 * fq;
#pragma unroll
        for (int ai = 0; ai < 2; ++ai)
#pragma unroll
            for (int m = 0; m < 4; ++m) { f32x4 o[2];
#pragma unroll
                for (int n = 0; n < 2; ++n)
#pragma unroll
                    for (int j = 0; j < 4; ++j) o[n][j] = acc[ai][0][m][n][j] * sigm(acc[ai][1][m][n][j]);
                W_.st(AGLU + (size_t)(row0 + ai * HALF + m * 16) * 512 + col0, pack8(o[0], o[1])); }
    }
};
struct EpiFT {
    static constexpr int NVM = 8;
    static constexpr bool WIDE = false;
    bf16_t* FT; bf16_t* FTC;
    __device__ __forceinline__ void operator()(const f32x4 (&acc)[2][2][4][2], const Unit& u, int wr, int wc, int fr, int fq) const {
        const int rb = u.pm * BM; bf16_t* base; int L, l0;
        if (rb < TL) { base = FT + (size_t)(rb / SEQ) * 512 * SEQ; L = SEQ; l0 = rb % SEQ; } else { base = FTC + (size_t)((rb - TL) / CTXL) * 512 * CTXL; L = CTXL; l0 = 0; }
        const int ch0 = (u.pn - 4) * BM + wc * 32 + 8 * fq;
        bf16_t* lanep = base + (size_t)ch0 * L + l0 + wr * 64 + fr;
#pragma unroll
        for (int ai = 0; ai < 2; ++ai)
#pragma unroll
            for (int m = 0; m < 4; ++m)
#pragma unroll
                for (int bj = 0; bj < 2; ++bj)
#pragma unroll
                    for (int n = 0; n < 2; ++n) { const unsigned p0 = cvt_pk_bf16(acc[ai][bj][m][n][0], acc[ai][bj][m][n][1]), p1 = cvt_pk_bf16(acc[ai][bj][m][n][2], acc[ai][bj][m][n][3]);
                        PG8_GAS bf16_t* d = (PG8_GAS bf16_t*)(lanep + (size_t)(bj * HALF + 4 * n) * L + (ai * HALF + m * 16));
                        d[0] = (bf16_t)(p0 & 0xffffu); d[(size_t)L] = (bf16_t)(p0 >> 16); d[(size_t)2 * L] = (bf16_t)(p1 & 0xffffu); d[(size_t)3 * L] = (bf16_t)(p1 >> 16); }
    }
};
struct EpiGluFT {    static constexpr int NVM = 8;
    static constexpr bool WIDE = false;
    EpiGlu g; EpiFT f;
    __device__ __forceinline__ void operator()(const f32x4 (&acc)[2][2][4][2], const Unit& u, int wr, int wc, int fr, int fq) const { if (u.pn < 4) g(acc, u, wr, wc, fr, fq); else f(acc, u, wr, wc, fr, fq); }
};
template <int L> struct EpiDft {
    static constexpr int NVM = 16;
    static constexpr bool WIDE = false;
    bf16_t* FF; int tok0; const void* wsb; int pitch, cbase;
    __device__ __forceinline__ void operator()(const f32x4 (&acc)[2][2][4][2], const Unit& u, int wr, int wc, int fr, int fq) const { const WsStore W_(wsb);
        constexpr int H = L / 2;
        const size_t tokbase = (size_t)tok0 + (size_t)u.aux * L;
        const int c0 = wc * 32 + 8 * fq;
#pragma unroll
        for (int ai = 0; ai < 2; ++ai)
#pragma unroll
            for (int m = 0; m < 4; ++m) { const int r = u.pm * BM + ai * HALF + wr * 64 + m * 16 + fr; const int part = r > H ? 1 : 0, k = part ? r - H : r;
#pragma unroll
                for (int bj = 0; bj < 2; ++bj) { const int g = 2 * u.pn + bj; const f32x4 a0 = acc[ai][bj][m][0], a1 = acc[ai][bj][m][1];
                    const u32x4 pos = pack8(a0, a1);
                    bf16_t* d1 = FF + (tokbase + k) * pitch + cbase + g * 256 + part * 128 + c0; W_.st(d1, pos);
                    if (k != 0 && k != H) { bf16_t* d2 = FF + (tokbase + (L - k)) * pitch + cbase + g * 256 + part * 128 + c0; u32x4 w = pos; if (part) { w.x ^= 0x80008000u; w.y ^= 0x80008000u; w.z ^= 0x80008000u; w.w ^= 0x80008000u; } W_.st(d2, w); }
                    else if (!part) { bf16_t* d3 = FF + (tokbase + k) * pitch + cbase + g * 256 + 128 + c0; W_.st(d3, (u32x4){0u, 0u, 0u, 0u}); } } }
    }
};
template <bool W> struct EpiNull {
    static constexpr bool WIDE = W; static constexpr int NVM = 0;
    __device__ __forceinline__ void operator()(const f32x4 (&acc)[2][2][4][2], const Unit&, int, int, int, int) const {
#pragma unroll
        for (int a = 0; a < 2; ++a)
#pragma unroll
            for (int b = 0; b < 2; ++b)
#pragma unroll
                for (int m = 0; m < 4; ++m)
#pragma unroll
                    for (int n = 0; n < 2; ++n) asm volatile("" ::"v"(acc[a][b][m][n]));
    }
};
constexpr float QSCALE = 0.125f * 1.4426950408889634f;
struct EpiQkv {
    static constexpr int NVM = 16;
    static constexpr bool WIDE = true;
    bf16_t* Q; bf16_t* KA; bf16_t* VA; const unsigned* rt; int is_ctx; const void* wsb; PG8_LAS unsigned char* stg0; unsigned* kmaxp;
    __device__ __forceinline__ void operator()(const f32x4 (&acc)[2][2][4][2], const Unit& u, int wr, int wc, int fr, int fq) const { const WsStore W_(wsb);
        const int kind = u.pn >> 2, pt = u.pn & 3;
        const int rb = u.pm * BM;
        const int b = is_ctx ? rb / CTXL : rb / SEQ, s0 = is_ctx ? 0 : rb % SEQ;
        const size_t kvrow0 = (size_t)b * LKV + (is_ctx ? 0 : CTXL) + s0;
        const int lr0 = wr * 64 + fr;
        PG8_LAS unsigned char* stg = stg0 + (wr * 4 + wc) * 2048;
        const int lane = fr + 16 * fq, rr = lane >> 3, ch = lane & 7;
        bf16_t* dbase = (kind == 0 ? Q + (size_t)rb * 1024 : (kind == 1 ? KA : VA) + kvrow0 * 1024) + (size_t)(wr * 64 + rr) * 1024 + pt * BM + wc * 64 + ch * 8;
        const bool rot = kind != 2 && !is_ctx;
        const float sc = kind == 0 ? QSCALE : 1.f;
        float k2max = 0.f;
        u32x4 tb[2][4][2];
        if (rot) {
#pragma unroll
            for (int ai = 0; ai < 2; ++ai)
#pragma unroll
                for (int m = 0; m < 4; ++m) { const PG8_GAS u32x4* p = (const PG8_GAS u32x4*)(rt + (size_t)(s0 + lr0 + ai * HALF + m * 16) * 32 + 8 * fq); tb[ai][m][0] = p[0]; tb[ai][m][1] = p[1]; }
        }
#pragma unroll
        for (int ai = 0; ai < 2; ++ai)
#pragma unroll
            for (int m = 0; m < 4; ++m) {
                f32x4 o1[2], o2[2];
                if (rot) {
#pragma unroll
                    for (int n = 0; n < 2; ++n) { const f32x4 x1 = acc[ai][0][m][n], x2 = acc[ai][1][m][n]; f32x4 cv, sv;
#pragma unroll
                        for (int j = 0; j < 4; ++j) { const unsigned w = tb[ai][m][n][j]; cv[j] = __builtin_bit_cast(float, w << 16); sv[j] = __builtin_bit_cast(float, w & 0xffff0000u); }
                        o1[n] = (x1 * cv - x2 * sv) * sc; o2[n] = (x2 * cv + x1 * sv) * sc; }
                } else { o1[0] = acc[ai][0][m][0]; o1[1] = acc[ai][0][m][1]; o2[0] = acc[ai][1][m][0]; o2[1] = acc[ai][1][m][1]; }
                if (kind == 1) { float ss = 0.f;
#pragma unroll
                    for (int n = 0; n < 2; ++n)
#pragma unroll
                        for (int j = 0; j < 4; ++j) ss = __builtin_fmaf(o1[n][j], o1[n][j], __builtin_fmaf(o2[n][j], o2[n][j], ss));
                    ss += __shfl_xor(ss, 16); ss += __shfl_xor(ss, 32); k2max = __builtin_fmaxf(k2max, ss); }
                *(PG8_LAS u32x4*)(stg + fr * 128 + ((fq ^ (fr & 7)) * 16)) = pack8(o1[0], o1[1]);
                *(PG8_LAS u32x4*)(stg + fr * 128 + (((4 + fq) ^ (fr & 7)) * 16)) = pack8(o2[0], o2[1]);
                asm volatile("s_waitcnt lgkmcnt(0)" ::: "memory");
                u32x4 w[2];
#pragma unroll
                for (int r = 0; r < 2; ++r) { const int row = 8 * r + rr; w[r] = *(const PG8_LAS u32x4*)(stg + row * 128 + ((ch ^ (row & 7)) * 16)); }
                asm volatile("s_waitcnt lgkmcnt(0)" ::: "memory");
#pragma unroll
                for (int r = 0; r < 2; ++r) W_.st(dbase + (size_t)(ai * HALF + m * 16 + 8 * r) * 1024, w[r]); }
        if (kind == 1) {
#pragma unroll
            for (int off = 1; off < 16; off <<= 1) k2max = __builtin_fmaxf(k2max, __shfl_xor(k2max, off));
            if (lane == 0) __hip_atomic_fetch_max(kmaxp + (b * 8 + pt * 2 + (wc >> 1)) * 2 + (wc & 1), __builtin_bit_cast(unsigned, __builtin_sqrtf(k2max)), __ATOMIC_RELAXED, __HIP_MEMORY_SCOPE_AGENT); }
    }
};
}

namespace attn_body {
using bf16=__hip_bfloat16;
using bf16x8=__attribute__((ext_vector_type(8)))short;
using s16x4=__attribute__((ext_vector_type(4)))short;
using f32x16=__attribute__((ext_vector_type(16)))float;
using u32x4=__attribute__((ext_vector_type(4)))unsigned;
constexpr int D=64,DM=1024,DMO=2048;
constexpr int NW=8,QBLK=32,QB=QBLK*NW,KVBLK=64;
constexpr int ATTN_PITCH=DM, ATTN_UNIT_ROWS=QB;
__device__ __forceinline__ int crow(int r,int hi){return (r&3)+8*(r>>2)+4*hi;}
#define SBAR() __builtin_amdgcn_sched_barrier(0)

constexpr int NSLOT=3, SLOTB=8192;
constexpr int LDS_K=0, LDS_V=NSLOT*SLOTB, LDS_WS=LDS_V+NSLOT*2*SLOTB, LDS_OST=LDS_WS+NW*64*4, LDS_BYTES=LDS_OST+NW*4096;
constexpr float C2=0.125f*1.4426950408889634f;
__device__ __forceinline__ void glds16(const void*gsrc,unsigned lds_dst){unsigned keep;
  asm volatile("s_mov_b32 %0, m0\n\ts_mov_b32 m0, %2\n\ts_nop 0\n\tglobal_load_lds_dwordx4 %1, off\n\ts_mov_b32 m0, %0":"=&s"(keep):"v"(gsrc),"s"(lds_dst):"memory");}
__device__ __forceinline__ void glds16s(const void*sbase,unsigned voff,unsigned lds_dst){unsigned keep;
  asm volatile("s_mov_b32 %0, m0\n\ts_mov_b32 m0, %3\n\ts_nop 0\n\tglobal_load_lds_dwordx4 %1, %2\n\ts_mov_b32 m0, %0":"=&s"(keep):"v"(voff),"s"(sbase),"s"(lds_dst):"memory");}
__device__ __forceinline__ float max3f(float a,float b,float c){float r;asm("v_max3_f32 %0, %1, %2, %3":"=v"(r):"v"(a),"v"(b),"v"(c));return r;}
__device__ __forceinline__ float max2f(float a,float b){float r;asm("v_max_f32_e32 %0, %1, %2":"=v"(r):"v"(a),"v"(b));return r;}
__device__ __forceinline__ float fadd_s(float a,float b){float r;asm("v_add_f32_e32 %0, %1, %2":"=v"(r):"v"(a),"v"(b));return r;}
__device__ __forceinline__ float fsub_s(float a,float b){float r;asm("v_sub_f32_e32 %0, %1, %2":"=v"(r):"v"(a),"v"(b));return r;}
typedef float f32x2_t __attribute__((ext_vector_type(2))); typedef __bf16 bf16x2_t __attribute__((ext_vector_type(2)));
__device__ __forceinline__ unsigned cvtpk_s(float lo,float hi){f32x2_t v={lo,hi};bf16x2_t b=__builtin_convertvector(v,bf16x2_t);return __builtin_bit_cast(unsigned,b);}
#define WAIT_BAR(N) asm volatile("s_waitcnt vmcnt(" #N ") lgkmcnt(0)\n\ts_barrier":::"memory")

__device__ __forceinline__ void qkt(f32x16&p0,f32x16&p1,const char*Kslot,const bf16x8*qr,const f32x16&negm,int r32,int hi){
  const char*kb=Kslot+hi*1024+r32*16;
  #pragma unroll
  for(int d0=0;d0<4;++d0){
    const bf16x8 b0=*reinterpret_cast<const bf16x8*>(kb+d0*2048);
    const bf16x8 b1=*reinterpret_cast<const bf16x8*>(kb+d0*2048+512);
    if(d0==0){p0=__builtin_amdgcn_mfma_f32_32x32x16_bf16(b0,qr[0],negm,0,0,0);p1=__builtin_amdgcn_mfma_f32_32x32x16_bf16(b1,qr[0],negm,0,0,0);}
    else{p0=__builtin_amdgcn_mfma_f32_32x32x16_bf16(b0,qr[d0],p0,0,0,0);p1=__builtin_amdgcn_mfma_f32_32x32x16_bf16(b1,qr[d0],p1,0,0,0);}}
}
typedef __attribute__((address_space(3))) const char* lds_cptr;
typedef short v4i16_t __attribute__((ext_vector_type(4)));
__device__ __forceinline__ void kload8(bf16x8*kf,lds_cptr kp){
  kf[0]=*(const __attribute__((address_space(3))) bf16x8*)(kp);      kf[1]=*(const __attribute__((address_space(3))) bf16x8*)(kp+512);
  kf[2]=*(const __attribute__((address_space(3))) bf16x8*)(kp+2048); kf[3]=*(const __attribute__((address_space(3))) bf16x8*)(kp+2560);
  kf[4]=*(const __attribute__((address_space(3))) bf16x8*)(kp+4096); kf[5]=*(const __attribute__((address_space(3))) bf16x8*)(kp+4608);
  kf[6]=*(const __attribute__((address_space(3))) bf16x8*)(kp+6144); kf[7]=*(const __attribute__((address_space(3))) bf16x8*)(kp+6656);
}
__device__ __forceinline__ void kload2(bf16x8*kf,lds_cptr kp,int j){ kf[2*j]=*(const __attribute__((address_space(3))) bf16x8*)(kp+j*2048); kf[2*j+1]=*(const __attribute__((address_space(3))) bf16x8*)(kp+j*2048+512); }
__device__ __forceinline__ s16x4 vtr(lds_cptr p){ return __builtin_bit_cast(s16x4,__builtin_amdgcn_ds_read_tr16_b64_v4i16((__attribute__((address_space(3))) v4i16_t*)p)); }
__device__ __forceinline__ float rowmax(const f32x16&p0,const f32x16&p1){
  float a=max3f(p0[0],p0[1],p1[0]),b=max3f(p0[2],p0[3],p1[1]);a=max3f(a,p1[2],p1[3]);
  #pragma unroll
  for(int r=4;r<16;r+=4){a=max3f(a,p0[r],p0[r+1]);b=max3f(b,p0[r+2],p0[r+3]);a=max3f(a,p1[r],p1[r+1]);b=max3f(b,p1[r+2],p1[r+3]);}
  const float m=max2f(a,b);
  auto rr=__builtin_amdgcn_permlane32_swap(__float_as_uint(m),__float_as_uint(m),false,false);
  return max2f(__uint_as_float(rr[0]),__uint_as_float(rr[1]));
}
__device__ __forceinline__ void pv(f32x16*o,int vb,bf16x8 pa0,bf16x8 pa1,bf16x8 pa2,bf16x8 pa3){
  #pragma unroll
  for(int d0=0;d0<4;++d0){s16x4 lo[4],hi[4];
    #pragma unroll
    for(int ks=0;ks<4;++ks){
      asm volatile("ds_read_b64_tr_b16 %0,%1 offset:%c2":"=&v"(lo[ks]):"v"(vb),"i"(d0*4096+ks*1024):"memory");
      asm volatile("ds_read_b64_tr_b16 %0,%1 offset:%c2":"=&v"(hi[ks]):"v"(vb),"i"(d0*4096+ks*1024+512):"memory");}
    asm volatile("s_waitcnt lgkmcnt(0)":::"memory");SBAR();
    #define PK(k) (bf16x8){lo[k][0],lo[k][1],lo[k][2],lo[k][3],hi[k][0],hi[k][1],hi[k][2],hi[k][3]}
    o[d0]=__builtin_amdgcn_mfma_f32_32x32x16_bf16(pa0,PK(0),o[d0],0,0,0);
    o[d0]=__builtin_amdgcn_mfma_f32_32x32x16_bf16(pa1,PK(1),o[d0],0,0,0);
    o[d0]=__builtin_amdgcn_mfma_f32_32x32x16_bf16(pa2,PK(2),o[d0],0,0,0);
    o[d0]=__builtin_amdgcn_mfma_f32_32x32x16_bf16(pa3,PK(3),o[d0],0,0,0);
    #undef PK
  }
}

#ifndef ATTN_STORE16
#define ATTN_STORE16(p,v) (*(__attribute__((address_space(1))) u32x4*)(p)=(v))
#endif
template<int THRL> __device__ __forceinline__ void attn_unit(const bf16*Qu,const bf16*__restrict__ Kh,const bf16*__restrict__ Vh,bf16*Ou,const int NT,char*shm,const float kmax){
  const int tid=threadIdx.x,lane=tid&63,r32=lane&31,hi=lane>>5; const int wid=__builtin_amdgcn_readfirstlane(tid>>6);
  const bf16*Qw=Qu+(long)(wid*QBLK)*DM;
  const unsigned lds0=(unsigned)(uintptr_t)shm;
  float*wsf=(float*)(shm+LDS_WS)+wid*64;
  const unsigned kvo=(unsigned)((lane*DM+wid*8)*2);
  const unsigned vvo=(unsigned)(((16*(wid&3)+(lane>>2))*DM+(wid>>2)*32+(lane&3)*8)*2);
  const unsigned kdst=lds0+LDS_K+wid*1024, vdst=lds0+LDS_V+wid*1024;
  #define DMA_K(t,slot) glds16s(Kh+(long)(t)*KVBLK*DM,kvo,(unsigned)__builtin_amdgcn_readfirstlane(kdst+(slot)))
  #define DMA_V(t,slot) do{ glds16s(Vh+(long)(t)*KVBLK*DM,vvo,(unsigned)__builtin_amdgcn_readfirstlane(vdst+2*(slot))); glds16s(Vh+64+(long)(t)*KVBLK*DM,vvo,(unsigned)__builtin_amdgcn_readfirstlane(vdst+8192+2*(slot))); }while(0)
  const int vb0=(int)(lds0+LDS_V)+((lane>>4)&1)*32+(lane&3)*8+(4*hi+((lane&15)>>2))*64;
  const char*Kbase=shm+LDS_K; bf16x8 kf[8];
  const lds_cptr shm3=(lds_cptr)shm; const lds_cptr kp0=shm3+LDS_K+hi*1024+r32*16; const lds_cptr vp0=shm3+LDS_V+((lane>>4)&1)*32+(lane&3)*8+(4*hi+((lane&15)>>2))*64;
  DMA_K(0,0);DMA_V(0,0);DMA_K(1,SLOTB);
  bf16x8 qr[4];
  #pragma unroll
  for(int d0=0;d0<4;++d0)qr[d0]=*(const __attribute__((address_space(1))) bf16x8*)(&Qw[(long)r32*DM+d0*16+hi*8]);
  float l_reg=0.f;f32x16 o[4];o[0]=f32x16{};o[1]=f32x16{};o[2]=f32x16{};o[3]=f32x16{};f32x16 negm;
  #define CMASK(P0,P1,t) do{}while(0)
  #define START(P0,P1) do{ _Pragma("unroll") for(int r=0;r<16;++r)P0[r]=__builtin_amdgcn_exp2f(P0[r]); }while(0)
  #define RESC() do{}while(0)
  f32x16 pA0,pA1,pB0,pB1;
  int sl_prev=0,sl_cur=0,sl_next=SLOTB;
  #define ROT() do{sl_prev=sl_cur;sl_cur=sl_next;sl_next=(sl_next==(NSLOT-1)*SLOTB)?0:sl_next+SLOTB;}while(0)
  DMA_K(2,2*SLOTB);
  WAIT_BAR(4);
  { float q2=0.f;
    #pragma unroll
    for(int d0=0;d0<4;++d0){
      #pragma unroll
      for(int e=0;e<8;++e){ const float qv=__builtin_bit_cast(float,((unsigned)(unsigned short)qr[d0][e])<<16); q2=__builtin_fmaf(qv,qv,q2);} }
    auto rq=__builtin_amdgcn_permlane32_swap(__float_as_uint(q2),__float_as_uint(q2),false,false); q2=__uint_as_float(rq[0])+__uint_as_float(rq[1]);
    const float bound=__builtin_sqrtf(q2)*kmax*1.02f+1e-6f;
    #pragma unroll
    for(int r=0;r<16;++r)negm[r]=-bound; asm volatile("":"+v"(negm)); }
  qkt(pA0,pA1,Kbase,qr,negm,r32,hi);asm volatile("s_nop 15\n\ts_nop 7":"+v"(pA0),"+v"(pA1));CMASK(pA0,pA1,0);
  START(pA0,pA1);
  _Pragma("unroll") for(int r=0;r<16;++r)pA1[r]=__builtin_amdgcn_exp2f(pA1[r]);
  WAIT_BAR(0);
  DMA_K(3,0);DMA_V(1,SLOTB);
  ROT();
  kload8(kf,kp0+sl_cur);
  WAIT_BAR(3);
  s16x4 vlo[8],vhi[8]; u32x4 pw0,pw1,pw2,pw3;
  #define PKW(P,B) cvtpk_s(P[B],P[B+1])
  #define PAF(k) __builtin_bit_cast(bf16x8,pw##k)
  #define VFR(i) (bf16x8){vlo[i][0],vlo[i][1],vlo[i][2],vlo[i][3],vhi[i][0],vhi[i][1],vhi[i][2],vhi[i][3]}
  #define PIN(x) asm volatile("":"+v"(x))
  #define MX3(a,b,c) __builtin_fmaxf(__builtin_fmaxf((a),(b)),(c))
  #define GAPA(MF,A0,A1,A2,A3,W0,W1,PW) do{ MF; sa0=fadd_s(sa0,A0); sa1=fadd_s(sa1,A1); sa0=fadd_s(sa0,A2); sa1=fadd_s(sa1,A3); PIN(sa0); PIN(sa1); W0; W1; PIN(PW); SBAR(); }while(0)
  #define EX(v) __builtin_amdgcn_exp2f(v)
  #define GAPB(MF,RL,X,B) do{ MF; RL; X[B]=EX(X[B]); X[B+1]=EX(X[B+1]); PIN(X); SBAR(); }while(0)
  #define VRD(d,k) do{ vlo[(d)*2+((k)&1)]=vtr(vp_+((d)*4096+(k)*1024)); vhi[(d)*2+((k)&1)]=vtr(vp_+((d)*4096+(k)*1024+512)); }while(0)
  #define VS(d,k) VFR((d)*2+((k)&1))
  #define KRD(G,j) do{ if(G){ kload2(kf,kp0+sl_next,j); SBAR(); } }while(0)
  #define STEP(C0,C1,P0,P1,t,GK,GV,GL) do{ SBAR(); \
    const lds_cptr vp_=vp0+2*sl_prev; \
    VRD(0,0); SBAR(); float sa0=P0[0],sa1=P0[1]; \
    GAPA(C0=__builtin_amdgcn_mfma_f32_32x32x16_bf16(kf[0],qr[0],negm,0,0,0), P0[2],P0[3],P0[4],P0[5],     pw0[0]=PKW(P0,0), pw0[1]=PKW(P0,2), pw0); \
    VRD(1,0); SBAR(); GAPA(C1=__builtin_amdgcn_mfma_f32_32x32x16_bf16(kf[1],qr[0],negm,0,0,0), P0[6],P0[7],P0[8],P0[9],     pw0[2]=PKW(P0,4), pw0[3]=PKW(P0,6), pw0); \
    VRD(2,0); SBAR(); GAPA(C0=__builtin_amdgcn_mfma_f32_32x32x16_bf16(kf[2],qr[1],C0,0,0,0),   P0[10],P0[11],P0[12],P0[13], pw1[0]=PKW(P0,8), pw1[1]=PKW(P0,10), pw1); \
    VRD(3,0); SBAR(); GAPA(C1=__builtin_amdgcn_mfma_f32_32x32x16_bf16(kf[3],qr[1],C1,0,0,0),   P0[14],P0[15],P1[0],P1[1],   pw1[2]=PKW(P0,12),pw1[3]=PKW(P0,14), pw1); \
    VRD(0,1); SBAR(); GAPA(C0=__builtin_amdgcn_mfma_f32_32x32x16_bf16(kf[4],qr[2],C0,0,0,0),   P1[2],P1[3],P1[4],P1[5],     pw2[0]=PKW(P1,0), pw2[1]=PKW(P1,2), pw2); \
    VRD(1,1); SBAR(); GAPA(C1=__builtin_amdgcn_mfma_f32_32x32x16_bf16(kf[5],qr[2],C1,0,0,0),   P1[6],P1[7],P1[8],P1[9],     pw2[2]=PKW(P1,4), pw2[3]=PKW(P1,6), pw2); \
    VRD(2,1); SBAR(); GAPA(C0=__builtin_amdgcn_mfma_f32_32x32x16_bf16(kf[6],qr[3],C0,0,0,0),   P1[10],P1[11],P1[12],P1[13], pw3[0]=PKW(P1,8), pw3[1]=PKW(P1,10), pw3); \
    VRD(3,1); SBAR(); GAPA(C1=__builtin_amdgcn_mfma_f32_32x32x16_bf16(kf[7],qr[3],C1,0,0,0),   P1[14],P1[15],0.f,0.f,       pw3[2]=PKW(P1,12),pw3[3]=PKW(P1,14), pw3); \
    l_reg+=(sa0+sa1); \
    if(GK){DMA_K((t)+3,sl_cur);} if(GV){DMA_V((t)+1,sl_next);} \
    CMASK(C0,C1,t); \
    SBAR(); \
    GAPB(o[0]=__builtin_amdgcn_mfma_f32_32x32x16_bf16(PAF(0),VS(0,0),o[0],0,0,0), VRD(0,2), C0,0); \
    GAPB(o[1]=__builtin_amdgcn_mfma_f32_32x32x16_bf16(PAF(0),VS(1,0),o[1],0,0,0), VRD(1,2), C0,2); \
    GAPB(o[2]=__builtin_amdgcn_mfma_f32_32x32x16_bf16(PAF(0),VS(2,0),o[2],0,0,0), VRD(2,2), C0,4); \
    GAPB(o[3]=__builtin_amdgcn_mfma_f32_32x32x16_bf16(PAF(0),VS(3,0),o[3],0,0,0), VRD(3,2), C0,6); \
    KRD(GL,0); GAPB(o[0]=__builtin_amdgcn_mfma_f32_32x32x16_bf16(PAF(1),VS(0,1),o[0],0,0,0), VRD(0,3), C0,8); \
    GAPB(o[1]=__builtin_amdgcn_mfma_f32_32x32x16_bf16(PAF(1),VS(1,1),o[1],0,0,0), VRD(1,3), C0,10); \
    KRD(GL,1); GAPB(o[2]=__builtin_amdgcn_mfma_f32_32x32x16_bf16(PAF(1),VS(2,1),o[2],0,0,0), VRD(2,3), C0,12); \
    GAPB(o[3]=__builtin_amdgcn_mfma_f32_32x32x16_bf16(PAF(1),VS(3,1),o[3],0,0,0), VRD(3,3), C0,14); \
    KRD(GL,2); GAPB(o[0]=__builtin_amdgcn_mfma_f32_32x32x16_bf16(PAF(2),VS(0,2),o[0],0,0,0), , C1,0); \
    GAPB(o[1]=__builtin_amdgcn_mfma_f32_32x32x16_bf16(PAF(2),VS(1,2),o[1],0,0,0), , C1,2); \
    KRD(GL,3); GAPB(o[2]=__builtin_amdgcn_mfma_f32_32x32x16_bf16(PAF(2),VS(2,2),o[2],0,0,0), , C1,4); \
    GAPB(o[3]=__builtin_amdgcn_mfma_f32_32x32x16_bf16(PAF(2),VS(3,2),o[3],0,0,0), , C1,6); \
    GAPB(o[0]=__builtin_amdgcn_mfma_f32_32x32x16_bf16(PAF(3),VS(0,3),o[0],0,0,0), , C1,8); \
    GAPB(o[1]=__builtin_amdgcn_mfma_f32_32x32x16_bf16(PAF(3),VS(1,3),o[1],0,0,0), , C1,10); \
    GAPB(o[2]=__builtin_amdgcn_mfma_f32_32x32x16_bf16(PAF(3),VS(2,3),o[2],0,0,0), , C1,12); \
    GAPB(o[3]=__builtin_amdgcn_mfma_f32_32x32x16_bf16(PAF(3),VS(3,3),o[3],0,0,0), , C1,14); \
    }while(0)
  int t=1;
  for(;t+5<NT;t+=2){
    STEP(pB0,pB1,pA0,pA1,t,true,true,true);     WAIT_BAR(3); RESC(); ROT();
    STEP(pA0,pA1,pB0,pB1,t+1,true,true,true);   WAIT_BAR(3); RESC(); ROT();
  }
  #define ENDW(tt) do{ if((tt)+3<NT){WAIT_BAR(3);} else if((tt)+2<NT){WAIT_BAR(2);} else {WAIT_BAR(0);} }while(0)
  for(;t+1<NT;t+=2){
    STEP(pB0,pB1,pA0,pA1,t,(t+3<NT),(t+1<NT),(t+1<NT));       ENDW(t);   RESC(); ROT();
    STEP(pA0,pA1,pB0,pB1,t+1,(t+4<NT),(t+2<NT),(t+2<NT));     ENDW(t+1); RESC(); ROT();
  }
  STEP(pB0,pB1,pA0,pA1,NT-1,false,false,false); RESC();
  { float sacc=pB0[0]+pB0[1]; _Pragma("unroll") for(int r=2;r<16;++r)sacc+=pB0[r]; _Pragma("unroll") for(int r=0;r<16;++r)sacc+=pB1[r]; l_reg+=sacc;
    pw0=(u32x4){PKW(pB0,0),PKW(pB0,2),PKW(pB0,4),PKW(pB0,6)};pw1=(u32x4){PKW(pB0,8),PKW(pB0,10),PKW(pB0,12),PKW(pB0,14)};pw2=(u32x4){PKW(pB1,0),PKW(pB1,2),PKW(pB1,4),PKW(pB1,6)};pw3=(u32x4){PKW(pB1,8),PKW(pB1,10),PKW(pB1,12),PKW(pB1,14)};
    SBAR(); pv(o,vb0+2*sl_cur,PAF(0),PAF(1),PAF(2),PAF(3)); }
  #undef PKW
  #undef PAF
  #undef VFR
  #undef PIN
  #undef MX3
  #undef GAPA
  #undef GAPB
  #undef EX
  #undef VRD
  #undef VS
  #undef KRD
  #undef STEP
  #undef ENDW
  {auto rr=__builtin_amdgcn_permlane32_swap(__float_as_uint(l_reg),__float_as_uint(l_reg),false,false);l_reg=__uint_as_float(rr[0])+__uint_as_float(rr[1]);}
  if(hi==0)wsf[32+r32]=l_reg;asm volatile("s_waitcnt lgkmcnt(0)":::"memory");
  float rli[16];
  #pragma unroll
  for(int r=0;r<16;++r)rli[r]=__builtin_amdgcn_rcpf(__builtin_fmaxf(wsf[32+crow(r,hi)],1e-30f));
  bf16*Ow=Ou+(long)(wid*QBLK)*DMO;
  #pragma unroll
  for(int hf=0;hf<2;++hf){ bf16*stg=(bf16*)(shm+LDS_OST)+wid*2048;
    #pragma unroll
    for(int r=0;r<16;++r){const int orow=crow(r,hi);
      #pragma unroll
      for(int d0=0;d0<2;++d0)stg[orow*64+d0*32+r32]=__float2bfloat16(o[2*hf+d0][r]*rli[r]);}
    asm volatile("s_waitcnt lgkmcnt(0)":::"memory");
    #pragma unroll
    for(int i=0;i<4;++i){const int row=i*8+(lane>>3),ch=lane&7; const u32x4 v=*(const u32x4*)(stg+row*64+ch*8); ATTN_STORE16(Ow+(long)row*DMO+hf*64+ch*8,v);}
    asm volatile("s_waitcnt lgkmcnt(0)":::"memory"); }
  asm volatile("s_waitcnt lgkmcnt(0)\n\ts_barrier":::"memory");
  #undef DMA_K
  #undef DMA_V
  #undef CMASK
  #undef START
  #undef RESC
  #undef ROT
}
constexpr int ATTN_LDS_BYTES=LDS_BYTES;
#undef SBAR
#undef WAIT_BAR
}

constexpr int NWAVES = 8;
#ifndef DBG_LAST_PHASE
#define DBG_LAST_PHASE 99
#endif
constexpr int NMOE = 2 + 3 * NCH;
constexpr int PB0 = 5, PH_QKV = PB0 + NMOE, PH_ATT = PH_QKV + 1, PH_CMB = PH_QKV + 2, PH_OPR = PH_QKV + 3, PB1 = PH_QKV + 4, NPHASES = PB1 + NMOE;

#ifndef CVT0_LATE
#define CVT0_LATE 0
#endif
constexpr size_t MiB = 1u << 20;
constexpr size_t WS_CTL = 0, CTL_ZERO_BYTES = 1 * MiB;
constexpr size_t WS_MOD = 1 * MiB;
constexpr size_t WS_ROPE = 2 * MiB;
constexpr size_t WS_WIN = 3 * MiB;
constexpr size_t WS_W2 = 6 * MiB;
constexpr size_t WS_WQKV = 9 * MiB;
constexpr size_t WS_WDAO = 15 * MiB;
constexpr size_t WS_SHUP = 17 * MiB;
constexpr size_t WS_SHDN = 19 * MiB;
constexpr size_t WS_WRT = 20 * MiB;
constexpr size_t WS_TABC = 20 * MiB + 512 * 1024;
constexpr size_t WS_LIST = 21 * MiB;
constexpr size_t WS_TOKSLOT = 29 * MiB + 512 * 1024;
constexpr size_t WS_TOKGATE = 30 * MiB + 768 * 1024;
constexpr size_t WS_CTXRES = 32 * MiB;
constexpr size_t WS_WEDN = 40 * MiB;
constexpr size_t WS_WEUP = 72 * MiB;
constexpr size_t WS_HX = 136 * MiB;
constexpr size_t WS_HID = 204 * MiB;
constexpr size_t WS_YEXP = 332 * MiB;
constexpr size_t WS_END = 586 * MiB;
constexpr size_t WS_TAB = 204 * MiB;
constexpr size_t WS_AGLU = 236 * MiB;
constexpr size_t WS_FT = 272 * MiB;
constexpr size_t WS_FTC = 304 * MiB;
constexpr size_t WS_XA = 306 * MiB;
constexpr size_t WS_YPART = 410 * MiB;
constexpr size_t WS_Y = 442 * MiB;
constexpr size_t WS_TOKLO = 332 * MiB;
constexpr size_t WS_Q = 204 * MiB;
constexpr size_t WS_OC = 272 * MiB;
constexpr size_t WS_KALL = 400 * MiB;
constexpr size_t WS_VALL = 468 * MiB;
constexpr size_t WS_Y1 = 400 * MiB;
static_assert(WS_HID + (size_t)(7 * T0 + 64 * 255 * NCH) / NCH * 512 <= WS_YEXP && WS_YEXP + (size_t)(7 * T0 + 64 * 255 * NCH) / NCH * 1024 <= WS_END, "MoE buffers");
static_assert(WS_LIST + (size_t)NCH * 64 * CAP * 4 <= WS_TOKSLOT && WS_TOKSLOT + (size_t)T0 * 32 <= WS_TOKGATE && WS_TOKGATE + (size_t)T0 * 32 <= WS_CTXRES, "lists");
constexpr int CW_TMO = 0, CW_CODE = 1, CW_BAR = 4096, CW_CNT = 16384, CNT_STRIDE = 64, CW_KMAX = 65536;

constexpr int RING_OFF = 0, RING_BYTES = 131072;
constexpr int LDSCTL_OFF = RING_BYTES, MISC_OFF = LDSCTL_OFF + 320, INPTR_OFF = LDSCTL_OFF + 512, TBL_OFF = LDSCTL_OFF + 1024;
constexpr int STAGE_OFF = 139264;
constexpr int LDS_BYTES = 155648;

#define GAS __attribute__((address_space(1)))
#define LAS __attribute__((address_space(3)))
typedef unsigned short bf16;
typedef unsigned v4u __attribute__((ext_vector_type(4)));
typedef unsigned v2u __attribute__((ext_vector_type(2)));
typedef float f32x4 __attribute__((ext_vector_type(4)));
typedef short bf16x8 __attribute__((ext_vector_type(8)));
typedef GAS unsigned gu32;
#define RLX_AGENT __ATOMIC_RELAXED, __HIP_MEMORY_SCOPE_AGENT
#define LDS_WAIT() asm volatile("s_waitcnt lgkmcnt(0)" ::: "memory")
#define VM_WAIT() asm volatile("s_waitcnt vmcnt(0)" ::: "memory")
__device__ __forceinline__ unsigned f2bf(float f) { unsigned u = __builtin_bit_cast(unsigned, f); return (u + 0x7fffu + ((u >> 16) & 1u)) >> 16; }
__device__ __forceinline__ float bf2f(unsigned b) { return __builtin_bit_cast(float, b << 16); }
__device__ __forceinline__ unsigned pk2(float lo, float hi) { return f2bf(lo) | (f2bf(hi) << 16); }

#define XB_TMO      128
#define XB_XCNT(j)  (256  + 64 * (j))
#define XB_XSUB(j)  (1280 + 64 * (j))
#define XB_XGEN(j)  (2304 + 64 * (j))
#define XB_TOP      3328
#define XB_TOPGEN   3392
#define XCD_BAR_WORDS 3456
#define XB_SPIN_CAP (1u << 18)

__device__ __forceinline__ unsigned xb_ld(unsigned* p)              { return __hip_atomic_load(p, __ATOMIC_RELAXED, __HIP_MEMORY_SCOPE_AGENT); }
__device__ __forceinline__ unsigned xb_add(unsigned* p, unsigned v) { return __hip_atomic_fetch_add(p, v, __ATOMIC_RELAXED, __HIP_MEMORY_SCOPE_AGENT); }
__device__ __forceinline__ unsigned xb_xcc_id() { return (unsigned)__builtin_amdgcn_s_getreg((3 << 11) | 20) & 0xFu; }
#define XB_SPIN(cond, bar) do { unsigned _sp = 0; while (cond) { __builtin_amdgcn_s_sleep(1); \
    if ((++_sp & 255u) == 0u) { if (xb_ld(&(bar)[XB_TMO])) break; if (_sp > XB_SPIN_CAP) { atomicAdd(&(bar)[XB_TMO], 1u); break; } } } } while (0)

struct XcdBarrier {
    unsigned* bar; unsigned x;
    volatile LAS unsigned* st;
};

__device__ __forceinline__ XcdBarrier xcd_barrier_post(unsigned* bar, volatile LAS unsigned* st) {
    XcdBarrier b; b.bar = bar; b.x = xb_xcc_id(); b.st = st;
    if (threadIdx.x == 0) (void)xb_add(&bar[XB_XCNT(b.x)], 1u);
    return b;
}
__device__ __forceinline__ void xcd_barrier_complete(unsigned* bar, unsigned x, unsigned& nloc, unsigned& nx) {
    const unsigned G = gridDim.x * gridDim.y * gridDim.z;
    unsigned sum, cnt, mine, sp = 0u;
    for (;;) {
        sum = 0u; cnt = 0u; mine = 0u;
#pragma unroll
        for (unsigned j = 0; j < 16; ++j) { const unsigned c = xb_ld(&bar[XB_XCNT(j)]); sum += c; cnt += (c > 0u) ? 1u : 0u; mine = (j == x) ? c : mine; }
        if (sum == G) break;
        __builtin_amdgcn_s_sleep(1);
        if ((++sp & 255u) == 0u) { if (xb_ld(&bar[XB_TMO])) break; if (sp > XB_SPIN_CAP) { atomicAdd(&bar[XB_TMO], 1u); break; } }
    }
    nloc = mine > 0u ? mine : 1u; nx = cnt > 0u ? cnt : 1u;
}

__device__ __forceinline__ void xcd_barrier(const XcdBarrier& b) {
    asm volatile("s_waitcnt vmcnt(0)" ::: "memory");
    __syncthreads();
    if (threadIdx.x == 0) {
        unsigned* bar = b.bar;
        __builtin_amdgcn_s_waitcnt(0);
        unsigned nloc = b.st[0], nx = b.st[1];
        if (nloc == 0u) { xcd_barrier_complete(bar, b.x, nloc, nx); b.st[0] = nloc; b.st[1] = nx; }
        const unsigned old = xb_add(&bar[XB_XSUB(b.x)], 1u);
        const unsigned gen = old / nloc;
        if (old + 1u == (gen + 1u) * nloc) {
            __builtin_amdgcn_fence(__ATOMIC_RELEASE, "agent");
            asm volatile("s_waitcnt vmcnt(0)" ::: "memory");
            const unsigned og = xb_add(&bar[XB_TOP], 1u);
            const unsigned tg = og / nx;
            if (og + 1u == (tg + 1u) * nx) xb_add(&bar[XB_TOPGEN], 1u);
            else XB_SPIN(xb_ld(&bar[XB_TOPGEN]) == tg, bar);
            __builtin_amdgcn_fence(__ATOMIC_ACQUIRE, "agent");
            xb_add(&bar[XB_XGEN(b.x)], 1u);
            asm volatile("s_waitcnt vmcnt(0)" ::: "memory");
        } else {
            XB_SPIN(xb_ld(&bar[XB_XGEN(b.x)]) == gen, bar);
            __builtin_amdgcn_fence(__ATOMIC_ACQUIRE, "agent");
            asm volatile("s_waitcnt vmcnt(0)" ::: "memory");
        }
    }
    __syncthreads();
}

struct Frame {
    LAS unsigned char* lds;
    volatile LAS unsigned* MISC;
    gu32* ctl;
    unsigned char* ws;
    int tid, lane, wave, vcu, G;
    float* out;
};
template <class T> __device__ __forceinline__ T* wsp(const Frame& F, size_t off) { return (T*)(F.ws + off); }
enum { I_X = 0, I_C, I_CTX, I_CCTX, I_ADAW, I_ADAB, I_NORMG, I_WIN, I_CONVW, I_CONVB, I_LNG, I_LNB, I_WOUT, I_WQKV, I_LAMBDA, I_SUBLNG, I_DAWOUT, I_RTW, I_RTB, I_WGATE, I_WUP, I_WDOWN, I_SHG, I_SHU, I_SHD };
__device__ __forceinline__ const float* inp(const Frame& F, int i) { const LAS unsigned* t = (const LAS unsigned*)(F.lds + INPTR_OFF) + 2 * i;
    const unsigned lo = __builtin_amdgcn_readfirstlane(t[0]), hi = __builtin_amdgcn_readfirstlane(t[1]); return (const float*)(const GAS float*)(((unsigned long long)hi << 32) | lo); }
#ifndef DBG_JITTER
#define DBG_JITTER 0
#endif
#define FENCE(F) do { if (DBG_JITTER && ((blockIdx.x * 5 + 3) % 7 < 2)) { const unsigned long long t0_ = __builtin_amdgcn_s_memrealtime(); while (__builtin_amdgcn_s_memrealtime() - t0_ < (unsigned long long)(DBG_JITTER * 100 * (1 + blockIdx.x % 3))) __builtin_amdgcn_s_sleep(8); } int t_ = threadIdx.x; asm volatile("" : "+v"(t_)); F.tid = t_; F.lane = t_ & 63; F.wave = __builtin_amdgcn_readfirstlane(t_ >> 6); asm volatile("" : "+s"(F.ws), "+s"(F.out), "+s"(F.ctl) :: "memory"); F.ws = (unsigned char*)(GAS unsigned char*)F.ws; F.out = (float*)(GAS float*)F.out; } while (0)

__device__ __forceinline__ float wave_sum(float v) {
#pragma unroll
    for (int o = 1; o < 64; o <<= 1) v += __shfl_xor(v, o);
    return v;
}
#ifndef NT_STREAMS
#define NT_STREAMS 1
#endif
#define NTLD(P) (NT_STREAMS ? __builtin_nontemporal_load(P) : *(P))
__device__ __forceinline__ void ldrow_f32(const float* p, int lane, f32x4 (&v)[4]) { const GAS f32x4* q = (const GAS f32x4*)p + lane;
#pragma unroll
    for (int j = 0; j < 4; ++j) v[j] = q[64 * j]; }
__device__ __forceinline__ void ldrow_bf16(const bf16* p, int lane, f32x4 (&v)[4]) { const GAS v2u* q = (const GAS v2u*)p + lane;
#pragma unroll
    for (int j = 0; j < 4; ++j) { const v2u w = q[64 * j]; v[j] = (f32x4){bf2f(w.x & 0xffffu), bf2f(w.x >> 16), bf2f(w.y & 0xffffu), bf2f(w.y >> 16)}; } }
__device__ __forceinline__ void ldrow_fp8(const unsigned char* p, int lane, f32x4 (&v)[4]) { typedef float f32x2 __attribute__((ext_vector_type(2))); const GAS unsigned* q = (const GAS unsigned*)p + lane;
#pragma unroll
    for (int j = 0; j < 4; ++j) { const int w = (int)NTLD(q + 64 * j); const f32x2 a = __builtin_amdgcn_cvt_pk_f32_fp8(w, false), b = __builtin_amdgcn_cvt_pk_f32_fp8(w, true); v[j] = (f32x4){a.x, a.y, b.x, b.y} * 0.0625f; } }
__device__ __forceinline__ void ldrow_f32_nt(const float* p, int lane, f32x4 (&v)[4]) { const GAS f32x4* q = (const GAS f32x4*)p + lane;
#pragma unroll
    for (int j = 0; j < 4; ++j) v[j] = NTLD(q + 64 * j); }
__device__ __forceinline__ void ldrow_bf16_nt(const bf16* p, int lane, f32x4 (&v)[4]) { const GAS v2u* q = (const GAS v2u*)p + lane;
#pragma unroll
    for (int j = 0; j < 4; ++j) { const v2u w = NTLD(q + 64 * j); v[j] = (f32x4){bf2f(w.x & 0xffffu), bf2f(w.x >> 16), bf2f(w.y & 0xffffu), bf2f(w.y >> 16)}; } }
__device__ __forceinline__ void strow_f32_nt(float* p, int lane, const f32x4 (&v)[4]) { GAS f32x4* q = (GAS f32x4*)p + lane;
#pragma unroll
    for (int j = 0; j < 4; ++j) { if (NT_STREAMS) __builtin_nontemporal_store(v[j], q + 64 * j); else q[64 * j] = v[j]; } }
__device__ __forceinline__ void strow_f32(float* p, int lane, const f32x4 (&v)[4]) { GAS f32x4* q = (GAS f32x4*)p + lane;
#pragma unroll
    for (int j = 0; j < 4; ++j) q[64 * j] = v[j]; }
__device__ __forceinline__ void strow_bf16(bf16* p, int lane, const f32x4 (&v)[4]) { GAS v2u* q = (GAS v2u*)p + lane;
#pragma unroll
    for (int j = 0; j < 4; ++j) q[64 * j] = (v2u){pk2(v[j].x, v[j].y), pk2(v[j].z, v[j].w)}; }
__device__ __forceinline__ float rstd_of(const f32x4 (&v)[4]) { float s = 0.f;
#pragma unroll
    for (int j = 0; j < 4; ++j) s += (v[j].x * v[j].x + v[j].y * v[j].y) + (v[j].z * v[j].z + v[j].w * v[j].w);
    return rsqrtf(wave_sum(s) * (1.f / DM) + EPSN); }
__device__ __forceinline__ void modnorm(const f32x4 (&v)[4], float rstd, const float* g, const float* shift, const float* scale, int lane, f32x4 (&o)[4]) {
    f32x4 gg[4], sh[4], sc[4]; ldrow_f32(g, lane, gg); ldrow_f32(shift, lane, sh); ldrow_f32(scale, lane, sc);
#pragma unroll
    for (int j = 0; j < 4; ++j) o[j] = v[j] * rstd * gg[j] * (sc[j] + 1.f) + sh[j]; }
__device__ __forceinline__ const float* modp(const Frame& F, int layer, int rb, int j) { return wsp<const float>(F, WS_MOD) + ((size_t)(layer * 9 + rb) * 6 + j) * 1024; }
__device__ __forceinline__ int rowbatch(int row) { return row < TL ? row / SEQ : 8; }

__device__ __forceinline__ int maprow(int mode, int n) {
    if (mode == 1) { if (n < 512) return 256 * (n >> 7) + (n & 127); if (n < 1024) { const int q = n - 512; return 256 * (q >> 7) + 128 + (q & 127); } return n; }
    if (mode == 2) { if (n < 2048) { const int blk = n >> 10, q = n & 1023, h = q >> 7, comp = (q >> 6) & 1, d = q & 63, bj = d >> 5, dd = d & 31, g = (h & 1) * 2 + comp; return blk * 1024 + 256 * (h >> 1) + 128 * bj + 32 * g + dd; } return n; }
    if (mode == 3) return 256 * (n >> 7) + (n & 127);
    if (mode == 4) return 256 * (n >> 7) + 128 + (n & 127);
    return n;
}
__device__ __forceinline__ void p0_transpose_item(const float* W, int K, int N, bf16* WT, int mode, LAS float* scr, int item, int lane, const float scale = 1.f) {
    (void)scr;
    const int nblk = N / 32, kb = item / nblk, nb = item % nblk, a = lane & 7, q = lane >> 3, k0 = 64 * kb + 8 * q, n0 = 32 * nb + 4 * a;
    const GAS f32x4* src = (const GAS f32x4*)(W + (size_t)k0 * N + n0);
    f32x4 r[8];
#pragma unroll
    for (int i = 0; i < 8; ++i) r[i] = NTLD(src + (size_t)i * (N / 4));
#pragma unroll
    for (int j = 0; j < 4; ++j) { v4u o; o.x = pk2(r[0][j] * scale, r[1][j] * scale); o.y = pk2(r[2][j] * scale, r[3][j] * scale); o.z = pk2(r[4][j] * scale, r[5][j] * scale); o.w = pk2(r[6][j] * scale, r[7][j] * scale);
        if (NT_STREAMS) __builtin_nontemporal_store(o, (GAS v4u*)(WT + (size_t)maprow(mode, n0 + j) * K + k0)); else *(GAS v4u*)(WT + (size_t)maprow(mode, n0 + j) * K + k0) = o; }
}
__device__ __forceinline__ void p0_router_item(const float* W, bf16* HI, bf16* LO, LAS float* scr, int item, int lane) {
    const int kb = item >> 1, nb = item & 1, k0 = 64 * kb, n0 = 32 * nb;
#pragma unroll 8
    for (int i = 0; i < 32; ++i) { const int kk = 2 * i + (lane >> 5); scr[kk * 33 + (lane & 31)] = ((const GAS float*)W)[(size_t)(k0 + kk) * 64 + n0 + (lane & 31)]; }
    LDS_WAIT(); asm volatile("" ::: "memory");
    const int c = lane & 7;
#pragma unroll
    for (int j = 0; j < 4; ++j) { const int n = (lane >> 3) + 8 * j; const LAS float* s = scr + (8 * c) * 33 + n;
        unsigned h[8], l[8];
#pragma unroll
        for (int q = 0; q < 8; ++q) { const float w = s[q * 33]; h[q] = f2bf(w); l[q] = f2bf(w - bf2f(h[q])); }
        v4u oh, ol; oh.x = h[0] | (h[1] << 16); oh.y = h[2] | (h[3] << 16); oh.z = h[4] | (h[5] << 16); oh.w = h[6] | (h[7] << 16);
        ol.x = l[0] | (l[1] << 16); ol.y = l[2] | (l[3] << 16); ol.z = l[4] | (l[5] << 16); ol.w = l[6] | (l[7] << 16);
        *(GAS v4u*)(HI + (size_t)(n0 + n) * 1024 + k0 + 8 * c) = oh; *(GAS v4u*)(LO + (size_t)(n0 + n) * 1024 + k0 + 8 * c) = ol; }
    LDS_WAIT(); asm volatile("" ::: "memory");
}
__device__ __forceinline__ void convert_experts(Frame& F, int layer, int it0 = 0, int it1 = 64 * 384, int cu0 = 0, int ncu = 0) {
    LAS float* scr = (LAS float*)(F.lds + RING_OFF + F.wave * 16384);
    const int gw = (ncu ? (int)blockIdx.x - cu0 : F.vcu) * NWAVES + F.wave, NGW = (ncu ? ncu : F.G) * NWAVES;
    bf16* UP = wsp<bf16>(F, WS_WEUP); bf16* DN = wsp<bf16>(F, WS_WEDN);
    for (int it = it0 + gw; it < it1; it += NGW) {
        const int e = it / 384, r = it % 384; const size_t eo = (size_t)(layer * 64 + e) * 1024 * 256;
        if (r < 128) p0_transpose_item(inp(F, I_WGATE) + eo, 1024, 256, UP + (size_t)e * 512 * 1024, 3, scr, r, F.lane);
        else if (r < 256) p0_transpose_item(inp(F, I_WUP) + eo, 1024, 256, UP + (size_t)e * 512 * 1024, 4, scr, r - 128, F.lane);
        else p0_transpose_item(inp(F, I_WDOWN) + eo, 256, 1024, DN + (size_t)e * 1024 * 256, 0, scr, r - 256, F.lane, 16.f);
    }
}
__device__ __forceinline__ float silu(float v) { return v / (1.f + __expf(-v)); }

__device__ __forceinline__ void p0_prologue(Frame& F) {
    __syncthreads();
#ifndef P0_PARTS
#define P0_PARTS 15
#endif
    if (P0_PARTS & 1)
    {
        LAS float* sc = (LAS float*)(F.lds);
        LAS float* part = (LAS float*)(F.lds + 40960);
        for (int i = F.tid; i < 9 * 1024; i += 512) { const int r = i >> 10, k = i & 1023; sc[i] = silu(r < 8 ? inp(F, I_C)[r * 1024 + k] : inp(F, I_CCTX)[k]); }
        __syncthreads();
        for (int item = F.vcu; item < 192; item += F.G) {
            const int layer = item / 96, col = (item % 96) * 64 + F.lane;
            const float* W = inp(F, I_ADAW) + (size_t)layer * 1024 * 6144 + col;
            float a[9];
#pragma unroll
            for (int r = 0; r < 9; ++r) a[r] = 0.f;
#pragma unroll 8
            for (int kk = 0; kk < 128; ++kk) { const int k = F.wave * 128 + kk; const float w = NTLD((const GAS float*)(W + (size_t)k * 6144));
#pragma unroll
                for (int r = 0; r < 9; ++r) a[r] += sc[r * 1024 + k] * w; }
#pragma unroll
            for (int r = 0; r < 9; ++r) part[(F.wave * 9 + r) * 64 + F.lane] = a[r];
            __syncthreads();
            for (int i = F.tid; i < 576; i += 512) { const int r = i >> 6, l = i & 63; float s = 0.f;
#pragma unroll
                for (int w = 0; w < 8; ++w) s += part[(w * 9 + r) * 64 + l];
                const int cc = (item % 96) * 64 + l;
                wsp<float>(F, WS_MOD)[(size_t)(layer * 9 + r) * 6144 + cc] = s + inp(F, I_ADAB)[layer * 6144 + cc]; }
            __syncthreads();
        }
        __syncthreads();
    }
    LAS float* scr = (LAS float*)(F.lds + RING_OFF + F.wave * 16384);
    const int gw = F.vcu * NWAVES + F.wave, NGW = F.G * NWAVES;
    constexpr int NI_IN = 16 * 48, NI_OUT = 8 * 32, NI_QKV = 16 * 96, NI_DAO = 16 * 32, NI_SHG = 16 * 8, NI_SHD = 4 * 32, NI_RT = 32;
    constexpr int NI_TAB = 4096, NI_TABC = 256, NI_BD = 2048, NI_ROPE = 2048;
    constexpr int NITEMS = NI_IN + NI_OUT + NI_QKV + NI_DAO + 4 * NI_SHG + 2 * NI_SHD + 2 * NI_RT + NI_TAB + NI_TABC + NI_BD + NI_ROPE;
#ifndef P0_IT_LO
#define P0_IT_LO 0
#define P0_IT_HI 1000000
#endif
    if (P0_PARTS & 2)
    for (int it = gw; it < NITEMS; it += NGW) {
        int r = it; if (it < P0_IT_LO || it >= P0_IT_HI) continue;
        if (r < NI_IN) { p0_transpose_item(inp(F, I_WIN), 1024, 1536, wsp<bf16>(F, WS_WIN), 1, scr, r, F.lane); continue; } r -= NI_IN;
        if (r < NI_OUT) { p0_transpose_item(inp(F, I_WOUT), 1536, 1024, wsp<bf16>(F, WS_W2), 0, scr, r, F.lane); continue; } r -= NI_OUT;
        if (r < NI_QKV) { p0_transpose_item(inp(F, I_WQKV), 1024, 3072, wsp<bf16>(F, WS_WQKV), 0, scr, r, F.lane); continue; } r -= NI_QKV;
        if (r < NI_DAO) { p0_transpose_item(inp(F, I_DAWOUT), 1024, 1024, wsp<bf16>(F, WS_WDAO), 0, scr, r, F.lane); continue; } r -= NI_DAO;
        if (r < 4 * NI_SHG) { const int l = r / (2 * NI_SHG), q = r % (2 * NI_SHG);
            if (q < NI_SHG) p0_transpose_item(inp(F, I_SHG) + (size_t)l * 1024 * 256, 1024, 256, wsp<bf16>(F, WS_SHUP) + (size_t)l * 512 * 1024, 3, scr, q, F.lane);
            else p0_transpose_item(inp(F, I_SHU) + (size_t)l * 1024 * 256, 1024, 256, wsp<bf16>(F, WS_SHUP) + (size_t)l * 512 * 1024, 4, scr, q - NI_SHG, F.lane);
            continue; } r -= 4 * NI_SHG;
        if (r < 2 * NI_SHD) { const int l = r / NI_SHD; p0_transpose_item(inp(F, I_SHD) + (size_t)l * 256 * 1024, 256, 1024, wsp<bf16>(F, WS_SHDN) + (size_t)l * 1024 * 256, 0, scr, r % NI_SHD, F.lane, 16.f); continue; } r -= 2 * NI_SHD;
        if (r < 2 * NI_RT) { const int l = r / NI_RT; bf16* base = wsp<bf16>(F, WS_WRT) + (size_t)l * 2 * 64 * 1024; p0_router_item(inp(F, I_RTW) + (size_t)l * 1024 * 64, base, base + 64 * 1024, scr, r % NI_RT, F.lane); continue; } r -= 2 * NI_RT;
        if (r < NI_TAB) {
            const int kk = r <= 2048 ? r : r - 2048; bf16* row = wsp<bf16>(F, WS_TAB) + (size_t)r * 4096;
            for (int q = 0; q < 8; ++q) { const int l0 = q * 512 + F.lane * 8; unsigned h[8];
#pragma unroll
                for (int i = 0; i < 8; ++i) { const int idx = (kk * (l0 + i)) & 4095; float s, c; sincospif((float)idx * (1.f / 2048.f), &s, &c); h[i] = f2bf((r <= 2048 ? c : -s) * (1.f / 64.f)); }
                *(GAS v4u*)(row + l0) = (v4u){h[0] | (h[1] << 16), h[2] | (h[3] << 16), h[4] | (h[5] << 16), h[6] | (h[7] << 16)}; }
            continue; } r -= NI_TAB;
        if (r < NI_TABC) { const int kk = r <= 128 ? r : r - 128; bf16* row = wsp<bf16>(F, WS_TABC) + (size_t)r * 256; const int l0 = F.lane * 4; unsigned h[4];
#pragma unroll
            for (int i = 0; i < 4; ++i) { const int idx = (kk * (l0 + i)) & 255; float s, c; sincospif((float)idx * (1.f / 128.f), &s, &c); h[i] = f2bf((r <= 128 ? c : -s) * (1.f / 16.f)); }
            *(GAS v2u*)(row + l0) = (v2u){h[0] | (h[1] << 16), h[2] | (h[3] << 16)};
            continue; } r -= NI_TABC;
        if (r < NI_BD) {
            const int nb = r & 15, cb = (r >> 4) & 15, part = (r >> 8) & 1, g = r >> 9; const int n = nb * 64 + F.lane, c0 = cb * 8;
            const GAS float* wsrc = (const GAS float*)inp(F, I_WOUT) + (size_t)(512 + 128 * g) * 1024 + n;
            { float s0, c0_, s1, c1_; sincospif((float)F.lane * (1.f / 64.f), &s0, &c0_); sincospif((float)(F.lane + 64) * (1.f / 64.f), &s1, &c1_);
              scr[F.lane] = part ? s0 : c0_; scr[F.lane + 64] = part ? s1 : c1_; LDS_WAIT(); asm volatile("" ::: "memory"); }
            float acc8[8];
#pragma unroll
            for (int j = 0; j < 8; ++j) acc8[j] = 0.f;
#pragma unroll 2
            for (int m = 0; m < 128; ++m) { const float wv = wsrc[(size_t)m * 1024];
#pragma unroll
                for (int j = 0; j < 8; ++j) acc8[j] += scr[(m * (c0 + j)) & 127] * wv; }
            LDS_WAIT(); asm volatile("" ::: "memory");
            unsigned h[8];
#pragma unroll
            for (int j = 0; j < 8; ++j) h[j] = f2bf(acc8[j] * 0.08838834764831845f);
            *(GAS v4u*)(wsp<bf16>(F, WS_W2) + (size_t)n * 1536 + 512 + 256 * g + 128 * part + c0) = (v4u){h[0] | (h[1] << 16), h[2] | (h[3] << 16), h[4] | (h[5] << 16), h[6] | (h[7] << 16)};
            continue; } r -= NI_BD;
        { const int s = r * 2 + (F.lane >> 5), dd = F.lane & 31, i = dd & 15; const float inv = powf(10000.f, -(float)i * (1.f / 16.f)); const float pos = (float)(dd < 16 ? s / 64 : s % 64); const float ang = pos * inv;
          wsp<unsigned>(F, WS_ROPE)[s * 32 + dd] = f2bf(cosf(ang)) | (f2bf(sinf(ang)) << 16); }
    }
    if (P0_PARTS & 4) convert_experts(F, 0, (CVT0_LATE > 0 && F.G == 256) ? CVT0_LATE : 0);
#if DBG_LAST_PHASE < 6
    if (P0_PARTS & 8)
    for (int m = gw; m < TL; m += NGW) { f32x4 v[4]; ldrow_f32(inp(F, I_X) + (size_t)m * DM, F.lane, v); strow_f32(F.out + (size_t)m * DM, F.lane, v); }
#endif
}

#ifndef KSPLIT_CTX
#define KSPLIT_CTX 1
#endif
#ifndef X3_BF16
#define X3_BF16 1
#endif
__device__ __forceinline__ void ldvec(const float* p, int lane, f32x4 (&v)[4]) { ldrow_f32(p, lane, v); }
__device__ __forceinline__ void phase_modnorm0(Frame& F) {
    const int gw = F.vcu * NWAVES + F.wave, NGW = F.G * NWAVES, R = (T0 + NGW - 1) / NGW;
    const int r0 = gw * R, r1 = (r0 + R < T0) ? r0 + R : T0;
    int crb = -1; f32x4 A[4], B[4];
    for (int row = r0; row < r1; ++row) {
        const int rb = rowbatch(row);
        if (rb != crb) { crb = rb; f32x4 g[4], sc[4]; ldvec(inp(F, I_NORMG), F.lane, g); ldvec(modp(F, 0, rb, 1), F.lane, sc); ldvec(modp(F, 0, rb, 0), F.lane, B);
#pragma unroll
            for (int j = 0; j < 4; ++j) A[j] = g[j] * (sc[j] + 1.f); }
        const float* xr = row < TL ? inp(F, I_X) + (size_t)row * DM : inp(F, I_CTX) + (size_t)(row - TL) * DM;
        f32x4 v[4], o[4]; ldrow_f32_nt(xr, F.lane, v); const float rs = rstd_of(v);
#pragma unroll
        for (int j = 0; j < 4; ++j) o[j] = v[j] * rs * A[j] + B[j];
        strow_bf16(wsp<bf16>(F, WS_HX) + (size_t)row * DM, F.lane, o);
    }
}
__device__ __forceinline__ void phase_e2(Frame& F, int layer) {
    const int gw = F.vcu * NWAVES + F.wave, NGW = F.G * NWAVES;
    const bool ksp = KSPLIT_CTX && layer == 0;
    const int nrows = (layer == 0 && !ksp) ? T0 : TL, R = (nrows + NGW - 1) / NGW;
    const int r0 = gw * R, r1 = (r0 + R < nrows) ? r0 + R : nrows;
    const int nx = ksp ? (TC - gw + NGW - 1) / NGW : 0;
    const bf16* Y = wsp<const bf16>(F, layer == 0 ? WS_Y : WS_Y1);
    int crb = -1; f32x4 C[4], A[4], B[4];
    for (int it = 0; it < (r1 > r0 ? r1 - r0 : 0) + nx; ++it) {
        const int row = (it < r1 - r0) ? r0 + it : TL + gw + (it - (r1 > r0 ? r1 - r0 : 0)) * NGW;
        const int rb = rowbatch(row);
        if (rb != crb) { crb = rb; f32x4 g1[4], m2[4], g2[4], m4[4]; ldvec(inp(F, I_NORMG) + (layer * 4 + 1) * 1024, F.lane, g1); ldvec(modp(F, layer, rb, 2), F.lane, m2);
            ldvec(inp(F, I_NORMG) + (layer * 4 + 2) * 1024, F.lane, g2); ldvec(modp(F, layer, rb, 4), F.lane, m4); ldvec(modp(F, layer, rb, 3), F.lane, B);
#pragma unroll
            for (int j = 0; j < 4; ++j) { C[j] = m2[j] * g1[j]; A[j] = g2[j] * (m4[j] + 1.f); } }
        const float* xr = layer == 0 ? (row < TL ? inp(F, I_X) + (size_t)row * DM : inp(F, I_CTX) + (size_t)(row - TL) * DM) : F.out + (size_t)row * DM;
        float* xo = row < TL ? F.out + (size_t)row * DM : wsp<float>(F, WS_CTXRES) + (size_t)(row - TL) * DM;
        f32x4 x[4], y[4]; ldrow_f32_nt(xr, F.lane, x);
        if (ksp && row >= TL) { const bf16* P = wsp<const bf16>(F, WS_YPART) + (size_t)(row - TL) * DM; f32x4 p1[4], p2[4], p3[4];
            ldrow_bf16(P, F.lane, y); ldrow_bf16(P + (size_t)TC * DM, F.lane, p1); ldrow_bf16(P + (size_t)2 * TC * DM, F.lane, p2); ldrow_bf16(P + (size_t)3 * TC * DM, F.lane, p3);
#pragma unroll
            for (int j = 0; j < 4; ++j) y[j] = (y[j] + p1[j]) + (p2[j] + p3[j]); }
        else ldrow_bf16_nt(Y + (size_t)row * DM, F.lane, y);
        const float ry = rstd_of(y);
#pragma unroll
        for (int j = 0; j < 4; ++j) x[j] = x[j] + (y[j] * ry) * C[j];
        if (layer == 0 || !X3_BF16) strow_f32_nt(xo, F.lane, x); else strow_bf16((bf16*)xo, F.lane, x);
        const float rx = rstd_of(x);
        GAS v2u* qh = (GAS v2u*)(wsp<bf16>(F, WS_HX) + (size_t)row * DM) + F.lane; GAS v2u* ql = (GAS v2u*)(wsp<bf16>(F, WS_TOKLO) + (size_t)row * DM) + F.lane;
#pragma unroll
        for (int j = 0; j < 4; ++j) { const f32x4 t = x[j] * rx * A[j] + B[j]; unsigned h[4], l[4];
#pragma unroll
            for (int i = 0; i < 4; ++i) { h[i] = f2bf(t[i]); l[i] = f2bf(t[i] - bf2f(h[i])); }
            qh[64 * j] = (v2u){h[0] | (h[1] << 16), h[2] | (h[3] << 16)}; ql[64 * j] = (v2u){l[0] | (l[1] << 16), l[2] | (l[3] << 16)}; }
    }
}
__device__ __forceinline__ void phase_e4(Frame& F, int layer, int chunk, int CT, bool dry = false) {
    (void)dry;
    const int gw = F.vcu * NWAVES + F.wave, NGW = F.G * NWAVES, R = (CT + NGW - 1) / NGW;
    const LAS int* tbs = (const LAS int*)(F.lds + TBL_OFF + 4096);
    const int NBr = tbs[64], cstart = chunk * CT;
    const int r0 = cstart + gw * R, r1 = (gw * R + R < CT) ? r0 + R : cstart + CT;
    const unsigned char* YE = wsp<const unsigned char>(F, WS_YEXP);
    const GAS int* TS = (const GAS int*)wsp<const int>(F, WS_TOKSLOT); const GAS float* TG = (const GAS float*)wsp<const float>(F, WS_TOKGATE);
    int crb = -1; f32x4 C[4], A[4], B[4];
    for (int t = r0; t < r1; ++t) {
        const int rb = rowbatch(t);
        if (rb != crb) { crb = rb; f32x4 g3[4], m5[4]; ldvec(inp(F, I_NORMG) + (layer * 4 + 3) * 1024, F.lane, g3); ldvec(modp(F, layer, rb, 5), F.lane, m5);
#pragma unroll
            for (int j = 0; j < 4; ++j) C[j] = m5[j] * g3[j];
            if (layer == 0) { f32x4 g0[4], m1[4]; ldvec(inp(F, I_NORMG) + 4 * 1024, F.lane, g0); ldvec(modp(F, 1, rb, 1), F.lane, m1); ldvec(modp(F, 1, rb, 0), F.lane, B);
#pragma unroll
                for (int j = 0; j < 4; ++j) A[j] = g0[j] * (m1[j] + 1.f); } }
        f32x4 y[4], v[4]; ldrow_fp8(YE + ((size_t)256 * NBr + (t - cstart)) * DM, F.lane, y);
#pragma unroll
        for (int k = 0; k < TOPK; ++k) { const int s = __builtin_amdgcn_readfirstlane(TS[t * 8 + k]); const float gt = __builtin_bit_cast(float, __builtin_amdgcn_readfirstlane(__builtin_bit_cast(int, TG[t * 8 + k])));
            const size_t row = (size_t)256 * tbs[s >> 20] + (s & 0xfffff); ldrow_fp8(YE + row * DM, F.lane, v);
#pragma unroll
            for (int j = 0; j < 4; ++j) y[j] = y[j] + v[j] * gt; }
        float* xo = t < TL ? F.out + (size_t)t * DM : wsp<float>(F, WS_CTXRES) + (size_t)(t - TL) * DM;
        f32x4 x[4]; if (layer == 0 || !X3_BF16) ldrow_f32_nt(xo, F.lane, x); else ldrow_bf16_nt((const bf16*)xo, F.lane, x);
        const float ry = rstd_of(y);
#pragma unroll
        for (int j = 0; j < 4; ++j) x[j] = x[j] + (y[j] * ry) * C[j];
        if (layer == 1 && NT_STREAMS) { GAS f32x4* q_ = (GAS f32x4*)xo + F.lane;
#pragma unroll
            for (int j = 0; j < 4; ++j) __builtin_nontemporal_store(x[j], q_ + 64 * j); }
        else strow_f32_nt(xo, F.lane, x);
        if (layer == 0) { const float rx = rstd_of(x); f32x4 h[4];
#pragma unroll
            for (int j = 0; j < 4; ++j) h[j] = x[j] * rx * A[j] + B[j];
            strow_bf16(wsp<bf16>(F, WS_HX) + (size_t)t * DM, F.lane, h); }
    }
}
__device__ __forceinline__ void phase_combine(Frame& F) {
    const int gw = F.vcu * NWAVES + F.wave, NGW = F.G * NWAVES;
    const float lam_init = 0.8f - 0.6f * expf(-0.3f);
    float s01 = 0.f, s23 = 0.f;
    for (int i = 0; i < 64; ++i) { s01 += inp(F, I_LAMBDA)[i] * inp(F, I_LAMBDA)[64 + i]; s23 += inp(F, I_LAMBDA)[128 + i] * inp(F, I_LAMBDA)[192 + i]; }
    const float lam = expf(s01) - expf(s23) + lam_init, post = 1.f - lam_init;
    const bf16* OC = wsp<const bf16>(F, WS_OC); bf16* AO = wsp<bf16>(F, WS_Q);
    const int h = F.lane >> 3, e0 = (F.lane & 7) * 16;
    float sg[16];
#pragma unroll
    for (int i = 0; i < 16; ++i) sg[i] = inp(F, I_SUBLNG)[e0 + i] * post;
    for (int t = gw; t < TL; t += NGW) {
        const bf16* p = OC + (size_t)t * 2048 + h * 256 + e0;
        const v4u a0 = NTLD((const GAS v4u*)p), a1 = NTLD((const GAS v4u*)(p + 8)), b0 = NTLD((const GAS v4u*)(p + 128)), b1 = NTLD((const GAS v4u*)(p + 136));
        const unsigned aw[8] = {a0.x, a0.y, a0.z, a0.w, a1.x, a1.y, a1.z, a1.w}, bw[8] = {b0.x, b0.y, b0.z, b0.w, b1.x, b1.y, b1.z, b1.w};
        float d[16]; float ss = 0.f;
#pragma unroll
        for (int i = 0; i < 8; ++i) { d[2 * i] = bf2f(aw[i] & 0xffffu) - lam * bf2f(bw[i] & 0xffffu); d[2 * i + 1] = bf2f(aw[i] >> 16) - lam * bf2f(bw[i] >> 16); ss += d[2 * i] * d[2 * i] + d[2 * i + 1] * d[2 * i + 1]; }
        ss += __shfl_xor(ss, 1); ss += __shfl_xor(ss, 2); ss += __shfl_xor(ss, 4);
        const float rstd = rsqrtf(ss * (1.f / 128.f) + EPSN);
        unsigned w[8];
#pragma unroll
        for (int i = 0; i < 8; ++i) w[i] = pk2(d[2 * i] * rstd * sg[2 * i], d[2 * i + 1] * rstd * sg[2 * i + 1]);
        bf16* q = AO + (size_t)t * DM + h * 128 + e0;
        *(GAS v4u*)q = (v4u){w[0], w[1], w[2], w[3]}; *(GAS v4u*)(q + 8) = (v4u){w[4], w[5], w[6], w[7]};
    }
}

__device__ __forceinline__ void phase_conv(Frame& F) {
    const int c = F.tid;
    float w[31];
#pragma unroll
    for (int j = 0; j < 31; ++j) w[j] = inp(F, I_CONVW)[j * 512 + c];
    const float bias = inp(F, I_CONVB)[c], lg = inp(F, I_LNG)[c], lb = inp(F, I_LNB)[c];
    LAS bf16* tile = (LAS bf16*)(F.lds);
    const bf16* AG = wsp<const bf16>(F, WS_AGLU); bf16* MIX = wsp<bf16>(F, WS_XA);
    for (int ti = F.vcu; ti < 544; ti += F.G) {
        int rowbase, L, p0;
        if (ti < 512) { rowbase = (ti >> 6) * SEQ; p0 = (ti & 63) * 64; L = SEQ; } else { const int q = ti - 512; rowbase = TL + (q >> 2) * CTXL; p0 = (q & 3) * 64; L = CTXL; }
        __syncthreads();
        for (int rr = F.wave; rr < 94; rr += 8) { const int p = p0 - 15 + rr; v4u val = (v4u){0u, 0u, 0u, 0u};
            if (p >= 0 && p < L) val = NTLD((const GAS v4u*)(AG + (size_t)(rowbase + p) * 512 + F.lane * 8));
            *(LAS v4u*)(tile + rr * 512 + F.lane * 8) = val; }
        __syncthreads();
        for (int ch = 0; ch < 8; ++ch) {
            float in[38];
#pragma unroll
            for (int i = 0; i < 38; ++i) in[i] = bf2f(tile[(ch * 8 + i) * 512 + c]);
            float a[8], s[8], ss[8];
#pragma unroll
            for (int q = 0; q < 8; ++q) { float t = bias;
#pragma unroll
                for (int j = 0; j < 31; ++j) t += w[j] * in[q + j];
                a[q] = t; s[q] = t; ss[q] = t * t; }
#pragma unroll
            for (int o = 1; o < 64; o <<= 1) {
                float ts[8], tq[8];
#pragma unroll
                for (int q = 0; q < 8; ++q) { ts[q] = __shfl_xor(s[q], o); tq[q] = __shfl_xor(ss[q], o); }
#pragma unroll
                for (int q = 0; q < 8; ++q) { s[q] += ts[q]; ss[q] += tq[q]; } }
#pragma unroll
            for (int q = 0; q < 8; ++q) { const float mean = s[q] * (1.f / 64.f), var = fmaxf(ss[q] * (1.f / 64.f) - mean * mean, 0.f);
                const float z = (a[q] - mean) * rsqrtf(var + EPSN) * lg + lb;
                ((GAS bf16*)MIX)[(size_t)(rowbase + p0 + ch * 8 + q) * 1536 + c] = (bf16)f2bf(z * __builtin_amdgcn_rcpf(1.f + __builtin_amdgcn_exp2f(-1.4426950408889634f * z))); }
        }
    }
    __syncthreads();
}

__device__ __forceinline__ void phase_router(Frame& F, int layer, int ntok, int CT, int cnt_off = 0) {
    typedef float f4 __attribute__((ext_vector_type(4)));
    const int gw = F.vcu * NWAVES + F.wave, NGW = F.G * NWAVES;
    LAS float* lg = (LAS float*)(F.lds + RING_OFF + F.wave * 20480);
    const bf16* TH = wsp<const bf16>(F, WS_HX); const bf16* TLo = wsp<const bf16>(F, WS_TOKLO);
    const bf16* WH = wsp<const bf16>(F, WS_WRT) + (size_t)layer * 2 * 64 * 1024; const bf16* WL = WH + 64 * 1024;
    const float* rbias = inp(F, I_RTB) + layer * 64;
    unsigned* cnt = (unsigned*)(F.ctl + CW_CNT) + layer * NCH * 64 * CNT_STRIDE + cnt_off;
    int* LIST = wsp<int>(F, WS_LIST); int* TS = wsp<int>(F, WS_TOKSLOT); float* TG = wsp<float>(F, WS_TOKGATE);
    const int lr = F.lane & 15, lq = F.lane >> 4;
    for (int task = F.wave * F.G + F.vcu; task < ntok / 64; task += NGW) {
        const int t0 = task * 64;
        f4 acc[4][4];
#pragma unroll
        for (int m = 0; m < 4; ++m)
#pragma unroll
            for (int n = 0; n < 4; ++n) acc[m][n] = (f4){0.f, 0.f, 0.f, 0.f};
        const bf16* ah = TH + (size_t)(t0 + lr) * DM + 8 * lq; const bf16* al = TLo + (size_t)(t0 + lr) * DM + 8 * lq;
        const bf16* bh = WH + (size_t)lr * DM + 8 * lq; const bf16* bl = WL + (size_t)lr * DM + 8 * lq;
#define RT_LOAD(XH, XL, WH, WL, K0) do { _Pragma("unroll") for (int m = 0; m < 4; ++m) { XH[m] = *(const GAS bf16x8*)(ah + (size_t)m * 16 * DM + (K0)); XL[m] = NTLD((const GAS bf16x8*)(al + (size_t)m * 16 * DM + (K0))); } \
            _Pragma("unroll") for (int n = 0; n < 4; ++n) { WH[n] = *(const GAS bf16x8*)(bh + (size_t)n * 16 * DM + (K0)); WL[n] = *(const GAS bf16x8*)(bl + (size_t)n * 16 * DM + (K0)); } } while (0)
#define RT_MMA(XH, XL, WH, WL) do { _Pragma("unroll") for (int m = 0; m < 4; ++m) _Pragma("unroll") for (int n = 0; n < 4; ++n) { \
            acc[m][n] = __builtin_amdgcn_mfma_f32_16x16x32_bf16(XH[m], WH[n], acc[m][n], 0, 0, 0); \
            acc[m][n] = __builtin_amdgcn_mfma_f32_16x16x32_bf16(XL[m], WH[n], acc[m][n], 0, 0, 0); \
            acc[m][n] = __builtin_amdgcn_mfma_f32_16x16x32_bf16(XH[m], WL[n], acc[m][n], 0, 0, 0); } } while (0)
        bf16x8 xhA[4], xlA[4], whA[4], wlA[4], xhB[4], xlB[4], whB[4], wlB[4];
        RT_LOAD(xhA, xlA, whA, wlA, 0);
        for (int ks = 0; ks < 32; ks += 2) {
            RT_LOAD(xhB, xlB, whB, wlB, (ks + 1) * 32);
            RT_MMA(xhA, xlA, whA, wlA);
            if (ks + 2 < 32) RT_LOAD(xhA, xlA, whA, wlA, (ks + 2) * 32);
            RT_MMA(xhB, xlB, whB, wlB);
        }
#undef RT_LOAD
#undef RT_MMA
#pragma unroll
        for (int m = 0; m < 4; ++m)
#pragma unroll
            for (int n = 0; n < 4; ++n)
#pragma unroll
                for (int j = 0; j < 4; ++j) lg[(m * 16 + 4 * lq + j) * 65 + n * 16 + lr] = acc[m][n][j];
        LDS_WAIT(); asm volatile("" ::: "memory");
        {
            const int t = t0 + F.lane;
            float v[64];
#pragma unroll
            for (int e = 0; e < 64; ++e) v[e] = pg8::sigm(lg[F.lane * 65 + e]) + rbias[e];
            float gs[8];
#pragma unroll
            for (int g = 0; g < 8; ++g) { float m1 = -INFINITY, m2 = -INFINITY;
#pragma unroll
                for (int i = 0; i < 8; ++i) { const float xx = v[8 * g + i]; m2 = fmaxf(m2, fminf(m1, xx)); m1 = fmaxf(m1, xx); }
                gs[g] = m1 + m2; }
#pragma unroll
            for (int g = 0; g < 8; ++g) { int rank = 0;
#pragma unroll
                for (int g2 = 0; g2 < 8; ++g2) rank += (gs[g2] > gs[g] || (gs[g2] == gs[g] && g2 < g)) ? 1 : 0;
                if (rank >= 4) {
#pragma unroll
                    for (int i = 0; i < 8; ++i) v[8 * g + i] = -INFINITY; } }
            int se[TOPK]; float ss[TOPK]; float ssum = 0.f;
#pragma unroll
            for (int k = 0; k < TOPK; ++k) { float best = -INFINITY; int bi = 0;
#pragma unroll
                for (int e = 0; e < 64; ++e) { const bool gt = v[e] > best; best = gt ? v[e] : best; bi = gt ? e : bi; }
#pragma unroll
                for (int e = 0; e < 64; ++e) v[e] = (e == bi) ? -INFINITY : v[e];
                const float bs = pg8::sigm(lg[F.lane * 65 + bi]);
                se[k] = bi; ss[k] = bs; ssum += bs; }
            const int chunk = t0 / CT; const float inv = 2.5f / ssum;
            LAS unsigned* hist = (LAS unsigned*)(lg + 64 * 65); LAS unsigned* hbase = hist + 64;
            hist[F.lane] = 0u; LDS_WAIT(); asm volatile("" ::: "memory");
            unsigned lrank[TOPK];
#pragma unroll
            for (int k = 0; k < TOPK; ++k) lrank[k] = __hip_atomic_fetch_add(hist + se[k], 1u, __ATOMIC_RELAXED, __HIP_MEMORY_SCOPE_WORKGROUP);
            LDS_WAIT(); asm volatile("" ::: "memory");
            { const unsigned tot = hist[F.lane]; unsigned base = 0u; if (tot) base = __hip_atomic_fetch_add(cnt + (chunk * 64 + F.lane) * CNT_STRIDE, tot, RLX_AGENT); hbase[F.lane] = base; }
            LDS_WAIT(); asm volatile("" ::: "memory");
#pragma unroll
            for (int k = 0; k < TOPK; ++k) { const int e = se[k]; const unsigned pos = hbase[e] + lrank[k];
                ((GAS int*)LIST)[((size_t)chunk * 64 + e) * CAP + pos] = t; ((GAS int*)TS)[t * 8 + k] = (e << 20) | (int)pos; ((GAS float*)TG)[t * 8 + k] = ss[k] * inv; }
        }
        LDS_WAIT(); asm volatile("" ::: "memory");
    }
}

template <bool GATHER_> struct MoeOrder {
    static constexpr bool GATHER = GATHER_; static constexpr int AUXA = 0;
    const LAS int* tb; int NBr, NBt, NPN, G, vcu;
    unsigned Asrc; int lda;
    unsigned Bexp, bstride, Bsh; int ldb;
    const int* list; const unsigned* cnt; int cstart; const LAS int* rows;
    __device__ __forceinline__ bool next(int i, pg8::Unit& u) const {
        const int L = i * G + vcu; if (L >= NBt * NPN) return false;
        const int blk = L / NPN, pn = L - blk * NPN; u.pm = blk; u.pn = pn;
        if (blk < NBr) { const int w = tb[blk]; u.aux = GATHER ? i : w; u.B = Bexp + (unsigned)(w >> 16) * bstride + (unsigned)pn * 256u * ldb * 2u; }
        else { u.aux = GATHER ? i : -1; u.B = Bsh + (unsigned)pn * 256u * ldb * 2u; }
        u.A = GATHER ? Asrc : Asrc + (unsigned)blk * 256u * lda * 2u; return true;
    }
    __device__ __forceinline__ void aoffs(const pg8::Unit& u, unsigned (&v)[2][2]) const {
        int tid = threadIdx.x; asm volatile("" : "+v"(tid));
#pragma unroll
        for (int i = 0; i < 2; ++i) { int R, C; pg8::stage_rc(tid * 16 + i * 8192, R, C);
#pragma unroll
            for (int h = 0; h < 2; ++h) { const int r = h * 128 + R;
                if constexpr (!GATHER) v[h][i] = (unsigned)(r * lda + C) * 2u;
                else v[h][i] = (unsigned)(rows[u.aux * 256 + r] * lda + C) * 2u; } }
    }
};
__device__ __forceinline__ void moe_rows(Frame& F, LAS int* rows, int NBr, int NBt, int NPN, const int* list, int cstart, bool UP_IDENT_ON = false) {
    const LAS int* tb = (const LAS int*)(F.lds + TBL_OFF);
    for (int idx = F.tid; idx < 16 * 256; idx += NWAVES * 64) { const int i = idx >> 8, r = idx & 255; const int L = i * F.G + F.vcu; if (L >= NBt * NPN) break;
        const int blk = L / NPN; int tok;
        if (blk < NBr) { const int w = tb[blk], e = w >> 16, pos = (w & 0xffff) * 256 + r; tok = pos < tb[1024 + 128 + e] ? ((const GAS int*)list)[(size_t)e * CAP + pos] : cstart; }
        else tok = cstart + (blk - NBr) * 256 + r;
#ifdef UP_IDENT
        if (UP_IDENT_ON) tok = cstart + ((i * 7 + (F.vcu & 63)) & 63) * 256 + r;
#endif
        rows[idx] = tok; }
    __syncthreads();
}
__device__ __forceinline__ void moe_tables(Frame& F, const unsigned* cnt) {
    LAS int* tb = (LAS int*)(F.lds + TBL_OFF); LAS int* tbs = (LAS int*)(F.lds + TBL_OFF + 4096);
    __syncthreads();
    if (F.wave == 0) { const int c = (int)cnt[F.lane * CNT_STRIDE]; const int nb = (c + 255) >> 8; int inc = nb;
#pragma unroll
        for (int o = 1; o < 64; o <<= 1) { const int t = __shfl_up(inc, o); if (F.lane >= o) inc += t; }
        const int start = inc - nb; tbs[F.lane] = start; tbs[128 + F.lane] = c; if (F.lane == 63) tbs[64] = inc;
        for (int j = 0; j < nb; ++j) tb[start + j] = (F.lane << 16) | j; }
    __syncthreads();
}

struct DftOrder {
    static constexpr bool GATHER = false; static constexpr int AUXA = 0;
    unsigned TAB, FT; int L, nM, G, vcu;
    __device__ __forceinline__ bool next(int i, pg8::Unit& u) const {
        const int U = i * G + vcu; if (U >= NBATCH * nM * 2) return false;
        const int b = U / (nM * 2), r = U % (nM * 2); u.pm = r >> 1; u.pn = r & 1; u.aux = b;
        u.A = TAB + (unsigned)u.pm * 256u * L * 2u; u.B = FT + ((unsigned)b * 512u + u.pn * 256u) * L * 2u; return true;
    }
    __device__ __forceinline__ void aoffs(const pg8::Unit&, unsigned (&v)[2][2]) const {
        int tid = threadIdx.x; asm volatile("" : "+v"(tid));
#pragma unroll
        for (int i = 0; i < 2; ++i) { int R, C; pg8::stage_rc(tid * 16 + i * 8192, R, C);
#pragma unroll
            for (int h = 0; h < 2; ++h) v[h][i] = (unsigned)((h * 128 + R) * L + C) * 2u; }
    }
};

struct KSplitOrder {
    static constexpr bool GATHER = false; static constexpr int AUXA = 0;
    unsigned A, B; int ld, nM, nN, nS, Kq, G, c;
    __device__ __forceinline__ bool next(int i, pg8::Unit& u) const {
        const int U = i * G + c; if (U >= nM * nN * nS) return false;
        const int ks = U % nS, t = U / nS, pm = t % nM, pn = t / nM; u.pm = pm + nM * ks; u.pn = pn; u.aux = 0;
        u.A = A + ((unsigned)pm * 256u * ld + (unsigned)ks * Kq) * 2u; u.B = B + ((unsigned)pn * 256u * ld + (unsigned)ks * Kq) * 2u; return true;
    }
    __device__ __forceinline__ void aoffs(const pg8::Unit&, unsigned (&v)[2][2]) const {
        int tid = threadIdx.x; asm volatile("" : "+v"(tid));
#pragma unroll
        for (int i = 0; i < 2; ++i) { int R, C; pg8::stage_rc(tid * 16 + i * 8192, R, C);
#pragma unroll
            for (int h = 0; h < 2; ++h) v[h][i] = (unsigned)((h * 128 + R) * ld + C) * 2u; }
    }
};
#ifndef KSPLIT_CTX
#define KSPLIT_CTX 1
#endif

struct Args { const float* in[25]; float* out; unsigned char* ws; int ph_lo, ph_hi, li, pad; };
#ifndef CVT_EARLY
#define CVT_EARLY 8192
#endif
#ifndef REPEAT_MASK
#define REPEAT_MASK 0u
#endif
#define IN(k) (lo <= (k) && (k) < hi && (k) <= DBG_LAST_PHASE)
#define REPS(k) for (int rep_ = 0; rep_ <= (int)((REPEAT_MASK >> (k)) & 1u); ++rep_)
#define SEAM(k) do { if (lo <= (k) && (k) + 1 < hi) xcd_barrier(bar); } while (0)

template <int LAYER, int CHUNK> __device__ __forceinline__ void moe_chunk(Frame& F, const XcdBarrier& bar, const int lo, const int hi) {
    constexpr int pb = LAYER == 0 ? PB0 : PB1, p = pb + 2 + 3 * CHUNK, ntok = LAYER == 0 ? T0 : TL, CT = ntok / NCH;
    if (IN(p)) REPS(p) { FENCE(F);
        const unsigned* cnt = (const unsigned*)(F.ctl + CW_CNT) + (LAYER * NCH + CHUNK) * 64 * CNT_STRIDE; const int* list = wsp<const int>(F, WS_LIST) + (size_t)CHUNK * 64 * CAP;
        const LAS int* tb = (const LAS int*)(F.lds + TBL_OFF); const LAS int* tbs = (const LAS int*)(F.lds + TBL_OFF + 4096);
        moe_tables(F, cnt); const int NBr = tbs[64];
        LAS int* rows = (LAS int*)(F.lds + STAGE_OFF);
        moe_rows(F, rows, NBr, NBr + CT / 256, 2, list, CHUNK * CT);
        MoeOrder<true> S{tb, NBr, NBr + CT / 256, 2, F.G, F.vcu, (unsigned)WS_HX, 1024, (unsigned)WS_WEUP, 512u * 1024u * 2u, (unsigned)WS_SHUP + (unsigned)LAYER * 512u * 1024u * 2u, 1024, list, cnt, CHUNK * CT, rows};
#ifdef UP_DRY
        { if (UP_DRY == 2) moe_rows(F, rows, NBr, NBr + CT / 256, 2, list, CHUNK * CT, true);
          pg8::EpiSwiglu E{wsp<bf16>(F, WS_HID), 256, F.ws, UP_DRY == 1 ? 1 : 0}; pg8::gemm_phase(F.lds + RING_OFF, F.ws, 1024, 1024, S, E); FENCE(F);
          if (UP_DRY == 2) { __syncthreads(); moe_rows(F, rows, NBr, NBr + CT / 256, 2, list, CHUNK * CT); } }
#endif
        pg8::EpiSwiglu E{wsp<bf16>(F, WS_HID), 256, F.ws}; pg8::gemm_phase(F.lds + RING_OFF, F.ws, 1024, 1024, S, E); } SEAM(p);
    if (IN(p + 1)) REPS(p + 1) { FENCE(F);
        const unsigned* cnt = (const unsigned*)(F.ctl + CW_CNT) + (LAYER * NCH + CHUNK) * 64 * CNT_STRIDE; const int* list = wsp<const int>(F, WS_LIST) + (size_t)CHUNK * 64 * CAP;
        const LAS int* tb = (const LAS int*)(F.lds + TBL_OFF); const LAS int* tbs = (const LAS int*)(F.lds + TBL_OFF + 4096);
        moe_tables(F, cnt); const int NBr = tbs[64];
        MoeOrder<false> S{tb, NBr, NBr + CT / 256, 4, F.G, F.vcu, (unsigned)WS_HID, 256, (unsigned)WS_WEDN, 1024u * 256u * 2u, (unsigned)WS_SHDN + (unsigned)LAYER * 1024u * 256u * 2u, 256, list, cnt, CHUNK * CT, nullptr};
        pg8::EpiFp8 E{wsp<unsigned char>(F, WS_YEXP), F.lds + STAGE_OFF, F.ws}; pg8::gemm_phase(F.lds + RING_OFF, F.ws, 256, 256, S, E); } SEAM(p + 1);
    if (IN(p + 2)) REPS(p + 2) { FENCE(F);
        const unsigned* cnt = (const unsigned*)(F.ctl + CW_CNT) + (LAYER * NCH + CHUNK) * 64 * CNT_STRIDE;
        moe_tables(F, cnt);
        phase_e4(F, LAYER, CHUNK, CT); }
    if (CHUNK == NCH - 1) SEAM(p + 2);
#if !MK_SINGLE
    static_assert(true, "");
#endif
}
template <int LAYER> __device__ __forceinline__ void moe_part(Frame& F, const XcdBarrier& bar, const int lo, const int hi) {
    constexpr int pb = LAYER == 0 ? PB0 : PB1, ntok = LAYER == 0 ? T0 : TL, CT = ntok / NCH;
    if (IN(pb)) REPS(pb) { FENCE(F); phase_e2(F, LAYER); } SEAM(pb);
    if (IN(pb + 1)) { FENCE(F);
#ifdef ROUTER_TIMING
        phase_router(F, LAYER, ntok, CT, 4 * 64 * CNT_STRIDE); FENCE(F);
#endif
        phase_router(F, LAYER, ntok, CT); } SEAM(pb + 1);
    moe_chunk<LAYER, 0>(F, bar, lo, hi);
    if constexpr (NCH > 1) moe_chunk<LAYER, NCH - 1>(F, bar, lo, hi);
    static_assert(NCH <= 2, "moe_part instantiates chunks 0 and NCH-1");
}

__global__ void __launch_bounds__(NWAVES * 64, 2) mega_fwd(Args args) {
    extern __shared__ __attribute__((aligned(16))) unsigned char lds[];
    Frame F;
    F.lds = (LAS unsigned char*)lds;
    F.MISC = (volatile LAS unsigned*)(F.lds + MISC_OFF);
    F.tid = threadIdx.x; F.lane = F.tid & 63; F.wave = __builtin_amdgcn_readfirstlane(F.tid >> 6);
    F.G = gridDim.x; { const int bx = blockIdx.x; F.vcu = (F.G % 8 == 0) ? (bx % 8) * (F.G / 8) + bx / 8 : bx; }
    F.ws = args.ws; F.ctl = (gu32*)(args.ws + WS_CTL); F.out = args.out;
    for (int u = F.tid; u < (LDS_BYTES - LDSCTL_OFF) / 4; u += NWAVES * 64) ((LAS unsigned*)(F.lds + LDSCTL_OFF))[u] = 0u;
    __syncthreads();
    if (F.tid < 25) { const unsigned long long pv = (unsigned long long)args.in[F.tid]; LAS unsigned* t = (LAS unsigned*)(F.lds + INPTR_OFF) + 2 * F.tid; t[0] = (unsigned)pv; t[1] = (unsigned)(pv >> 32); }
    __syncthreads();
    XcdBarrier bar; bar.bar = (unsigned*)(F.ctl + CW_BAR); bar.x = 0; bar.st = nullptr;
#if MK_SINGLE
    bar = xcd_barrier_post((unsigned*)(F.ctl + CW_BAR), F.MISC + 8);
#endif
    const int lo = args.ph_lo, hi = args.ph_hi;
    const int bx = (int)blockIdx.x;

    if (IN(0)) REPS(0) { FENCE(F); p0_prologue(F); } SEAM(0);
#ifdef EXTRA_BARS
    for (int eb = 0; eb < EXTRA_BARS; ++eb) xcd_barrier(bar);
#endif
    if (IN(1)) REPS(1) { FENCE(F); phase_modnorm0(F); } SEAM(1);
    if (IN(2)) REPS(2) { FENCE(F);
        pg8::DenseOrder S; S.init((unsigned)WS_HX, 1024, (unsigned)WS_WIN, 1024, T0 / 256, 6, 0, F.G, bx); pg8::EpiGluFT E{{wsp<bf16>(F, WS_AGLU), F.ws}, {wsp<bf16>(F, WS_FT), wsp<bf16>(F, WS_FTC)}}; pg8::gemm_phase(F.lds + RING_OFF, F.ws, 1024, 1024, S, E);
        if (CVT0_LATE > 0 && F.G == 256 && bx >= 48) { FENCE(F); convert_experts(F, 0, 0, CVT0_LATE, 48, 208); } } SEAM(2);
    if (IN(3)) REPS(3) { FENCE(F); phase_conv(F);
        { DftOrder S{(unsigned)WS_TAB, (unsigned)WS_FT, SEQ, SEQ / 256, F.G, F.vcu}; pg8::EpiDft<SEQ> E{wsp<bf16>(F, WS_XA), 0, F.ws, 1536, 512}; pg8::gemm_phase(F.lds + RING_OFF, F.ws, SEQ, SEQ, S, E); }
        FENCE(F);
        { DftOrder S{(unsigned)WS_TABC, (unsigned)WS_FTC, CTXL, 1, F.G, F.G - 1 - F.vcu};     pg8::EpiDft<CTXL> E{wsp<bf16>(F, WS_XA), TL, F.ws, 1536, 512}; pg8::gemm_phase(F.lds + RING_OFF, F.ws, CTXL, CTXL, S, E); } } SEAM(3);
    if (IN(4)) REPS(4) { FENCE(F);
#if KSPLIT_CTX
        { pg8::DenseOrder S; S.init((unsigned)WS_XA, 1536, (unsigned)WS_W2, 1536, TL / 256, 4, 0, F.G, bx);
          pg8::EpiBf16 E{wsp<bf16>(F, WS_Y), 1024, 0, F.lds + STAGE_OFF, F.ws}; pg8::gemm_phase(F.lds + RING_OFF, F.ws, 1536, 1536, S, E); }
        FENCE(F);
        { KSplitOrder S{(unsigned)(WS_XA + (size_t)TL * 1536 * 2), (unsigned)WS_W2, 1536, TC / 256, 4, 4, 384, F.G, bx};
          pg8::EpiBf16 E{wsp<bf16>(F, WS_YPART), 1024, 0, F.lds + STAGE_OFF, F.ws}; pg8::gemm_phase(F.lds + RING_OFF, F.ws, 384, 1536, S, E); }
#else
        pg8::DenseOrder S; S.init((unsigned)WS_XA, 1536, (unsigned)WS_W2, 1536, T0 / 256, 4, 0, F.G, bx);
        pg8::EpiBf16 E{wsp<bf16>(F, WS_Y), 1024, 0, F.lds + STAGE_OFF, F.ws}; pg8::gemm_phase(F.lds + RING_OFF, F.ws, 1536, 1536, S, E);
#endif
    } SEAM(4);
    moe_part<0>(F, bar, lo, hi);
    if (IN(PH_QKV)) REPS(PH_QKV) { FENCE(F);
        { pg8::DenseOrder S; S.init((unsigned)WS_HX, 1024, (unsigned)WS_WQKV, 1024, TL / 256, 12, 0, F.G, bx);
          pg8::EpiQkv E{wsp<bf16>(F, WS_Q), wsp<bf16>(F, WS_KALL), wsp<bf16>(F, WS_VALL), wsp<unsigned>(F, WS_ROPE), 0, F.ws, F.lds + STAGE_OFF, (unsigned*)(F.ctl + CW_KMAX)}; pg8::gemm_phase(F.lds + RING_OFF, F.ws, 1024, 1024, S, E); }
        FENCE(F);
        { pg8::DenseOrder S; S.init((unsigned)(WS_HX + (size_t)TL * 2048), 1024, (unsigned)WS_WQKV, 1024, TC / 256, 8, 4, F.G, bx);
          pg8::EpiQkv E{wsp<bf16>(F, WS_Q), wsp<bf16>(F, WS_KALL), wsp<bf16>(F, WS_VALL), wsp<unsigned>(F, WS_ROPE), 1, F.ws, F.lds + STAGE_OFF, (unsigned*)(F.ctl + CW_KMAX)}; pg8::gemm_phase(F.lds + RING_OFF, F.ws, 1024, 1024, S, E); }
        if (CVT_EARLY > 0 && F.G == 256 && bx >= 64) { FENCE(F); convert_experts(F, 1, 0, CVT_EARLY, 64, 192); }
    } SEAM(PH_QKV);
    if (IN(PH_ATT)) REPS(PH_ATT) { FENCE(F);
        const attn_body::bf16* Q = wsp<const attn_body::bf16>(F, WS_Q); const attn_body::bf16* KA = wsp<const attn_body::bf16>(F, WS_KALL); const attn_body::bf16* VA = wsp<const attn_body::bf16>(F, WS_VALL);
        attn_body::bf16* OC = wsp<attn_body::bf16>(F, WS_OC);
        for (int i = 0;; ++i) { int bh, cc, qb;
            if (F.G == 256) { if (i >= 8) break; const int xg = F.vcu >> 5, ci = F.vcu & 31; bh = xg * 8 + i; cc = ci >> 4; qb = ci & 15; }
            else { const int u = i * F.G + F.vcu; if (u >= 64 * 2 * (SEQ / 256)) break; bh = u >> 5; cc = (u >> 4) & 1; qb = u & 15; }
            const int b = bh >> 3, h = bh & 7;
            attn_body::attn_unit<8>(Q + ((size_t)b * SEQ + qb * 256) * 1024 + h * 128 + cc * 64, KA + (size_t)b * LKV * 1024 + h * 128 + cc * 64, VA + (size_t)b * LKV * 1024 + h * 128,
                                    OC + ((size_t)b * SEQ + qb * 256) * 2048 + h * 256 + cc * 128, LKV / 64, (char*)lds + RING_OFF, __builtin_bit_cast(float, F.ctl[CW_KMAX + (b * 8 + h) * 2 + cc])); }
    } SEAM(PH_ATT);
    if (IN(PH_CMB)) REPS(PH_CMB) { FENCE(F); phase_combine(F); FENCE(F); convert_experts(F, 1, (CVT_EARLY > 0 && F.G == 256) ? CVT_EARLY : 0); } SEAM(PH_CMB);
    if (IN(PH_OPR)) REPS(PH_OPR) { FENCE(F); pg8::DenseOrder S; S.init((unsigned)WS_Q, 1024, (unsigned)WS_WDAO, 1024, TL / 256, 4, 0, F.G, bx);
#ifdef OPR_EXTRA
        for (int xk = 0; xk < OPR_EXTRA; ++xk) {
#ifdef OPR_AMUL
            S.amul = OPR_AMUL;
#endif
#if OPR_NULL
            pg8::EpiNull<true> E0; pg8::gemm_phase(F.lds + RING_OFF, F.ws, 1024, 1024, S, E0);
#else
            pg8::EpiBf16 E0{wsp<bf16>(F, WS_Y1), 1024, 0, F.lds + STAGE_OFF, F.ws}; pg8::gemm_phase(F.lds + RING_OFF, F.ws, 1024, 1024, S, E0);
#endif
            FENCE(F); S.init((unsigned)WS_Q, 1024, (unsigned)WS_WDAO, 1024, TL / 256, 4, 0, F.G, bx); }
#endif
        pg8::EpiBf16 E{wsp<bf16>(F, WS_Y1), 1024, 0, F.lds + STAGE_OFF, F.ws}; pg8::gemm_phase(F.lds + RING_OFF, F.ws, 1024, 1024, S, E); } SEAM(PH_OPR);
    moe_part<1>(F, bar, lo, hi);
}
#undef IN
#undef SEAM

extern "C" void kernel_launch(void* const* d_in, const int* in_sizes, int n_in, void* d_out, int out_size, void* d_ws, size_t ws_size, hipStream_t stream) {
    static int grid = 0;
    if (grid == 0) {
        if (n_in != 25 || in_sizes[0] != TL * DM || out_size != TL * DM || ws_size < WS_END) { fprintf(stderr, "kernel_launch: unexpected problem shape / workspace (n_in %d, in0 %d, out %d, ws %zu, need %zu); nothing launched\n", n_in, n_in > 0 ? in_sizes[0] : -1, out_size, ws_size, (size_t)WS_END); grid = -1; return; }
        int dev = 0, cus = 0, per_cu = 0;
        if (hipGetDevice(&dev) != hipSuccess || hipDeviceGetAttribute(&cus, hipDeviceAttributeMultiprocessorCount, dev) != hipSuccess) { grid = -1; return; }
        if (hipFuncSetAttribute((const void*)mega_fwd, hipFuncAttributeMaxDynamicSharedMemorySize, LDS_BYTES) != hipSuccess) { fprintf(stderr, "kernel_launch: hipFuncSetAttribute failed\n"); grid = -1; return; }
        if (hipOccupancyMaxActiveBlocksPerMultiprocessor(&per_cu, (const void*)mega_fwd, NWAVES * 64, LDS_BYTES) != hipSuccess || per_cu < 1) fprintf(stderr, "kernel_launch: occupancy query reports %d per CU\n", per_cu);
        (void)hipGetLastError();
        grid = cus;
    }
    if (grid < 0) return;
    if (hipMemsetAsync((char*)d_ws + WS_CTL, 0, CTL_ZERO_BYTES, stream) != hipSuccess) return;
    Args a{};
    for (int i = 0; i < 25; ++i) a.in[i] = (const float*)d_in[i];
    a.out = (float*)d_out; a.ws = (unsigned char*)d_ws;
#if MK_SINGLE
    a.ph_lo = 0; a.ph_hi = NPHASES; a.li = 0;
    hipLaunchKernelGGL(mega_fwd, dim3(grid), dim3(NWAVES * 64), LDS_BYTES, stream, a);
#else
    for (int p = 0; p <= DBG_LAST_PHASE && p < NPHASES; ++p) { a.ph_lo = p; a.ph_hi = p + 1; a.li = p;
        hipLaunchKernelGGL(mega_fwd, dim3(grid), dim3(NWAVES * 64), LDS_BYTES, stream, a); }
#endif
}
```
